# Optimizing an MI355X kernel written in HIP

```python
import functools
import numpy as np
import jax, jax.numpy as jnp
from jax import lax

D_MODEL = 2048
BATCH = 4
SEQ = 2048
DEPTH = 1
DEC_BATCH = 32
DEC_SEQ = 8
PAST_LEN = 8192
PAGE_SIZE = 128

GDN_QK_HEADS = 16
GDN_V_HEADS = 32
GDN_DK = 128
GDN_DV = 128
CONV_W = 4
GDN_CHUNK = 64
ATT_HEADS = 16
ATT_KV_HEADS = 2
ATT_DH = 128
IDX_HEADS = 16
IDX_DH = 128
TOPK_MAX = 256
Q_BLOCK = 128
NORM_EPS = 1e-6
L2_EPS = 1e-6

A_QK = GDN_QK_HEADS * GDN_DK
A_V = GDN_V_HEADS * GDN_DV
A_CONV_CH = 2 * A_QK + A_V
B_Q = ATT_HEADS * ATT_DH
B_KV = ATT_KV_HEADS * ATT_DH
IDX_Q = IDX_HEADS * IDX_DH
SPLIT_SIZES = (A_CONV_CH, A_V, GDN_V_HEADS, GDN_V_HEADS, B_Q, B_KV, B_KV, B_Q, IDX_Q, IDX_DH, IDX_HEADS, D_MODEL, D_MODEL)
D_IN = sum(SPLIT_SIZES)

kernel_name = 'hybrid_gdn_dsa_decoder_step'


def rms_norm(x, g):
    xf = x.astype(jnp.float32)
    y = xf * lax.rsqrt(jnp.mean(xf * xf, axis=-1, keepdims=True) + NORM_EPS)
    return (y * g.astype(jnp.float32)).astype(x.dtype)


def l2_normalize(x):
    xf = x.astype(jnp.float32)
    return xf * lax.rsqrt(jnp.sum(xf * xf, axis=-1, keepdims=True) + L2_EPS)


def split_columns(t):
    offsets = np.cumsum(SPLIT_SIZES)[:-1].tolist()
    return jnp.split(t, offsets, axis=-1)


def causal_short_conv(x, buf, w):
    L = x.shape[1]
    xp = jnp.concatenate([buf.astype(x.dtype), x], axis=1)
    y = sum(xp[:, i:i + L] * w[i] for i in range(CONV_W))
    return jax.nn.silu(y), xp[:, xp.shape[1] - (CONV_W - 1):]


def gated_delta_rule(q, k, v, g, beta, s0):
    B, L, H, DK = q.shape
    DV = v.shape[-1]
    C = min(GDN_CHUNK, L)
    n = -(-L // C)
    pad = n * C - L

    def blocks(t):
        t = jnp.moveaxis(t, 2, 1)
        t = jnp.pad(t, [(0, 0), (0, 0), (0, pad)] + [(0, 0)] * (t.ndim - 3))
        return t.reshape(B, H, n, C, *t.shape[3:])

    q, k, v, g, beta = (blocks(t) for t in (q, k, v, g, beta))
    G = jnp.cumsum(g, axis=-1)
    incl = jnp.tril(jnp.ones((C, C), bool))
    strict = jnp.tril(jnp.ones((C, C), bool), -1)
    decay = jnp.exp(jnp.where(incl, G[..., :, None] - G[..., None, :], -jnp.inf))
    kb = k * beta[..., None]
    a_strict = jnp.where(strict, jnp.einsum('bhnid,bhnjd->bhnij', kb, k) * decay, 0.0)
    rhs = jnp.concatenate([v * beta[..., None], kb * jnp.exp(G)[..., None]], axis=-1)
    sol = lax.linalg.triangular_solve(a_strict, rhs, left_side=True, lower=True, unit_diagonal=True)
    u_intra, w_state = sol[..., :DV], sol[..., DV:]
    qk = jnp.einsum('bhnid,bhnjd->bhnij', q, k) * decay
    q_dec = q * jnp.exp(G)[..., None]
    k_tail = k * jnp.exp(G[..., -1:] - G)[..., None]
    g_tail = jnp.exp(G[..., -1])

    def chunk_step(s, xs):
        u_c, w_c, qk_c, qd_c, kt_c, gt_c = xs
        u = u_c - jnp.einsum('bhck,bhkv->bhcv', w_c, s)
        o = jnp.einsum('bhck,bhkv->bhcv', qd_c, s) + jnp.einsum('bhij,bhjv->bhiv', qk_c, u)
        s = s * gt_c[..., None, None] + jnp.einsum('bhck,bhcv->bhkv', kt_c, u)
        return s, o

    xs = tuple(jnp.moveaxis(t, 2, 0) for t in (u_intra, w_state, qk, q_dec, k_tail, g_tail))
    s, o = lax.scan(chunk_step, s0, xs)
    o = jnp.moveaxis(o, 0, 2).reshape(B, H, n * C, DV)[:, :, :L]
    return jnp.moveaxis(o, 1, 2), s


def gdn_branch(a_qkv, a_z, a_b, a_a, conv_buf, s0, conv_w, a_log, dt_bias, gdn_norm_g):
    B, L, _ = a_qkv.shape
    qkv, conv_new = causal_short_conv(a_qkv, conv_buf, conv_w)
    q, k, v = jnp.split(qkv, [A_QK, 2 * A_QK], axis=-1)
    rep = GDN_V_HEADS // GDN_QK_HEADS
    q = jnp.repeat(l2_normalize(q.reshape(B, L, GDN_QK_HEADS, GDN_DK)), rep, axis=2) * (GDN_DK ** -0.5)
    k = jnp.repeat(l2_normalize(k.reshape(B, L, GDN_QK_HEADS, GDN_DK)), rep, axis=2)
    v = v.reshape(B, L, GDN_V_HEADS, GDN_DV).astype(jnp.float32)
    beta = jax.nn.sigmoid(a_b.astype(jnp.float32))
    g = -jnp.exp(a_log.astype(jnp.float32)) * jax.nn.softplus(a_a.astype(jnp.float32) + dt_bias.astype(jnp.float32))
    o, s = gated_delta_rule(q, k, v, g, beta, s0.astype(jnp.float32))
    z = a_z.reshape(B, L, GDN_V_HEADS, GDN_DV).astype(jnp.float32)
    y = rms_norm(o, gdn_norm_g) * jax.nn.silu(z)
    return y.reshape(B, L, A_V).astype(a_qkv.dtype), s.astype(s0.dtype), conv_new


def indexer_topk(qi, wi, kidx, q_pos, topk):
    logits = jnp.einsum('bqhd,bkd->bqhk', qi.astype(jnp.float32), kidx.astype(jnp.float32)) * (IDX_DH ** -0.5)
    score = jnp.einsum('bqhk,bqh->bqk', jax.nn.relu(logits), wi.astype(jnp.float32)) * (IDX_HEADS ** -0.5)
    causal = jnp.arange(kidx.shape[1])[None, :] <= q_pos[:, None]
    score = jnp.where(causal[None], score, -jnp.inf)
    _, idx = lax.top_k(score, topk)
    return idx, idx <= q_pos[None, :, None]


def sparse_attention(q, k_sel, v_sel, valid):
    B, Q = q.shape[:2]
    qg = q.reshape(B, Q, ATT_KV_HEADS, ATT_HEADS // ATT_KV_HEADS, ATT_DH)
    s = jnp.einsum('bqngd,bqknd->bqngk', qg, k_sel).astype(jnp.float32) * (ATT_DH ** -0.5)
    s = jnp.where(valid[:, :, None, None, :], s, -jnp.inf)
    p = jax.nn.softmax(s, axis=-1).astype(v_sel.dtype)
    o = jnp.einsum('bqngk,bqknd->bqngd', p, v_sel)
    return o.reshape(B, Q, ATT_HEADS * ATT_DH)


def gather_rows(rows, idx):
    return jax.vmap(lambda r, i: r[i])(rows, idx)


def dsa_prompt(q, k, v, qi, wi, kidx):
    B, L = q.shape[:2]
    topk = min(TOPK_MAX, L // 4)
    qb = Q_BLOCK if L % Q_BLOCK == 0 else L
    nb = L // qb

    def to_blocks(t):
        return jnp.swapaxes(t.reshape(B, nb, qb, *t.shape[2:]), 0, 1)

    def block(args):
        q_b, qi_b, wi_b, pos_b = args
        idx, valid = indexer_topk(qi_b, wi_b, kidx, pos_b, topk)
        return sparse_attention(q_b, gather_rows(k, idx), gather_rows(v, idx), valid)

    o = lax.map(block, (to_blocks(q), to_blocks(qi), to_blocks(wi), jnp.arange(L).reshape(nb, qb)))
    return jnp.swapaxes(o, 0, 1).reshape(B, L, ATT_HEADS * ATT_DH)


def dsa_sample(q, k, v, qi, wi, kidx, cache_k, cache_v, cache_kidx, page_table):
    B, L = q.shape[:2]
    past = page_table.shape[1] * PAGE_SIZE
    topk = min(TOPK_MAX, (past + L) // 4)
    kidx_past = cache_kidx[page_table].reshape(B, past, IDX_DH)
    kidx_all = jnp.concatenate([kidx_past, kidx.astype(kidx_past.dtype)], axis=1)
    idx, valid = indexer_topk(qi, wi, kidx_all, past + jnp.arange(L), topk)
    in_past = (idx < past)[..., None, None]
    p_idx = jnp.minimum(idx, past - 1)
    phys = gather_rows(page_table, p_idx // PAGE_SIZE)
    off = p_idx % PAGE_SIZE
    n_idx = jnp.clip(idx - past, 0, L - 1)
    k_sel = jnp.where(in_past, cache_k[phys, off], gather_rows(k, n_idx).astype(cache_k.dtype))
    v_sel = jnp.where(in_past, cache_v[phys, off], gather_rows(v, n_idx).astype(cache_v.dtype))
    return sparse_attention(q, k_sel, v_sel, valid)


def hybrid_layer(x, c, conv_buf, s0, attend, w_ada, b_ada, pre_norm_g, w_in, conv_w, a_log, dt_bias,
                 gdn_norm_g, w_pa, w_pb, w_out, post_norm_g):
    B, L, _ = x.shape
    mod = jnp.einsum('bc,cd->bd', jax.nn.silu(c), w_ada) + b_ada
    shift, scale, gate = jnp.split(mod, 3, axis=-1)
    h = rms_norm(x, pre_norm_g) * (1.0 + scale[:, None]) + shift[:, None]
    (a_qkv, a_z, a_b, a_a, b_q, b_k, b_v, b_z, i_q, i_k, i_w, g_a, g_b) = split_columns(h @ w_in)
    y_a, s_new, conv_new = gdn_branch(a_qkv, a_z, a_b, a_a, conv_buf, s0, conv_w, a_log, dt_bias, gdn_norm_g)
    q = b_q.reshape(B, L, ATT_HEADS, ATT_DH)
    k = b_k.reshape(B, L, ATT_KV_HEADS, ATT_DH)
    v = b_v.reshape(B, L, ATT_KV_HEADS, ATT_DH)
    qi = i_q.reshape(B, L, IDX_HEADS, IDX_DH)
    y_b = attend(q, k, v, qi, i_w, i_k) * jax.nn.silu(b_z)
    merged = jax.nn.sigmoid(g_a) * (y_a @ w_pa) + jax.nn.sigmoid(g_b) * (y_b @ w_pb)
    out = rms_norm(merged @ w_out, post_norm_g)
    return x + gate[:, None] * out, (k, v, i_k, s_new, conv_new)


def setup_inputs(seed: int = 0) -> dict:
    key = jax.random.key(seed)
    ks = jax.random.split(key, 24)
    f32 = jnp.float32
    n_pages = PAST_LEN // PAGE_SIZE
    n_pool = (DEC_BATCH * n_pages * 5) // 4

    def nrm(k, shape, s):
        return jax.random.normal(k, shape, f32) * s

    page_table = jax.random.permutation(ks[9], n_pool)[:DEC_BATCH * n_pages].reshape(DEC_BATCH, n_pages).astype(jnp.int32)
    return {
        'x_prompt': nrm(ks[0], (BATCH, SEQ, D_MODEL), 1.0),
        'x_sample': nrm(ks[1], (DEC_BATCH, DEC_SEQ, D_MODEL), 1.0),
        'c_prompt': nrm(ks[2], (BATCH, D_MODEL), 1.0),
        'c_sample': nrm(ks[3], (DEC_BATCH, D_MODEL), 1.0),
        'cache_k': nrm(ks[4], (DEPTH, n_pool, PAGE_SIZE, ATT_KV_HEADS, ATT_DH), 1.0),
        'cache_v': nrm(ks[5], (DEPTH, n_pool, PAGE_SIZE, ATT_KV_HEADS, ATT_DH), 1.0),
        'cache_kidx': nrm(ks[6], (DEPTH, n_pool, PAGE_SIZE, IDX_DH), 1.0),
        'state_gdn': nrm(ks[7], (DEPTH, DEC_BATCH, GDN_V_HEADS, GDN_DK, GDN_DV), 0.1),
        'state_conv': nrm(ks[8], (DEPTH, DEC_BATCH, CONV_W - 1, A_CONV_CH), 1.0),
        'page_table': page_table,
        'w_ada': nrm(ks[10], (DEPTH, D_MODEL, 3 * D_MODEL), 0.5 * D_MODEL ** -0.5),
        'b_ada': nrm(ks[11], (DEPTH, 3 * D_MODEL), 0.01),
        'pre_norm_g': 1.0 + nrm(ks[12], (DEPTH, D_MODEL), 0.02),
        'w_in': nrm(ks[13], (DEPTH, D_MODEL, D_IN), D_MODEL ** -0.5),
        'conv_w': nrm(ks[14], (DEPTH, CONV_W, A_CONV_CH), CONV_W ** -0.5),
        'a_log': jnp.log(jax.random.uniform(ks[15], (DEPTH, GDN_V_HEADS), f32, 1.0, 16.0)),
        'dt_bias': nrm(ks[16], (DEPTH, GDN_V_HEADS), 0.1),
        'gdn_norm_g': 1.0 + nrm(ks[17], (DEPTH, GDN_DV), 0.02),
        'w_pa': nrm(ks[18], (DEPTH, A_V, D_MODEL), A_V ** -0.5),
        'w_pb': nrm(ks[19], (DEPTH, B_Q, D_MODEL), B_Q ** -0.5),
        'w_out': nrm(ks[20], (DEPTH, D_MODEL, D_MODEL), D_MODEL ** -0.5),
        'post_norm_g': 1.0 + nrm(ks[21], (DEPTH, D_MODEL), 0.02),
    }


def reference(x_prompt, x_sample, c_prompt, c_sample, cache_k, cache_v, cache_kidx, state_gdn, state_conv,
              page_table, w_ada, b_ada, pre_norm_g, w_in, conv_w, a_log, dt_bias, gdn_norm_g, w_pa, w_pb,
              w_out, post_norm_g):
    y_p, y_s = x_prompt, x_sample
    bp = x_prompt.shape[0]
    new_p, new_s = [], []
    for l in range(DEPTH):
        w = (w_ada[l], b_ada[l], pre_norm_g[l], w_in[l], conv_w[l], a_log[l], dt_bias[l], gdn_norm_g[l],
             w_pa[l], w_pb[l], w_out[l], post_norm_g[l])
        conv0 = jnp.zeros((bp, CONV_W - 1, A_CONV_CH), x_prompt.dtype)
        s0 = jnp.zeros((bp, GDN_V_HEADS, GDN_DK, GDN_DV), state_gdn.dtype)
        y_p, st_p = hybrid_layer(y_p, c_prompt, conv0, s0, dsa_prompt, *w)
        attend_s = functools.partial(dsa_sample, cache_k=cache_k[l], cache_v=cache_v[l],
                                     cache_kidx=cache_kidx[l], page_table=page_table)
        y_s, st_s = hybrid_layer(y_s, c_sample, state_conv[l], state_gdn[l], attend_s, *w)
        new_p.append(st_p)
        new_s.append(st_s)

    def stacked(sts, i):
        return jnp.stack([st[i] for st in sts])

    return (y_p, y_s,
            stacked(new_p, 0), stacked(new_p, 1), stacked(new_p, 2), stacked(new_p, 3), stacked(new_p, 4),
            stacked(new_s, 0), stacked(new_s, 1), stacked(new_s, 2), stacked(new_s, 3), stacked(new_s, 4))
```

```cpp
#include <hip/hip_runtime.h>
#include <cstdio>
#include <cstdint>
constexpr int D = 2048, BP = 4, LP = 2048, BS = 32, LS = 8, MP = BP * LP, MS = BS * LS, MROWS = MP + MS;
constexpr int NPAGES = 64, PAGE = 128, PAST = NPAGES * PAGE;
constexpr int HV = 32, HQK = 16, DK = 128, DV = 128, CONVCH = 8192;
constexpr int NIN = 23248, NPAD = 23296;
constexpr int NTOPK = 256;
constexpr float NORM_EPS = 1e-6f, L2_EPS = 1e-6f;
constexpr int SCS_LD = 8256;
constexpr size_t O_YP = 0, O_YS = O_YP + (size_t)MP * D, O_KP = O_YS + (size_t)MS * D, O_VP = O_KP + (size_t)MP * 256, O_KIP = O_VP + (size_t)MP * 256,
                 O_GP = O_KIP + (size_t)MP * 128, O_CP = O_GP + (size_t)BP * HV * DK * DV, O_KS = O_CP + (size_t)BP * 3 * CONVCH, O_VS = O_KS + (size_t)MS * 256,
                 O_KIS = O_VS + (size_t)MS * 256, O_GS = O_KIS + (size_t)MS * 128, O_CS = O_GS + (size_t)BS * HV * DK * DV, O_END = O_CS + (size_t)BS * 3 * CONVCH;
static_assert(O_END == 42467328, "output size");
__host__ __device__ __forceinline__ int win_src_col(int n) {
    if (n < 12288) return n;
    if (n < 18944) return n + 64;
    if (n < 23040) return n + 208;
    if (n < 23168) return n - 23040 + 19008;
    if (n < 23200) return n - 23168 + 12288;
    if (n < 23232) return n - 23200 + 12320;
    if (n < 23248) return n - 23232 + 19136;
    return -1;
}
namespace pg8 {
#define PG8_LAS __attribute__((address_space(3)))
typedef unsigned short bf16_t;
typedef short bf16x8 __attribute__((ext_vector_type(8)));
typedef float f32x4 __attribute__((ext_vector_type(4)));
typedef unsigned u32x4 __attribute__((ext_vector_type(4)));
constexpr int BM = 256, BK = 64, HALF = 128, HTB = HALF * BK * 2  , STAGE_BYTES = 8 * HTB, NXCD = 8, WGM = 8;

__host__ __device__ __forceinline__ int lds_byte(int r, int c) { const int st = (r >> 4) * 2 + (c >> 5), rr = r & 15, cc = c & 31, ob = rr * 64 + cc * 2; return st * 1024 + (ob ^ (((ob >> 9) & 1) << 5)); }
__host__ __device__ __forceinline__ void stage_rc(int b, int& R, int& C) { const int st = b / 1024, sb = b % 1024, swz = sb ^ (((sb >> 9) & 1) << 5); R = (st >> 1) * 16 + swz / 64; C = (st & 1) * 32 + (swz % 64) / 2; }
__host__ __device__ __forceinline__ int perm32(int rho) { const int n = rho >> 4, i = rho & 15; return 8 * (i >> 2) + 4 * n + (i & 3); }

struct Unit { int pm, pn; };
struct Gemm { const bf16_t* A; const bf16_t* Bt; int M, N, K; };

struct StaticOrder {
    int nM, nN, nwg, G, c;
    __host__ __device__ void init(int M, int N, int G_, int c_) { nM = M / BM; nN = N / BM; nwg = nM * nN; G = G_; c = c_; }
    __host__ __device__ bool next(int i, Unit& u) const {
        const long L = (long)i * G + c; if (L >= nwg) return false;
        int wgid = (int)L; { const int q = nwg / NXCD, r = nwg % NXCD, xcd = wgid % NXCD, off = wgid / NXCD; wgid = (xcd < r ? xcd * (q + 1) : r * (q + 1) + (xcd - r) * q) + off; }
        const int nig = WGM * nN, gid = wgid / nig, fm = gid * WGM, gsz = (nM - fm) < WGM ? (nM - fm) : WGM;
        u.pm = fm + ((wgid % nig) % gsz); u.pn = (wgid % nig) / gsz; return true;
    }
    __device__ __forceinline__ void a_ready(const Unit&) const {}
    __device__ __forceinline__ void done(const Unit&) const {}
};

__device__ __forceinline__ unsigned cvt_pk_bf16(float lo, float hi) { unsigned r; asm volatile("v_cvt_pk_bf16_f32 %0, %1, %2" : "=v"(r) : "v"(lo), "v"(hi)); return r; }
__device__ __forceinline__ float bf_lo(unsigned w) { return __uint_as_float(w << 16); }
__device__ __forceinline__ float bf_hi(unsigned w) { return __uint_as_float(w & 0xffff0000u); }
__device__ __forceinline__ float fsigmoid(float x) { return __builtin_amdgcn_rcpf(1.0f + __expf(-x)); }
__device__ __forceinline__ float fsilu(float x) { return x * fsigmoid(x); }
__device__ __forceinline__ f32x4 act4(f32x4 v, int act) {
    if (act == 1) { v[0] = fsilu(v[0]); v[1] = fsilu(v[1]); v[2] = fsilu(v[2]); v[3] = fsilu(v[3]); }
    else if (act == 2) { v[0] = fsigmoid(v[0]); v[1] = fsigmoid(v[1]); v[2] = fsigmoid(v[2]); v[3] = fsigmoid(v[3]); }
    else if (act == 3) { v = v * 0.08838834764831845f; }
    return v;
}
struct EpiIn {
    static constexpr bool PERM = true, AFTER_DRAIN = false;
    bf16_t *QKV, *Z, *BQ, *BZ, *IQ, *GA, *GB, *IK; float *BETA, *GG, *IW; float* out; const float* a_log; const float* dt_bias;
    __device__ __forceinline__ void operator()(const f32x4 (&acc)[2][2][4][2], const Unit& u, int wr, int wc, int fr, int fq) const {
        const int pn = u.pn, row0 = u.pm * BM + wr * 64 + fr, cl = wc * 32 + 8 * fq;
        if (pn < 56 || (pn >= 58 && pn < 90)) {
            bf16_t* dst; int ldc, cbase, act;
            if (pn < 32) { dst = QKV; ldc = 8192; cbase = pn * 256; act = 0; }
            else if (pn < 48) { dst = Z; ldc = 4096; cbase = (pn - 32) * 256; act = 1; }
            else if (pn < 56) { dst = BQ; ldc = 2048; cbase = (pn - 48) * 256; act = 3; }
            else if (pn < 66) { dst = BZ; ldc = 2048; cbase = (pn - 58) * 256; act = 1; }
            else if (pn < 74) { dst = IQ; ldc = 2048; cbase = (pn - 66) * 256; act = 0; }
            else if (pn < 82) { dst = GA; ldc = 2048; cbase = (pn - 74) * 256; act = 2; }
            else { dst = GB; ldc = 2048; cbase = (pn - 82) * 256; act = 2; }
#pragma unroll
            for (int ai = 0; ai < 2; ++ai)
#pragma unroll
                for (int m = 0; m < 4; ++m) {
                    const int row = row0 + ai * HALF + m * 16;
                    bf16_t* rowp = dst + (size_t)row * ldc + cbase + cl;
                    float* tail = nullptr;
                    if (pn < 32) {
                        if (row < MP) { const int t = row & (LP - 1); if (t >= LP - 3) tail = out + O_CP + ((size_t)(row >> 11) * 3 + (t - (LP - 3))) * CONVCH + cbase + cl; }
                        else { const int rr = row - MP, t = rr & 7; if (t >= 5) tail = out + O_CS + ((size_t)(rr >> 3) * 3 + (t - 5)) * CONVCH + cbase + cl; }
                    }
#pragma unroll
                    for (int bj = 0; bj < 2; ++bj) {
                        f32x4 v0 = acc[ai][bj][m][0], v1 = acc[ai][bj][m][1];
                        if (tail) { *(f32x4*)(tail + bj * HALF) = v0; *(f32x4*)(tail + bj * HALF + 4) = v1; }
                        v0 = act4(v0, act); v1 = act4(v1, act);
                        u32x4 w; w.x = cvt_pk_bf16(v0[0], v0[1]); w.y = cvt_pk_bf16(v0[2], v0[3]); w.z = cvt_pk_bf16(v1[0], v1[1]); w.w = cvt_pk_bf16(v1[2], v1[3]);
                        *(u32x4*)(rowp + bj * HALF) = w;
                    }
                }
        } else if (pn < 58) {
#pragma unroll
            for (int ai = 0; ai < 2; ++ai)
#pragma unroll
                for (int m = 0; m < 4; ++m) {
                    const int row = row0 + ai * HALF + m * 16;
                    float* rowp = out + (row < MP ? (pn == 56 ? O_KP : O_VP) + (size_t)row * 256 : (pn == 56 ? O_KS : O_VS) + (size_t)(row - MP) * 256) + cl;
#pragma unroll
                    for (int bj = 0; bj < 2; ++bj) { *(f32x4*)(rowp + bj * HALF) = acc[ai][bj][m][0]; *(f32x4*)(rowp + bj * HALF + 4) = acc[ai][bj][m][1]; }
                }
        } else {
#pragma unroll
            for (int ai = 0; ai < 2; ++ai)
#pragma unroll
                for (int m = 0; m < 4; ++m) {
                    const int row = row0 + ai * HALF + m * 16;
                    {
                        const f32x4 v0 = acc[ai][0][m][0], v1 = acc[ai][0][m][1];
                        float* o = out + (row < MP ? O_KIP + (size_t)row * 128 : O_KIS + (size_t)(row - MP) * 128) + cl;
                        *(f32x4*)o = v0; *(f32x4*)(o + 4) = v1;
                        u32x4 w; w.x = cvt_pk_bf16(v0[0], v0[1]); w.y = cvt_pk_bf16(v0[2], v0[3]); w.z = cvt_pk_bf16(v1[0], v1[1]); w.w = cvt_pk_bf16(v1[2], v1[3]);
                        *(u32x4*)(IK + (size_t)row * 128 + cl) = w;
                    }
                    {
                        f32x4 v0 = acc[ai][1][m][0], v1 = acc[ai][1][m][1];
                        if (wc == 0) {
                            float* o = BETA + (size_t)row * 32 + cl;
                            v0 = act4(v0, 2); v1 = act4(v1, 2); *(f32x4*)o = v0; *(f32x4*)(o + 4) = v1;
                        } else if (wc == 1) {
                            const int h0 = cl - 32; float* o = GG + (size_t)row * 32 + h0;
                            float r[8];
#pragma unroll
                            for (int e = 0; e < 8; ++e) { const float x = (e < 4 ? v0[e & 3] : v1[e & 3]) + dt_bias[h0 + e]; const float sp = fmaxf(x, 0.f) + log1pf(__expf(-fabsf(x))); r[e] = -__expf(a_log[h0 + e]) * sp; }
                            *(f32x4*)o = (f32x4){r[0], r[1], r[2], r[3]}; *(f32x4*)(o + 4) = (f32x4){r[4], r[5], r[6], r[7]};
                        } else if (wc == 2 && fq < 2) {
                            float* o = IW + (size_t)row * 16 + (cl - 64);
                            *(f32x4*)o = v0; *(f32x4*)(o + 4) = v1;
                        }
                    }
                }
        }
    }
};
struct EpiM1 {
    static constexpr bool PERM = true, AFTER_DRAIN = false;
    const bf16_t* GA; float* TMP;
    __device__ __forceinline__ void operator()(const f32x4 (&acc)[2][2][4][2], const Unit& u, int wr, int wc, int fr, int fq) const {
        const int row0 = u.pm * BM + wr * 64 + fr, col0 = u.pn * BM + wc * 32 + 8 * fq;
#pragma unroll
        for (int ai = 0; ai < 2; ++ai)
#pragma unroll
            for (int m = 0; m < 4; ++m) { const size_t off = (size_t)(row0 + ai * HALF + m * 16) * D + col0;
#pragma unroll
                for (int bj = 0; bj < 2; ++bj) { const u32x4 gw = *(const u32x4*)(GA + off + bj * HALF); const f32x4 v0 = acc[ai][bj][m][0], v1 = acc[ai][bj][m][1];
                    *(f32x4*)(TMP + off + bj * HALF) = (f32x4){v0[0] * bf_lo(gw.x), v0[1] * bf_hi(gw.x), v0[2] * bf_lo(gw.y), v0[3] * bf_hi(gw.y)};
                    *(f32x4*)(TMP + off + bj * HALF + 4) = (f32x4){v1[0] * bf_lo(gw.z), v1[1] * bf_hi(gw.z), v1[2] * bf_lo(gw.w), v1[3] * bf_hi(gw.w)}; } }
    }
};
struct EpiM2 {
    static constexpr bool PERM = true, AFTER_DRAIN = false;
    const bf16_t* GB; const float* TMP; bf16_t* MG;
    __device__ __forceinline__ void operator()(const f32x4 (&acc)[2][2][4][2], const Unit& u, int wr, int wc, int fr, int fq) const {
        const int row0 = u.pm * BM + wr * 64 + fr, col0 = u.pn * BM + wc * 32 + 8 * fq;
#pragma unroll
        for (int ai = 0; ai < 2; ++ai)
#pragma unroll
            for (int m = 0; m < 4; ++m) { const size_t off = (size_t)(row0 + ai * HALF + m * 16) * D + col0;
#pragma unroll
                for (int bj = 0; bj < 2; ++bj) { const u32x4 gw = *(const u32x4*)(GB + off + bj * HALF); const f32x4 v0 = acc[ai][bj][m][0], v1 = acc[ai][bj][m][1];
                    const f32x4 t0 = *(const f32x4*)(TMP + off + bj * HALF), t1 = *(const f32x4*)(TMP + off + bj * HALF + 4);
                    u32x4 w; w.x = cvt_pk_bf16(t0[0] + v0[0] * bf_lo(gw.x), t0[1] + v0[1] * bf_hi(gw.x)); w.y = cvt_pk_bf16(t0[2] + v0[2] * bf_lo(gw.y), t0[3] + v0[3] * bf_hi(gw.y));
                    w.z = cvt_pk_bf16(t1[0] + v1[0] * bf_lo(gw.z), t1[1] + v1[1] * bf_hi(gw.z)); w.w = cvt_pk_bf16(t1[2] + v1[2] * bf_lo(gw.w), t1[3] + v1[3] * bf_hi(gw.w));
                    *(u32x4*)(MG + off + bj * HALF) = w; } }
    }
};
struct EpiF32P {
    static constexpr bool PERM = true, AFTER_DRAIN = false;
    float* C; int ldc;
    __device__ __forceinline__ void operator()(const f32x4 (&acc)[2][2][4][2], const Unit& u, int wr, int wc, int fr, int fq) const {
        const int row0 = u.pm * BM + wr * 64 + fr, col0 = u.pn * BM + wc * 32 + 8 * fq;
#pragma unroll
        for (int ai = 0; ai < 2; ++ai)
#pragma unroll
            for (int m = 0; m < 4; ++m) { float* rowp = C + (size_t)(row0 + ai * HALF + m * 16) * ldc + col0;
#pragma unroll
                for (int bj = 0; bj < 2; ++bj) { *(f32x4*)(rowp + bj * HALF) = acc[ai][bj][m][0]; *(f32x4*)(rowp + bj * HALF + 4) = acc[ai][bj][m][1]; } }
    }
};
template <class Epi, class Sched, bool ALIGN_EPI = false, bool SP2 = false>
__device__ __forceinline__ void gemm_phase(PG8_LAS unsigned char* lds, const Gemm g, const Sched& S, const Epi& E) {
    const int tid = threadIdx.x, wid = __builtin_amdgcn_readfirstlane(tid >> 6), lane = tid & 63, wr = wid >> 2, wc = wid & 3, fr = lane & 15, fq = lane >> 4;
    const int K = g.K, nt = K / BK;
    unsigned voffA[2], voffB[2];
#pragma unroll
    for (int i = 0; i < 2; ++i) { int R, C; stage_rc(tid * 16 + i * 8192, R, C); const int Rb = Epi::PERM ? ((R & ~31) + perm32(R & 31)) : R;
        voffA[i] = (unsigned)(R * K + C) * 2u; voffB[i] = (unsigned)(Rb * K + C) * 2u; }
    const size_t kstep = (size_t)(BK * 2);
    const size_t hstep = (size_t)HALF * K * 2;
    const size_t tstep = 2 * hstep;
    const unsigned ldsw = (unsigned)wid * 1024u;
    const int aoff = lds_byte(wr * 64 + fr, fq * 8), boff = lds_byte(wc * 32 + fr, fq * 8);
#define PG8_SA(b, h) (((b) * 2 + (h)) * HTB)
#define PG8_SB(b, h) ((4 + (b) * 2 + (h)) * HTB)
#define PG8_STAGE(bufoff, gbase, voff) do { _Pragma("unroll") for (int _i = 0; _i < 2; ++_i) \
        __builtin_amdgcn_global_load_lds((const unsigned*)((const char*)(gbase) + (voff)[_i]), (PG8_LAS unsigned*)(lds + (bufoff) + ldsw + _i * 8192), 16, 0, 0); } while (0)
#define PG8_LDA(dst, b, h) do { _Pragma("unroll") for (int m = 0; m < 4; ++m) _Pragma("unroll") for (int k = 0; k < 2; ++k) dst[m][k] = *(const PG8_LAS bf16x8*)(lds + PG8_SA(b, h) + aoff + m * 2048 + k * 1024); } while (0)
#define PG8_LDB(dst, b, h) do { _Pragma("unroll") for (int n = 0; n < 2; ++n) _Pragma("unroll") for (int k = 0; k < 2; ++k) dst[n][k] = *(const PG8_LAS bf16x8*)(lds + PG8_SB(b, h) + boff + n * 2048 + k * 1024); } while (0)
#define PG8_MMA(ai, bj, At, Bt) do { __builtin_amdgcn_s_setprio(1); _Pragma("unroll") for (int m = 0; m < 4; ++m) _Pragma("unroll") for (int n = 0; n < 2; ++n) _Pragma("unroll") for (int k = 0; k < 2; ++k) \
        acc[ai][bj][m][n] = __builtin_amdgcn_mfma_f32_16x16x32_bf16(Bt[n][k], At[m][k], acc[ai][bj][m][n], 0, 0, 0); __builtin_amdgcn_s_setprio(0); } while (0)
#define PG8_WAIT_V(n) asm volatile("s_waitcnt vmcnt(" #n ")" ::: "memory")
#define PG8_WAIT_L(n) asm volatile("s_waitcnt lgkmcnt(" #n ")" ::: "memory")
#define PG8_BAR __builtin_amdgcn_s_barrier()
#define PG8_SCHED __builtin_amdgcn_sched_barrier(0)
    Unit cur, nxt; int ui = 0;
    if (!S.next(0, cur)) return;
    f32x4 acc[2][2][4][2];
#pragma unroll
    for (int a = 0; a < 2; ++a)
#pragma unroll
        for (int b = 0; b < 2; ++b)
#pragma unroll
            for (int m = 0; m < 4; ++m)
#pragma unroll
                for (int n = 0; n < 2; ++n) acc[a][b][m][n] = (f32x4){0.f, 0.f, 0.f, 0.f};
    bf16x8 At[4][2], B0[2][2], B1[2][2];
    const char* cA = (const char*)g.A + (size_t)cur.pm * tstep; const char* cB = (const char*)g.Bt + (size_t)cur.pn * tstep;
    S.a_ready(cur);
    if constexpr (SP2) {
        PG8_STAGE(PG8_SB(0, 0), cB, voffB); PG8_STAGE(PG8_SB(0, 1), cB + hstep, voffB); PG8_STAGE(PG8_SA(0, 0), cA, voffA); PG8_STAGE(PG8_SA(0, 1), cA + hstep, voffA);
        if (wr == 1) PG8_BAR;
        PG8_WAIT_V(2); PG8_BAR;
        PG8_STAGE(PG8_SB(1, 0), cB + kstep, voffB); PG8_STAGE(PG8_SA(1, 0), cA + kstep, voffA); PG8_STAGE(PG8_SB(1, 1), cB + hstep + kstep, voffB);
        PG8_WAIT_V(6); PG8_BAR;
    } else {
        PG8_STAGE(PG8_SB(0, 0), cB, voffB); PG8_STAGE(PG8_SA(0, 0), cA, voffA); PG8_STAGE(PG8_SB(0, 1), cB + hstep, voffB); PG8_STAGE(PG8_SA(0, 1), cA + hstep, voffA);
        if (wr == 1) PG8_BAR;
        PG8_WAIT_V(4); PG8_BAR;
        PG8_STAGE(PG8_SB(1, 0), cB + kstep, voffB); PG8_STAGE(PG8_SA(1, 0), cA + kstep, voffA); PG8_STAGE(PG8_SB(1, 1), cB + hstep + kstep, voffB);
        PG8_WAIT_V(6); PG8_BAR;
    }
    for (;;) {
        const bool has_next = S.next(ui + 1, nxt);
        const char* nA = has_next ? (const char*)g.A + (size_t)nxt.pm * tstep : cA; const char* nB = has_next ? (const char*)g.Bt + (size_t)nxt.pn * tstep : cB;
        for (int t = 0; t < nt; t += 2) {
            const bool last = (t == nt - 2);
            const char* a1 = cA + (size_t)(t + 1) * kstep;
            const char* a2 = last ? nA : cA + (size_t)(t + 2) * kstep; const char* b2 = last ? nB : cB + (size_t)(t + 2) * kstep;
            const char* a3 = a2 + kstep; const char* b3 = b2 + kstep;
            if (last && has_next) S.a_ready(nxt);
            if constexpr (SP2) {
            PG8_LDB(B0, 0, 0); PG8_LDB(B1, 0, 1); PG8_SCHED; PG8_LDA(At, 0, 0); PG8_STAGE(PG8_SA(1, 1), a1 + hstep, voffA);
            PG8_WAIT_V(8); PG8_WAIT_L(0); PG8_BAR; PG8_MMA(0, 0, At, B0); PG8_MMA(0, 1, At, B1); PG8_BAR; PG8_SCHED;
            PG8_LDA(At, 0, 1); PG8_STAGE(PG8_SB(0, 0), b2, voffB); PG8_STAGE(PG8_SB(0, 1), b2 + hstep, voffB); PG8_STAGE(PG8_SA(0, 0), a2, voffA);
            PG8_WAIT_V(8); PG8_WAIT_L(0); PG8_BAR; PG8_MMA(1, 0, At, B0); PG8_MMA(1, 1, At, B1); PG8_BAR; PG8_SCHED;
            PG8_LDB(B0, 1, 0); PG8_LDB(B1, 1, 1); PG8_SCHED; PG8_LDA(At, 1, 0); PG8_STAGE(PG8_SA(0, 1), a2 + hstep, voffA);
            PG8_WAIT_V(8); PG8_WAIT_L(0); PG8_BAR; PG8_MMA(0, 0, At, B0); PG8_MMA(0, 1, At, B1); PG8_BAR; PG8_SCHED;
            PG8_LDA(At, 1, 1); PG8_STAGE(PG8_SB(1, 0), b3, voffB); PG8_STAGE(PG8_SB(1, 1), b3 + hstep, voffB); PG8_STAGE(PG8_SA(1, 0), a3, voffA);
            PG8_WAIT_V(8); PG8_WAIT_L(0); PG8_BAR; PG8_MMA(1, 0, At, B0); PG8_MMA(1, 1, At, B1); PG8_BAR; PG8_SCHED;
            } else {
            PG8_LDB(B0, 0, 0); PG8_SCHED; PG8_LDA(At, 0, 0); PG8_STAGE(PG8_SA(1, 1), a1 + hstep, voffA);
            PG8_WAIT_L(8); PG8_BAR; PG8_WAIT_L(0); PG8_MMA(0, 0, At, B0); PG8_BAR; PG8_SCHED;
            PG8_LDB(B1, 0, 1); PG8_STAGE(PG8_SB(0, 0), b2, voffB);
            PG8_BAR; PG8_WAIT_L(0); PG8_MMA(0, 1, At, B1); PG8_BAR;
            PG8_LDA(At, 0, 1); PG8_STAGE(PG8_SA(0, 0), a2, voffA);
            PG8_BAR; PG8_WAIT_L(0); PG8_MMA(1, 0, At, B0); PG8_BAR; PG8_SCHED;
            PG8_STAGE(PG8_SB(0, 1), b2 + hstep, voffB);
            PG8_WAIT_V(6); PG8_BAR; PG8_MMA(1, 1, At, B1); PG8_BAR;
            PG8_LDB(B0, 1, 0); PG8_SCHED; PG8_LDA(At, 1, 0); PG8_STAGE(PG8_SA(0, 1), a2 + hstep, voffA);
            PG8_WAIT_L(8); PG8_BAR; PG8_WAIT_L(0); PG8_MMA(0, 0, At, B0); PG8_BAR; PG8_SCHED;
            PG8_LDB(B1, 1, 1); PG8_STAGE(PG8_SB(1, 0), b3, voffB);
            PG8_BAR; PG8_WAIT_L(0); PG8_MMA(0, 1, At, B1); PG8_BAR;
            PG8_LDA(At, 1, 1); PG8_STAGE(PG8_SA(1, 0), a3, voffA);
            PG8_BAR; PG8_WAIT_L(0); PG8_MMA(1, 0, At, B0); PG8_BAR; PG8_SCHED;
            PG8_STAGE(PG8_SB(1, 1), b3 + hstep, voffB);
            PG8_WAIT_V(6); PG8_BAR; PG8_MMA(1, 1, At, B1); PG8_BAR;
            }
        }
        if constexpr (ALIGN_EPI) { if (wr == 0) PG8_BAR; }
        if constexpr (!Epi::AFTER_DRAIN) { E(acc, cur, wr, wc, fr, fq); S.done(cur); }
        if (!has_next) break;
#pragma unroll
        for (int a = 0; a < 2; ++a)
#pragma unroll
            for (int b = 0; b < 2; ++b)
#pragma unroll
                for (int m = 0; m < 4; ++m)
#pragma unroll
                    for (int n = 0; n < 2; ++n) acc[a][b][m][n] = (f32x4){0.f, 0.f, 0.f, 0.f};
        cur = nxt; cA = nA; cB = nB; ++ui;
        if constexpr (ALIGN_EPI) { if (wr == 1) PG8_BAR; }
    }
    PG8_WAIT_V(0);
    if constexpr (!ALIGN_EPI) { if (wr == 0) PG8_BAR; }
    PG8_BAR;
    if constexpr (Epi::AFTER_DRAIN) { E.fused(acc, cur, wr, wc, fr, fq, lds, wid, lane); S.done(cur); }
#undef PG8_SA
#undef PG8_SB
#undef PG8_STAGE
#undef PG8_LDA
#undef PG8_LDB
#undef PG8_MMA
#undef PG8_WAIT_V
#undef PG8_WAIT_L
#undef PG8_BAR
#undef PG8_SCHED
}
}
#ifndef MK_ONE_LAUNCH
#define MK_ONE_LAUNCH 0
#endif
constexpr int NWAVES = 8, NTHREADS = NWAVES * 64;
constexpr int N_PHASES = 11;
constexpr size_t MiB = 1u << 20;
constexpr size_t WS_CTL = 0, CTL_ZERO_BYTES = 2 * MiB;
constexpr size_t WS_MOD = 1 * MiB;
constexpr size_t WS_WIN = 2 * MiB;
constexpr size_t WS_WPA = 94 * MiB;
constexpr size_t WS_WPB = 110 * MiB;
constexpr size_t WS_WOUT = 118 * MiB;
constexpr size_t WS_H = 126 * MiB;
constexpr size_t WS_QKV = 159 * MiB;
constexpr size_t WS_Z = 291 * MiB;
constexpr size_t WS_BQ = 357 * MiB;
constexpr size_t WS_BZ = 390 * MiB;
constexpr size_t WS_IQ = 423 * MiB;
constexpr size_t WS_GA = 456 * MiB, WS_GB = 489 * MiB;
constexpr size_t WS_IK = 522 * MiB;
constexpr size_t WS_BETA = 525 * MiB, WS_GG = 527 * MiB, WS_IW = 529 * MiB;
constexpr size_t WS_YA = 530 * MiB;
constexpr size_t WS_YB = 596 * MiB;
constexpr size_t WS_SC = 629 * MiB;
constexpr size_t WS_SCS = 693 * MiB;
constexpr size_t WS_SEL = 702 * MiB;
constexpr size_t WS_CNT = 711 * MiB;
constexpr size_t WS_TMP = 712 * MiB;
constexpr size_t WS_MG = 778 * MiB;
constexpr size_t WS_OUTF = 811 * MiB;
constexpr size_t WS_END = 877 * MiB;
static_assert(WS_WIN + (size_t)NPAD * D * 2 <= WS_WPA && WS_H + (size_t)MROWS * D * 2 <= WS_QKV && WS_QKV + (size_t)MROWS * 8192 * 2 <= WS_Z && WS_Z + (size_t)MROWS * 4096 * 2 <= WS_BQ, "ws map");
static_assert(WS_SC + (size_t)MP * 2048 * 4 <= WS_SCS && WS_SCS + (size_t)MS * SCS_LD * 4 <= WS_SEL && WS_SEL + (size_t)MROWS * 256 * 4 <= WS_CNT && WS_TMP + (size_t)MROWS * D * 4 <= WS_MG && WS_OUTF + (size_t)MROWS * D * 4 <= WS_END, "ws map 2");
constexpr int CW_BAR = 4096;
constexpr int RING_BYTES = 131072;
constexpr int LDSCTL_OFF = RING_BYTES, MISC_OFF = LDSCTL_OFF + 320;
constexpr int LDS_BYTES = 147456;

#define GAS __attribute__((address_space(1)))
#define LAS __attribute__((address_space(3)))
typedef unsigned short bf16;
typedef unsigned v4u __attribute__((ext_vector_type(4)));
typedef unsigned v2u __attribute__((ext_vector_type(2)));
typedef float f32x4 __attribute__((ext_vector_type(4)));
typedef short bf16x8 __attribute__((ext_vector_type(8)));
typedef short s16x4 __attribute__((ext_vector_type(4)));
typedef GAS unsigned gu32;
#define LDS_WAIT() asm volatile("s_waitcnt lgkmcnt(0)" ::: "memory")
#define VM_WAIT() asm volatile("s_waitcnt vmcnt(0)" ::: "memory")
__device__ __forceinline__ float bf2f(bf16 v) { return __uint_as_float(((unsigned)v) << 16); }
__device__ __forceinline__ unsigned pk2(float lo, float hi) { return pg8::cvt_pk_bf16(lo, hi); }
__device__ __forceinline__ bf16 f2bf(float f) { return (bf16)(pg8::cvt_pk_bf16(f, 0.f) & 0xffffu); }
__device__ __forceinline__ float wave_sum(float v) {
#pragma unroll
    for (int o = 1; o < 64; o <<= 1) v += __shfl_xor(v, o);
    return v;
}
__device__ __forceinline__ int wave_sum_i(int v) {
#pragma unroll
    for (int o = 1; o < 64; o <<= 1) v += __shfl_xor(v, o);
    return v;
}

#define XB_TMO      128
#define XB_XCNT(j)  (256  + 64 * (j))
#define XB_XSUB(j)  (1280 + 64 * (j))
#define XB_XGEN(j)  (2304 + 64 * (j))
#define XB_TOP      3328
#define XB_TOPGEN   3392
#define XCD_BAR_WORDS 3456
#define XB_SPIN_CAP (1u << 18)
__device__ __forceinline__ unsigned xb_ld(unsigned* p)              { return __hip_atomic_load(p, __ATOMIC_RELAXED, __HIP_MEMORY_SCOPE_AGENT); }
__device__ __forceinline__ unsigned xb_add(unsigned* p, unsigned v) { return __hip_atomic_fetch_add(p, v, __ATOMIC_RELAXED, __HIP_MEMORY_SCOPE_AGENT); }
__device__ __forceinline__ unsigned xb_xcc_id() { return (unsigned)__builtin_amdgcn_s_getreg((3 << 11) | 20) & 0xFu; }
#define XB_SPIN(cond, bar) do { unsigned _sp = 0; while (cond) { __builtin_amdgcn_s_sleep(1); \
    if ((++_sp & 255u) == 0u) { if (xb_ld(&(bar)[XB_TMO])) break; if (_sp > XB_SPIN_CAP) { atomicAdd(&(bar)[XB_TMO], 1u); break; } } } } while (0)
struct XcdBarrier { unsigned* bar; unsigned x; volatile LAS unsigned* st; };
__device__ __forceinline__ XcdBarrier xcd_barrier_post(unsigned* bar, volatile LAS unsigned* st) {
    XcdBarrier b; b.bar = bar; b.x = xb_xcc_id(); b.st = st;
    if (threadIdx.x == 0) (void)xb_add(&bar[XB_XCNT(b.x)], 1u);
    return b;
}
__device__ __forceinline__ void xcd_barrier_complete(unsigned* bar, unsigned x, unsigned& nloc, unsigned& nx) {
    const unsigned G = gridDim.x * gridDim.y * gridDim.z;
    unsigned sum, cnt, mine, sp = 0u;
    for (;;) {
        sum = 0u; cnt = 0u; mine = 0u;
#pragma unroll
        for (unsigned j = 0; j < 16; ++j) { const unsigned c = xb_ld(&bar[XB_XCNT(j)]); sum += c; cnt += (c > 0u) ? 1u : 0u; mine = (j == x) ? c : mine; }
        if (sum == G) break;
        __builtin_amdgcn_s_sleep(1);
        if ((++sp & 255u) == 0u) { if (xb_ld(&bar[XB_TMO])) break; if (sp > XB_SPIN_CAP) { atomicAdd(&bar[XB_TMO], 1u); break; } }
    }
    nloc = mine > 0u ? mine : 1u; nx = cnt > 0u ? cnt : 1u;
}
__device__ __forceinline__ void xcd_barrier(const XcdBarrier& b) {
    asm volatile("s_waitcnt vmcnt(0)" ::: "memory");
    __syncthreads();
    if (threadIdx.x == 0) {
        unsigned* bar = b.bar;
        __builtin_amdgcn_s_waitcnt(0);
        unsigned nloc = b.st[0], nx = b.st[1];
        if (nloc == 0u) { xcd_barrier_complete(bar, b.x, nloc, nx); b.st[0] = nloc; b.st[1] = nx; }
        const unsigned old = xb_add(&bar[XB_XSUB(b.x)], 1u);
        const unsigned gen = old / nloc;
        if (old + 1u == (gen + 1u) * nloc) {
            __builtin_amdgcn_fence(__ATOMIC_RELEASE, "agent");
            asm volatile("s_waitcnt vmcnt(0)" ::: "memory");
            const unsigned og = xb_add(&bar[XB_TOP], 1u);
            const unsigned tg = og / nx;
            if (og + 1u == (tg + 1u) * nx) xb_add(&bar[XB_TOPGEN], 1u);
            else XB_SPIN(xb_ld(&bar[XB_TOPGEN]) == tg, bar);
            __builtin_amdgcn_fence(__ATOMIC_ACQUIRE, "agent");
            xb_add(&bar[XB_XGEN(b.x)], 1u);
            asm volatile("s_waitcnt vmcnt(0)" ::: "memory");
        } else {
            XB_SPIN(xb_ld(&bar[XB_XGEN(b.x)]) == gen, bar);
            __builtin_amdgcn_fence(__ATOMIC_ACQUIRE, "agent");
            asm volatile("s_waitcnt vmcnt(0)" ::: "memory");
        }
    }
    __syncthreads();
}

struct Args {
    const float *x_p, *x_s, *c_p, *c_s, *cache_k, *cache_v, *cache_kidx, *state_gdn, *state_conv; const int* page_table;
    const float *w_ada, *b_ada, *pre_g, *w_in, *conv_w, *a_log, *dt_bias, *gdn_g, *w_pa, *w_pb, *w_out, *post_g;
    float* out; unsigned char* ws; int ph_lo, ph_hi;
};
static_assert(sizeof(Args) == 24 * 8 + 8, "Args has no padding");

__device__ __forceinline__ void transpose_item(const float* W, int Nsrc, int K, bf16* WT, int n0, int k0, bool remap, LAS float* scr, int lane) {
    const int nl = lane & 31, nd = n0 + nl, sc = remap ? win_src_col(nd) : nd;
#pragma unroll 8
    for (int i = 0; i < 32; ++i) { const int kk = 2 * i + (lane >> 5); float v = 0.f; if (sc >= 0) v = W[(size_t)(k0 + kk) * Nsrc + sc]; scr[kk * 33 + nl] = v; }
    LDS_WAIT(); asm volatile("" ::: "memory");
    const int c = lane & 7;
#pragma unroll
    for (int j = 0; j < 4; ++j) { const int n = (lane >> 3) + 8 * j; const LAS float* s = scr + (8 * c) * 33 + n;
        v4u o; o.x = pk2(s[0 * 33], s[1 * 33]); o.y = pk2(s[2 * 33], s[3 * 33]); o.z = pk2(s[4 * 33], s[5 * 33]); o.w = pk2(s[6 * 33], s[7 * 33]);
        *(GAS v4u*)(WT + (size_t)(n0 + n) * K + k0 + 8 * c) = o; }
    LDS_WAIT(); asm volatile("" ::: "memory");
}
__device__ __forceinline__ void mod_item(const Args& a, float* mod, int item, LAS float* scr, int lane) {
    const int kc = item / 96, cg = item % 96, col = cg * 64 + lane;
    float acc[36];
#pragma unroll
    for (int r = 0; r < 36; ++r) acc[r] = 0.f;
    for (int sub = 0; sub < 4; ++sub) {
        const int kb = kc * 256 + sub * 64;
#pragma unroll 4
        for (int r = 0; r < 36; ++r) { const float cv = (r < 4) ? a.c_p[r * D + kb + lane] : a.c_s[(r - 4) * D + kb + lane]; scr[r * 64 + lane] = cv * __builtin_amdgcn_rcpf(1.0f + __expf(-cv)); }
        LDS_WAIT(); asm volatile("" ::: "memory");
        for (int k4 = 0; k4 < 16; ++k4) {
            const float* wp = a.w_ada + (size_t)(kb + 4 * k4) * 6144 + col;
            const float w0 = wp[0], w1 = wp[6144], w2 = wp[2 * 6144], w3 = wp[3 * 6144];
#pragma unroll
            for (int r = 0; r < 36; ++r) { const f32x4 s = *(const LAS f32x4*)(scr + r * 64 + 4 * k4); acc[r] += s[0] * w0 + s[1] * w1 + s[2] * w2 + s[3] * w3; }
        }
        LDS_WAIT(); asm volatile("" ::: "memory");
    }
#pragma unroll
    for (int r = 0; r < 36; ++r) unsafeAtomicAdd(mod + r * 6144 + col, acc[r]);
}

constexpr int TC = 32;
__device__ __forceinline__ void gdn_unit(const Args& a, LAS float* L, int u) {
    const int tid = threadIdx.x, lane = tid & 63, wave = tid >> 6;
    const bool sample = u >= BP * HV;
    int b, h, Lr, row0;
    if (!sample) { b = u >> 5; h = u & 31; Lr = LP; row0 = b * LP; } else { const int v = u - BP * HV; b = v >> 5; h = v & 31; Lr = LS; row0 = MP + b * LS; }
    const int hq = h >> 1, dv = tid & 127, dkg = tid >> 7;
    const bf16* QKV = (const bf16*)(a.ws + WS_QKV); const bf16* Z = (const bf16*)(a.ws + WS_Z); bf16* YA = (bf16*)(a.ws + WS_YA);
    const float* BETA = (const float*)(a.ws + WS_BETA); const float* GG = (const float*)(a.ws + WS_GG);
    LAS float* qs = L; LAS float* ks = L + TC * 128; LAS float* vs = L + 2 * TC * 128; LAS float* opart = L + 3 * TC * 128; LAS float* part = opart + TC * 4 * 128; LAS float* at = part + 2 * 4 * 128; LAS float* bt = at + TC;
    float S[32];
    if (sample) {
        const float* s0 = a.state_gdn + ((size_t)(b * HV + h) * DK + 32 * dkg) * DV + dv;
#pragma unroll
        for (int i = 0; i < 32; ++i) S[i] = s0[(size_t)i * DV];
    } else {
#pragma unroll
        for (int i = 0; i < 32; ++i) S[i] = 0.f;
    }
    const int grp = dkg;
    const int ch = grp == 0 ? hq * 128 + dv : (grp == 1 ? 2048 + hq * 128 + dv : 4096 + h * 128 + dv);
    const float cw0 = a.conv_w[ch], cw1 = a.conv_w[CONVCH + ch], cw2 = a.conv_w[2 * CONVCH + ch], cw3 = a.conv_w[3 * CONVCH + ch];
    float x0 = 0.f, x1 = 0.f, x2 = 0.f;
    if (sample) { const float* cb = a.state_conv + (size_t)b * 3 * CONVCH + ch; x0 = cb[0]; x1 = cb[CONVCH]; x2 = cb[2 * CONVCH]; }
    const float gnorm0 = a.gdn_g[lane], gnorm1 = a.gdn_g[lane + 64];
    for (int t0 = 0; t0 < Lr; t0 += TC) {
        const int nt = (Lr - t0) < TC ? (Lr - t0) : TC;
        if (grp < 3) {
            LAS float* dst = L + grp * TC * 128 + dv;
            for (int tt = 0; tt < nt; ++tt) {
                const float xn = bf2f(QKV[(size_t)(row0 + t0 + tt) * CONVCH + ch]);
                float y = cw0 * x0 + cw1 * x1 + cw2 * x2 + cw3 * xn; x0 = x1; x1 = x2; x2 = xn;
                y = y * __builtin_amdgcn_rcpf(1.0f + __expf(-y));
                dst[tt * 128] = y;
            }
        }
        if (tid < nt) { at[tid] = __expf(GG[(size_t)(row0 + t0 + tid) * 32 + h]); bt[tid] = BETA[(size_t)(row0 + t0 + tid) * 32 + h]; }
        __syncthreads();
        for (int tt = wave; tt < nt; tt += NWAVES) {
#pragma unroll
            for (int gk = 0; gk < 2; ++gk) { LAS float* p = L + gk * TC * 128 + tt * 128; const float a0 = p[lane], a1 = p[lane + 64];
                const float rs = rsqrtf(wave_sum(a0 * a0 + a1 * a1) + L2_EPS) * (gk == 0 ? 0.08838834764831845f : 1.0f); p[lane] = a0 * rs; p[lane + 64] = a1 * rs; }
        }
        __syncthreads();
        for (int tt = 0; tt < nt; ++tt) {
            const float av = at[tt], bv = bt[tt];
            const LAS f32x4* kp = (const LAS f32x4*)(ks + tt * 128 + 32 * dkg);
            const LAS f32x4* qp = (const LAS f32x4*)(qs + tt * 128 + 32 * dkg);
            float p = 0.f;
#pragma unroll
            for (int i4 = 0; i4 < 8; ++i4) { const f32x4 k4 = kp[i4]; p += S[4 * i4] * k4[0] + S[4 * i4 + 1] * k4[1] + S[4 * i4 + 2] * k4[2] + S[4 * i4 + 3] * k4[3]; }
            LAS float* pb = part + (tt & 1) * 512;
            pb[dkg * 128 + dv] = p;
            __syncthreads();
            const float pt = (pb[dv] + pb[128 + dv]) + (pb[256 + dv] + pb[384 + dv]);
            const float dl = bv * (vs[tt * 128 + dv] - av * pt);
            float o = 0.f;
#pragma unroll
            for (int i4 = 0; i4 < 8; ++i4) { const f32x4 k4 = kp[i4], q4 = qp[i4];
#pragma unroll
                for (int e = 0; e < 4; ++e) { const float sn = av * S[4 * i4 + e] + k4[e] * dl; S[4 * i4 + e] = sn; o += sn * q4[e]; } }
            opart[(tt * 4 + dkg) * 128 + dv] = o;
        }
        __syncthreads();
        for (int tt = wave; tt < nt; tt += NWAVES) {
            const LAS float* op = opart + tt * 4 * 128;
            const float o0 = (op[lane] + op[128 + lane]) + (op[256 + lane] + op[384 + lane]);
            const float o1 = (op[64 + lane] + op[192 + lane]) + (op[320 + lane] + op[448 + lane]);
            const float rs = rsqrtf(wave_sum(o0 * o0 + o1 * o1) * (1.0f / 128.0f) + NORM_EPS);
            const size_t ro = (size_t)(row0 + t0 + tt) * 4096 + h * 128;
            YA[ro + lane] = f2bf(o0 * rs * gnorm0 * bf2f(Z[ro + lane]));
            YA[ro + lane + 64] = f2bf(o1 * rs * gnorm1 * bf2f(Z[ro + lane + 64]));
        }
        __syncthreads();
    }
    float* so = a.out + (sample ? O_GS : O_GP) + ((size_t)(b * HV + h) * DK + 32 * dkg) * DV + dv;
#pragma unroll
    for (int i = 0; i < 32; ++i) so[(size_t)i * DV] = S[i];
}

constexpr float IDX_SCALE = 0.08838834764831845f * 0.25f;
__device__ __forceinline__ void idx_prompt_item(const Args& a, int b, int j, int lane) {
    const bf16* IQ = (const bf16*)(a.ws + WS_IQ); const bf16* IK = (const bf16*)(a.ws + WS_IK); const float* IW = (const float*)(a.ws + WS_IW); float* SC = (float*)(a.ws + WS_SC);
    const int m = lane & 15, g = lane >> 4, rq = b * LP + 2 * j;
    bf16x8 afr[2][4]; f32x4 wv[2];
#pragma unroll
    for (int qq = 0; qq < 2; ++qq) {
#pragma unroll
        for (int s = 0; s < 4; ++s) afr[qq][s] = *(const bf16x8*)(IQ + (size_t)(rq + qq) * 2048 + m * 128 + 32 * s + 8 * g);
        wv[qq] = *(const f32x4*)(IW + (size_t)(rq + qq) * 16 + 4 * g);
    }
    const int nkt = (2 * j + 1) / 16 + 1;
    for (int kt = 0; kt < nkt; ++kt) {
        const int key = 16 * kt + m;
        bf16x8 bfr[4];
#pragma unroll
        for (int s = 0; s < 4; ++s) bfr[s] = *(const bf16x8*)(IK + (size_t)(b * LP + key) * 128 + 32 * s + 8 * g);
#pragma unroll
        for (int qq = 0; qq < 2; ++qq) {
            f32x4 acc = {0.f, 0.f, 0.f, 0.f};
#pragma unroll
            for (int s = 0; s < 4; ++s) acc = __builtin_amdgcn_mfma_f32_16x16x32_bf16(afr[qq][s], bfr[s], acc, 0, 0, 0);
            float v = fmaxf(acc[0], 0.f) * wv[qq][0] + fmaxf(acc[1], 0.f) * wv[qq][1] + fmaxf(acc[2], 0.f) * wv[qq][2] + fmaxf(acc[3], 0.f) * wv[qq][3];
            v += __shfl_xor(v, 16); v += __shfl_xor(v, 32);
            v *= IDX_SCALE;
            if (key > 2 * j + qq) v = -__builtin_inff();
            if (g == 0) SC[(size_t)(rq + qq) * 2048 + key] = v;
        }
    }
}
__device__ __forceinline__ void idx_sample_item(const Args& a, int b, int p, int lane) {
    const bf16* IQ = (const bf16*)(a.ws + WS_IQ); const bf16* IK = (const bf16*)(a.ws + WS_IK); const float* IW = (const float*)(a.ws + WS_IW); float* SCS = (float*)(a.ws + WS_SCS);
    const int m = lane & 15, g = lane >> 4;
    const float* kbase = nullptr;
    if (p < NPAGES) kbase = a.cache_kidx + (size_t)a.page_table[b * NPAGES + p] * PAGE * 128;
    for (int qh = 0; qh < 2; ++qh) {
        const int rq = MP + b * LS + qh * 4;
        bf16x8 afr[4][4]; f32x4 wv[4];
#pragma unroll
        for (int qq = 0; qq < 4; ++qq) {
#pragma unroll
            for (int s = 0; s < 4; ++s) afr[qq][s] = *(const bf16x8*)(IQ + (size_t)(rq + qq) * 2048 + m * 128 + 32 * s + 8 * g);
            wv[qq] = *(const f32x4*)(IW + (size_t)(rq + qq) * 16 + 4 * g);
        }
        const int nkt = p < NPAGES ? 8 : 1;
        for (int kt = 0; kt < nkt; ++kt) {
            bf16x8 bfr[4];
            if (p < NPAGES) {
                const float* kr = kbase + (size_t)(16 * kt + m) * 128 + 8 * g;
#pragma unroll
                for (int s = 0; s < 4; ++s) { const f32x4 f0 = *(const f32x4*)(kr + 32 * s), f1 = *(const f32x4*)(kr + 32 * s + 4);
                    v4u w; w.x = pk2(f0[0], f0[1]); w.y = pk2(f0[2], f0[3]); w.z = pk2(f1[0], f1[1]); w.w = pk2(f1[2], f1[3]); bfr[s] = __builtin_bit_cast(bf16x8, w); }
            } else {
                const int jr = m < LS ? m : LS - 1;
#pragma unroll
                for (int s = 0; s < 4; ++s) bfr[s] = *(const bf16x8*)(IK + (size_t)(MP + b * LS + jr) * 128 + 32 * s + 8 * g);
            }
#pragma unroll
            for (int qq = 0; qq < 4; ++qq) {
                f32x4 acc = {0.f, 0.f, 0.f, 0.f};
#pragma unroll
                for (int s = 0; s < 4; ++s) acc = __builtin_amdgcn_mfma_f32_16x16x32_bf16(afr[qq][s], bfr[s], acc, 0, 0, 0);
                float v = fmaxf(acc[0], 0.f) * wv[qq][0] + fmaxf(acc[1], 0.f) * wv[qq][1] + fmaxf(acc[2], 0.f) * wv[qq][2] + fmaxf(acc[3], 0.f) * wv[qq][3];
                v += __shfl_xor(v, 16); v += __shfl_xor(v, 32);
                v *= IDX_SCALE;
                float* srow = SCS + (size_t)(b * LS + qh * 4 + qq) * SCS_LD;
                if (p < NPAGES) { if (g == 0) srow[p * PAGE + 16 * kt + m] = v; }
                else { if (m > qh * 4 + qq) v = -__builtin_inff(); if (g == 0 && m < LS) srow[PAST + m] = v; }
            }
        }
    }
}

template <int NPL> __device__ __forceinline__ void topk_query(const float* sc, int n, int* sel, int* cnt, int lane) {
    if (n <= NTOPK) {
#pragma unroll
        for (int j = 0; j < NTOPK / 64; ++j) { const int i = j * 64 + lane; sel[i] = i < n ? i : 0; }
        if (lane == 0) *cnt = n;
        return;
    }
    unsigned key[NPL];
#pragma unroll
    for (int i = 0; i < NPL; ++i) { const int idx = i * 64 + lane; unsigned k = 0u;
        if (idx < n) { const unsigned uu = __float_as_uint(sc[idx]); k = (uu & 0x80000000u) ? ~uu : (uu | 0x80000000u); }
        key[i] = k; }
    unsigned tau = 0u;
    for (int bit = 31; bit >= 0; --bit) {
        const unsigned tr = tau | (1u << bit); int c = 0;
#pragma unroll
        for (int i = 0; i < NPL; ++i) c += (key[i] >= tr) ? 1 : 0;
        c = wave_sum_i(c);
        if (c >= NTOPK) tau = tr;
    }
    int base = 0;
#pragma unroll
    for (int i = 0; i < NPL; ++i) {
        const bool f = key[i] >= tau;
        const unsigned long long bal = __ballot(f);
        const int pos = base + __popcll(bal & ((1ull << lane) - 1ull));
        if (f && pos < NTOPK) sel[pos] = i * 64 + lane;
        base += __popcll(bal);
    }
    if (lane == 0) *cnt = base < NTOPK ? base : NTOPK;
}

__device__ __forceinline__ unsigned off_b(unsigned row, unsigned ch) { return 256u * row + 16u * (ch ^ (((row & 3) << 2) | ((row >> 2) & 3))); }
__device__ __forceinline__ unsigned tr_read_addr_16(unsigned lane, unsigned c, unsigned t) { const unsigned g = lane >> 4, q = (lane & 15) >> 2, p = lane & 3; return off_b(8 * g + 4 * t + q, 2 * c + (p >> 1)) + 8 * (p & 1); }
__device__ __forceinline__ s16x4 vtr(const LAS unsigned char* p) { return __builtin_bit_cast(s16x4, __builtin_amdgcn_ds_read_tr16_b64_v4i16((LAS s16x4*)p)); }
__device__ __forceinline__ const float* kv_row(const Args& a, bool isv, bool sample, int b, int key, int kvh) {
    if (!sample) return a.out + (isv ? O_VP : O_KP) + ((size_t)(b * LP + key) * 2 + kvh) * 128;
    if (key < PAST) { const int phys = a.page_table[b * NPAGES + (key >> 7)]; return (isv ? a.cache_v : a.cache_k) + (((size_t)phys * PAGE + (key & 127)) * 2 + kvh) * 128; }
    return a.out + (isv ? O_VS : O_KS) + ((size_t)(b * LS + (key - PAST)) * 2 + kvh) * 128;
}
__device__ __forceinline__ void attn_query(const Args& a, LAS unsigned char* wl, int row, int lane) {
    const bf16* BQ = (const bf16*)(a.ws + WS_BQ); const bf16* BZ = (const bf16*)(a.ws + WS_BZ); bf16* YB = (bf16*)(a.ws + WS_YB);
    const int* sel = (const int*)(a.ws + WS_SEL) + (size_t)row * NTOPK; const int cnt = ((const int*)(a.ws + WS_CNT))[row];
    const bool sample = row >= MP; const int b = sample ? (row - MP) >> 3 : row >> 11;
    const int m = lane & 15, g = lane >> 4;
    LAS unsigned char* Kb = wl; LAS unsigned char* Vb = wl + 8192;
    const int ntile = (cnt + 31) >> 5;
#pragma unroll 1
    for (int kvh = 0; kvh < 2; ++kvh) {
        bf16x8 qf[4];
#pragma unroll
        for (int s = 0; s < 4; ++s) { qf[s] = (bf16x8){0, 0, 0, 0, 0, 0, 0, 0}; if (m < 8) qf[s] = *(const bf16x8*)(BQ + (size_t)row * 2048 + (kvh * 8 + m) * 128 + 32 * s + 8 * g); }
        f32x4 o[8];
#pragma unroll
        for (int cc = 0; cc < 8; ++cc) o[cc] = (f32x4){0.f, 0.f, 0.f, 0.f};
        float mrun = -__builtin_inff(), lrun = 0.f;
#pragma unroll 1
        for (int T = 0; T < ntile; ++T) {
#pragma unroll
            for (int i = 0; i < 8; ++i) {
                const int kap = 4 * i + g; int slot = 32 * T + kap; slot = slot < cnt ? slot : cnt - 1;
                const int key = sel[slot];
                const int nu = 8 * ((kap >> 2) & 3) + 4 * (kap >> 4) + (kap & 3);
                const float* ksrc = kv_row(a, false, sample, b, key, kvh) + 8 * m;
                const float* vsrc = kv_row(a, true, sample, b, key, kvh) + 8 * m;
                const f32x4 f0 = *(const f32x4*)ksrc, f1 = *(const f32x4*)(ksrc + 4), e0 = *(const f32x4*)vsrc, e1 = *(const f32x4*)(vsrc + 4);
                v4u w; w.x = pk2(f0[0], f0[1]); w.y = pk2(f0[2], f0[3]); w.z = pk2(f1[0], f1[1]); w.w = pk2(f1[2], f1[3]);
                *(LAS v4u*)(Kb + off_b(kap, m)) = w;
                v4u x; x.x = pk2(e0[0], e0[1]); x.y = pk2(e0[2], e0[3]); x.z = pk2(e1[0], e1[1]); x.w = pk2(e1[2], e1[3]);
                *(LAS v4u*)(Vb + off_b(nu, m)) = x;
            }
            f32x4 c[2];
#pragma unroll
            for (int rb = 0; rb < 2; ++rb) {
                f32x4 acc = {0.f, 0.f, 0.f, 0.f};
#pragma unroll
                for (int s = 0; s < 4; ++s) { const bf16x8 kf = *(const LAS bf16x8*)(Kb + off_b(m + 16 * rb, 4 * s + g)); acc = __builtin_amdgcn_mfma_f32_16x16x32_bf16(kf, qf[s], acc, 0, 0, 0); }
                c[rb] = acc;
            }
            float tm = -__builtin_inff();
#pragma unroll
            for (int rb = 0; rb < 2; ++rb)
#pragma unroll
                for (int i = 0; i < 4; ++i) { const int slot = 32 * T + 16 * rb + 4 * g + i; if (slot >= cnt) c[rb][i] = -__builtin_inff(); tm = fmaxf(tm, c[rb][i]); }
            tm = fmaxf(tm, __shfl_xor(tm, 16)); tm = fmaxf(tm, __shfl_xor(tm, 32));
            const float mnew = fmaxf(mrun, tm);
            const float alpha = __expf(mrun - mnew);
            mrun = mnew;
            float ps = 0.f;
#pragma unroll
            for (int rb = 0; rb < 2; ++rb)
#pragma unroll
                for (int i = 0; i < 4; ++i) { const float pe = __expf(c[rb][i] - mnew); c[rb][i] = pe; ps += pe; }
            lrun = lrun * alpha + ps;
            float al[4];
#pragma unroll
            for (int i = 0; i < 4; ++i) al[i] = __shfl(alpha, (4 * g + i) & 15);
#pragma unroll
            for (int cc = 0; cc < 8; ++cc)
#pragma unroll
                for (int i = 0; i < 4; ++i) o[cc][i] *= al[i];
            v4u pw; pw.x = pk2(c[0][0], c[0][1]); pw.y = pk2(c[0][2], c[0][3]); pw.z = pk2(c[1][0], c[1][1]); pw.w = pk2(c[1][2], c[1][3]);
            const bf16x8 pa = __builtin_bit_cast(bf16x8, pw);
#pragma unroll
            for (int cc = 0; cc < 8; ++cc) {
                const s16x4 v0 = vtr(Vb + tr_read_addr_16(lane, cc, 0)), v1 = vtr(Vb + tr_read_addr_16(lane, cc, 1));
                const bf16x8 vf = (bf16x8){v0[0], v0[1], v0[2], v0[3], v1[0], v1[1], v1[2], v1[3]};
                o[cc] = __builtin_amdgcn_mfma_f32_16x16x32_bf16(pa, vf, o[cc], 0, 0, 0);
            }
        }
        float l = lrun; l += __shfl_xor(l, 16); l += __shfl_xor(l, 32);
        float linv[4];
#pragma unroll
        for (int i = 0; i < 4; ++i) linv[i] = 1.0f / __shfl(l, (4 * g + i) & 15);
        if (g < 2) {
#pragma unroll
            for (int i = 0; i < 4; ++i) { const size_t ro = (size_t)row * 2048 + (kvh * 8 + 4 * g + i) * 128 + m;
#pragma unroll
                for (int cc = 0; cc < 8; ++cc) YB[ro + 16 * cc] = f2bf(o[cc][i] * linv[i] * bf2f(BZ[ro + 16 * cc])); }
        }
    }
}

__global__ void __launch_bounds__(NTHREADS, 2) fwd(Args a) {
    extern __shared__ __attribute__((aligned(16))) unsigned char lds_raw[];
    LAS unsigned char* lds = (LAS unsigned char*)lds_raw;
    const int tid = threadIdx.x, lane = tid & 63, wave = __builtin_amdgcn_readfirstlane(tid >> 6);
    const int G = gridDim.x, bid = blockIdx.x;
    const int gw = bid * NWAVES + wave, NGW = G * NWAVES;
    unsigned char* ws = a.ws;
    gu32* ctl = (gu32*)(ws + WS_CTL);
    for (int u = tid; u < (LDS_BYTES - LDSCTL_OFF) / 4; u += NTHREADS) ((LAS unsigned*)(lds + LDSCTL_OFF))[u] = 0u;
    __syncthreads();
    volatile LAS unsigned* MISC = (volatile LAS unsigned*)(lds + MISC_OFF);
#if MK_ONE_LAUNCH
    XcdBarrier bar = xcd_barrier_post((unsigned*)ctl + CW_BAR, MISC + 8);
#define GRID_BAR() xcd_barrier(bar)
#else
    (void)MISC; (void)ctl;
#define GRID_BAR() do {} while (0)
#endif
    const int lo = a.ph_lo, hi = a.ph_hi;
#ifndef PH_MASK
#define PH_MASK 0x7ff
#endif
#define IN(k) (((PH_MASK >> (k)) & 1) && lo <= (k) && (k) < hi)
#define BOTH(k) (IN(k) && IN((k) + 1))
    float* MOD = (float*)(ws + WS_MOD);
    bf16* WIN = (bf16*)(ws + WS_WIN); bf16* WPA = (bf16*)(ws + WS_WPA); bf16* WPB = (bf16*)(ws + WS_WPB); bf16* WOUT = (bf16*)(ws + WS_WOUT);
    bf16* H = (bf16*)(ws + WS_H);

    if (IN(0)) {
        LAS float* scr = (LAS float*)(lds + wave * 16384);
        constexpr int I_IN = (D / 64) * (NPAD / 32), I_PA = (4096 / 64) * (D / 32), I_PB = (D / 64) * (D / 32), I_OUT = I_PB, I_MOD = 8 * 96;
        constexpr int NITEMS = I_MOD + I_IN + I_PA + I_PB + I_OUT;
        for (int it = gw; it < NITEMS; it += NGW) {
            int r = it;
            if (r < I_MOD) { mod_item(a, MOD, r, scr, lane); continue; } r -= I_MOD;
            if (r < I_IN) { const int nblk = NPAD / 32; transpose_item(a.w_in, NIN, D, WIN, 32 * (r % nblk), 64 * (r / nblk), true, scr, lane); continue; } r -= I_IN;
            if (r < I_PA) { const int nblk = D / 32; transpose_item(a.w_pa, D, 4096, WPA, 32 * (r % nblk), 64 * (r / nblk), false, scr, lane); continue; } r -= I_PA;
            if (r < I_PB) { const int nblk = D / 32; transpose_item(a.w_pb, D, D, WPB, 32 * (r % nblk), 64 * (r / nblk), false, scr, lane); continue; } r -= I_PB;
            { const int nblk = D / 32; transpose_item(a.w_out, D, D, WOUT, 32 * (r % nblk), 64 * (r / nblk), false, scr, lane); }
        }
        if (BOTH(0)) GRID_BAR();
    }
    if (IN(1)) {
        for (int mrow = gw; mrow < MROWS; mrow += NGW) {
            const float* xr = mrow < MP ? a.x_p + (size_t)mrow * D : a.x_s + (size_t)(mrow - MP) * D;
            const int bi = mrow < MP ? (mrow >> 11) : 4 + ((mrow - MP) >> 3);
            const float* md = MOD + bi * 6144;
            f32x4 v[8]; float s = 0.f;
#pragma unroll
            for (int j = 0; j < 8; ++j) { v[j] = ((const f32x4*)xr)[lane + 64 * j]; s += (v[j][0] * v[j][0] + v[j][1] * v[j][1]) + (v[j][2] * v[j][2] + v[j][3] * v[j][3]); }
            const float rstd = rsqrtf(wave_sum(s) * (1.0f / D) + NORM_EPS);
#pragma unroll
            for (int j = 0; j < 8; ++j) { const int col = 4 * (lane + 64 * j);
                const f32x4 gg = *(const f32x4*)(a.pre_g + col), sh = *(const f32x4*)(md + col) + *(const f32x4*)(a.b_ada + col), sc = *(const f32x4*)(md + 2048 + col) + *(const f32x4*)(a.b_ada + 2048 + col);
                const f32x4 hv = v[j] * rstd * gg * (sc + 1.0f) + sh;
                v2u w; w.x = pk2(hv[0], hv[1]); w.y = pk2(hv[2], hv[3]);
                *(v2u*)(H + (size_t)mrow * D + col) = w; }
        }
        if (BOTH(1)) GRID_BAR();
    }
    if (IN(2)) {
        pg8::Gemm g{H, WIN, MROWS, NPAD, D}; pg8::StaticOrder S; S.init(MROWS, NPAD, G, bid);
        pg8::EpiIn E{(bf16*)(ws + WS_QKV), (bf16*)(ws + WS_Z), (bf16*)(ws + WS_BQ), (bf16*)(ws + WS_BZ), (bf16*)(ws + WS_IQ), (bf16*)(ws + WS_GA), (bf16*)(ws + WS_GB), (bf16*)(ws + WS_IK),
                     (float*)(ws + WS_BETA), (float*)(ws + WS_GG), (float*)(ws + WS_IW), a.out, a.a_log, a.dt_bias};
        pg8::gemm_phase<pg8::EpiIn, pg8::StaticOrder, true, true>(lds, g, S, E);
        if (BOTH(2)) GRID_BAR();
    }
    if (IN(3)) {
        for (int u = bid; u < BP * HV + BS * HV; u += G) gdn_unit(a, (LAS float*)lds, u);
        if (BOTH(3)) GRID_BAR();
    }
    if (IN(4)) {
        constexpr int NPI = BP * (LP / 2), NSI = BS * (NPAGES + 1);
        for (int it = gw; it < NPI + NSI; it += NGW) {
            if (it < NPI) { int i2 = it < NPI / 2 ? it : (NPI - 1) - (it - NPI / 2); idx_prompt_item(a, i2 & 3, (LP / 2 - 1) - (i2 >> 2), lane); }
            else { const int r = it - NPI; idx_sample_item(a, r / (NPAGES + 1), r % (NPAGES + 1), lane); }
        }
        if (BOTH(4)) GRID_BAR();
    }
    if (IN(5)) {
        int* SEL = (int*)(ws + WS_SEL); int* CNT = (int*)(ws + WS_CNT);
        for (int r = gw; r < MROWS; r += NGW) {
            if (r < MP) topk_query<32>((const float*)(ws + WS_SC) + (size_t)r * 2048, (r & (LP - 1)) + 1, SEL + (size_t)r * NTOPK, CNT + r, lane);
            else topk_query<129>((const float*)(ws + WS_SCS) + (size_t)(r - MP) * SCS_LD, PAST + ((r - MP) & 7) + 1, SEL + (size_t)r * NTOPK, CNT + r, lane);
        }
        if (BOTH(5)) GRID_BAR();
    }
    if (IN(6)) {
        for (int r = gw; r < MROWS; r += NGW) attn_query(a, lds + wave * 16384, r, lane);
        if (BOTH(6)) GRID_BAR();
    }
    if (IN(7)) {
        pg8::Gemm g{(const bf16*)(ws + WS_YA), WPA, MROWS, D, 4096}; pg8::StaticOrder S; S.init(MROWS, D, G, bid);
        pg8::EpiM1 E{(const bf16*)(ws + WS_GA), (float*)(ws + WS_TMP)};
        pg8::gemm_phase<pg8::EpiM1, pg8::StaticOrder, true, true>(lds, g, S, E);
        if (BOTH(7)) GRID_BAR();
    }
    if (IN(8)) {
        pg8::Gemm g{(const bf16*)(ws + WS_YB), WPB, MROWS, D, D}; pg8::StaticOrder S; S.init(MROWS, D, G, bid);
        pg8::EpiM2 E{(const bf16*)(ws + WS_GB), (const float*)(ws + WS_TMP), (bf16*)(ws + WS_MG)};
        pg8::gemm_phase<pg8::EpiM2, pg8::StaticOrder, true, true>(lds, g, S, E);
        if (BOTH(8)) GRID_BAR();
    }
    if (IN(9)) {
        pg8::Gemm g{(const bf16*)(ws + WS_MG), WOUT, MROWS, D, D}; pg8::StaticOrder S; S.init(MROWS, D, G, bid);
        pg8::EpiF32P E{(float*)(ws + WS_OUTF), D};
        pg8::gemm_phase<pg8::EpiF32P, pg8::StaticOrder, true, true>(lds, g, S, E);
        if (BOTH(9)) GRID_BAR();
    }
    if (IN(10)) {
        const float* OUTF = (const float*)(ws + WS_OUTF);
        for (int mrow = gw; mrow < MROWS; mrow += NGW) {
            const float* xr = mrow < MP ? a.x_p + (size_t)mrow * D : a.x_s + (size_t)(mrow - MP) * D;
            float* yr = mrow < MP ? a.out + O_YP + (size_t)mrow * D : a.out + O_YS + (size_t)(mrow - MP) * D;
            const int bi = mrow < MP ? (mrow >> 11) : 4 + ((mrow - MP) >> 3);
            const float* md = MOD + bi * 6144 + 4096;
            const float* orow = OUTF + (size_t)mrow * D;
            f32x4 v[8]; float s = 0.f;
#pragma unroll
            for (int j = 0; j < 8; ++j) { v[j] = ((const f32x4*)orow)[lane + 64 * j]; s += (v[j][0] * v[j][0] + v[j][1] * v[j][1]) + (v[j][2] * v[j][2] + v[j][3] * v[j][3]); }
            const float rstd = rsqrtf(wave_sum(s) * (1.0f / D) + NORM_EPS);
#pragma unroll
            for (int j = 0; j < 8; ++j) { const int col = 4 * (lane + 64 * j);
                const f32x4 gg = *(const f32x4*)(a.post_g + col), gt = *(const f32x4*)(md + col) + *(const f32x4*)(a.b_ada + 4096 + col), xv = ((const f32x4*)xr)[lane + 64 * j];
                ((f32x4*)yr)[lane + 64 * j] = xv + gt * (v[j] * rstd * gg); }
        }
    }
#undef IN
#undef BOTH
}

extern "C" void kernel_launch(void* const* d_in, const int* in_sizes, int n_in, void* d_out, int out_size, void* d_ws, size_t ws_size, hipStream_t stream) {
    static int grid = 0;
    if (grid == 0) {
        if (n_in != 22 || (size_t)out_size != O_END || ws_size < WS_END) { fprintf(stderr, "kernel_launch: unexpected shapes (n_in %d, out %d, ws %zu); nothing launched\n", n_in, out_size, ws_size); grid = -1; return; }
        int dev = 0, cus = 0;
        if (hipGetDevice(&dev) != hipSuccess || hipDeviceGetAttribute(&cus, hipDeviceAttributeMultiprocessorCount, dev) != hipSuccess) { grid = -1; return; }
        if (hipFuncSetAttribute((const void*)fwd, hipFuncAttributeMaxDynamicSharedMemorySize, LDS_BYTES) != hipSuccess) { fprintf(stderr, "kernel_launch: hipFuncSetAttribute failed\n"); grid = -1; return; }
        int per_cu = 0;
        if (hipOccupancyMaxActiveBlocksPerMultiprocessor(&per_cu, (const void*)fwd, NTHREADS, LDS_BYTES) != hipSuccess || per_cu < 1) fprintf(stderr, "kernel_launch: note: occupancy query reports %d\n", per_cu);
        (void)hipGetLastError();
        grid = cus;
    }
    if (grid < 0) return;
    (void)hipMemsetAsync((char*)d_ws + WS_CTL, 0, CTL_ZERO_BYTES, stream);
    Args a{};
    a.x_p = (const float*)d_in[0]; a.x_s = (const float*)d_in[1]; a.c_p = (const float*)d_in[2]; a.c_s = (const float*)d_in[3];
    a.cache_k = (const float*)d_in[4]; a.cache_v = (const float*)d_in[5]; a.cache_kidx = (const float*)d_in[6]; a.state_gdn = (const float*)d_in[7]; a.state_conv = (const float*)d_in[8];
    a.page_table = (const int*)d_in[9];
    a.w_ada = (const float*)d_in[10]; a.b_ada = (const float*)d_in[11]; a.pre_g = (const float*)d_in[12]; a.w_in = (const float*)d_in[13]; a.conv_w = (const float*)d_in[14];
    a.a_log = (const float*)d_in[15]; a.dt_bias = (const float*)d_in[16]; a.gdn_g = (const float*)d_in[17]; a.w_pa = (const float*)d_in[18]; a.w_pb = (const float*)d_in[19];
    a.w_out = (const float*)d_in[20]; a.post_g = (const float*)d_in[21];
    a.out = (float*)d_out; a.ws = (unsigned char*)d_ws;
#if MK_ONE_LAUNCH
    a.ph_lo = 0; a.ph_hi = N_PHASES;
    hipLaunchKernelGGL(fwd, dim3(grid), dim3(NTHREADS), LDS_BYTES, stream, a);
#else
    for (int ph = 0; ph < N_PHASES; ++ph) { a.ph_lo = ph; a.ph_hi = ph + 1; hipLaunchKernelGGL(fwd, dim3(grid), dim3(NTHREADS), LDS_BYTES, stream, a); }
#endif
}
```

```cpp
#include <hip/hip_runtime.h>
#include <cstdio>
#include <cstdint>
constexpr int D = 2048, BP = 4, LP = 2048, BS = 32, LS = 8, MP = BP * LP, MS = BS * LS, MROWS = MP + MS;
constexpr int NPAGES = 64, PAGE = 128, PAST = NPAGES * PAGE;
constexpr int HV = 32, HQK = 16, DK = 128, DV = 128, CONVCH = 8192;
constexpr int NIN = 23248, NPAD = 23296;
constexpr int NTOPK = 256;
constexpr float NORM_EPS = 1e-6f, L2_EPS = 1e-6f;
constexpr int SCS_LD = 8256;
constexpr size_t O_YP = 0, O_YS = O_YP + (size_t)MP * D, O_KP = O_YS + (size_t)MS * D, O_VP = O_KP + (size_t)MP * 256, O_KIP = O_VP + (size_t)MP * 256,
                 O_GP = O_KIP + (size_t)MP * 128, O_CP = O_GP + (size_t)BP * HV * DK * DV, O_KS = O_CP + (size_t)BP * 3 * CONVCH, O_VS = O_KS + (size_t)MS * 256,
                 O_KIS = O_VS + (size_t)MS * 256, O_GS = O_KIS + (size_t)MS * 128, O_CS = O_GS + (size_t)BS * HV * DK * DV, O_END = O_CS + (size_t)BS * 3 * CONVCH;
static_assert(O_END == 42467328, "output size");
__host__ __device__ __forceinline__ int win_src_col(int n) {
    if (n < 12288) return n;
    if (n < 18944) return n + 64;
    if (n < 23040) return n + 208;
    if (n < 23168) return n - 23040 + 19008;
    if (n < 23200) return n - 23168 + 12288;
    if (n < 23232) return n - 23200 + 12320;
    if (n < 23248) return n - 23232 + 19136;
    return -1;
}
namespace pg8 {
#define PG8_LAS __attribute__((address_space(3)))
typedef unsigned short bf16_t;
typedef short bf16x8 __attribute__((ext_vector_type(8)));
typedef float f32x4 __attribute__((ext_vector_type(4)));
typedef unsigned u32x4 __attribute__((ext_vector_type(4)));
constexpr int BM = 256, BK = 64, HALF = 128, HTB = HALF * BK * 2  , STAGE_BYTES = 8 * HTB, NXCD = 8, WGM = 4;

__host__ __device__ __forceinline__ int lds_byte(int r, int c) { const int st = (r >> 4) * 2 + (c >> 5), rr = r & 15, cc = c & 31, ob = rr * 64 + cc * 2; return st * 1024 + (ob ^ (((ob >> 9) & 1) << 5)); }
__host__ __device__ __forceinline__ void stage_rc(int b, int& R, int& C) { const int st = b / 1024, sb = b % 1024, swz = sb ^ (((sb >> 9) & 1) << 5); R = (st >> 1) * 16 + swz / 64; C = (st & 1) * 32 + (swz % 64) / 2; }
__host__ __device__ __forceinline__ int perm32(int rho) { const int n = rho >> 4, i = rho & 15; return 8 * (i >> 2) + 4 * n + (i & 3); }

struct Unit { int pm, pn, seg; };
struct Gemm { const bf16_t* A; const bf16_t* Bt; int M, N, K; };

struct StaticOrder {
    int nM, nN, nwg, G, c;
    __host__ __device__ void init(int M, int N, int G_, int c_) { nM = M / BM; nN = N / BM; nwg = nM * nN; G = G_; c = c_; }
    __host__ __device__ bool next(int i, Unit& u) const {
        const long L = (long)i * G + c; if (L >= nwg) return false;
        int wgid = (int)L; { const int q = nwg / NXCD, r = nwg % NXCD, xcd = wgid % NXCD, off = wgid / NXCD; wgid = (xcd < r ? xcd * (q + 1) : r * (q + 1) + (xcd - r) * q) + off; }
        const int nig = WGM * nN, gid = wgid / nig, fm = gid * WGM, gsz = (nM - fm) < WGM ? (nM - fm) : WGM;
        u.pm = fm + ((wgid % nig) % gsz); u.pn = (wgid % nig) / gsz; return true;
    }
    __device__ __forceinline__ void a_ready(const Unit&) const {}
    __device__ __forceinline__ void done(const Unit&) const {}
};

typedef __bf16 bf16x2_t __attribute__((ext_vector_type(2)));
typedef float f32x2_t __attribute__((ext_vector_type(2)));
__device__ __forceinline__ unsigned cvt_pk_bf16(float lo, float hi) { const f32x2_t v = {lo, hi}; const bf16x2_t b = __builtin_convertvector(v, bf16x2_t); return __builtin_bit_cast(unsigned, b); }
__device__ __forceinline__ float bf_lo(unsigned w) { return __uint_as_float(w << 16); }
__device__ __forceinline__ float bf_hi(unsigned w) { return __uint_as_float(w & 0xffff0000u); }
__device__ __forceinline__ float fsigmoid(float x) { return __builtin_amdgcn_rcpf(1.0f + __expf(-x)); }
__device__ __forceinline__ float fsilu(float x) { return x * fsigmoid(x); }
__device__ __forceinline__ f32x4 act4(f32x4 v, int act) {
    if (act == 1) { v[0] = fsilu(v[0]); v[1] = fsilu(v[1]); v[2] = fsilu(v[2]); v[3] = fsilu(v[3]); }
    else if (act == 2) { v[0] = fsigmoid(v[0]); v[1] = fsigmoid(v[1]); v[2] = fsigmoid(v[2]); v[3] = fsigmoid(v[3]); }
    else if (act == 3) { v = v * 0.08838834764831845f; }
    return v;
}
struct EpiIn {
    static constexpr bool PERM = true, AFTER_DRAIN = false;
    bf16_t *QKV, *Z, *BQ, *BZ, *IQ, *GA, *GB, *IK; float *BETA, *GG, *IW; float* out; const float* a_log; const float* dt_bias; bf16_t* BKV;
    __device__ __forceinline__ void operator()(const f32x4 (&acc)[2][2][4][2], const Unit& u, int wr, int wc, int fr, int fq) const {
        const int pn = u.pn, row0 = u.pm * BM + wr * 64 + fr, cl = wc * 32 + 8 * fq;
        if (pn < 56 || (pn >= 58 && pn < 90)) {
            bf16_t* dst; int ldc, cbase, act;
            if (pn < 32) { dst = QKV; ldc = 8192; cbase = pn * 256; act = 0; }
            else if (pn < 48) { dst = Z; ldc = 4096; cbase = (pn - 32) * 256; act = 1; }
            else if (pn < 56) { dst = BQ; ldc = 2048; cbase = (pn - 48) * 256; act = 3; }
            else if (pn < 66) { dst = BZ; ldc = 2048; cbase = (pn - 58) * 256; act = 1; }
            else if (pn < 74) { dst = IQ; ldc = 2048; cbase = (pn - 66) * 256; act = 0; }
            else if (pn < 82) { dst = GA; ldc = 2048; cbase = (pn - 74) * 256; act = 2; }
            else { dst = GB; ldc = 2048; cbase = (pn - 82) * 256; act = 2; }
            const float csc = act == 3 ? 0.08838834764831845f : 1.0f;
            const bool use_sig = (act == 1) || (act == 2), keep_x = act != 2;
            bf16_t* base = dst + (size_t)row0 * ldc + cbase + cl;
            if (use_sig) {
#pragma unroll
                for (int ai = 0; ai < 2; ++ai)
#pragma unroll
                    for (int m = 0; m < 4; ++m)
#pragma unroll
                        for (int bj = 0; bj < 2; ++bj) {
                            f32x4 v0 = acc[ai][bj][m][0], v1 = acc[ai][bj][m][1];
#pragma unroll
                            for (int e = 0; e < 4; ++e) { const float s0 = fsigmoid(v0[e]), s1 = fsigmoid(v1[e]); v0[e] = keep_x ? v0[e] * s0 : s0; v1[e] = keep_x ? v1[e] * s1 : s1; }
                            u32x4 w; w.x = cvt_pk_bf16(v0[0], v0[1]); w.y = cvt_pk_bf16(v0[2], v0[3]); w.z = cvt_pk_bf16(v1[0], v1[1]); w.w = cvt_pk_bf16(v1[2], v1[3]);
                            __builtin_nontemporal_store(w, (u32x4*)(base + (size_t)(ai * HALF + m * 16) * ldc + bj * HALF));
                        }
            } else {
#pragma unroll
                for (int ai = 0; ai < 2; ++ai)
#pragma unroll
                    for (int m = 0; m < 4; ++m)
#pragma unroll
                        for (int bj = 0; bj < 2; ++bj) {
                            const f32x4 v0 = acc[ai][bj][m][0] * csc, v1 = acc[ai][bj][m][1] * csc;
                            u32x4 w; w.x = cvt_pk_bf16(v0[0], v0[1]); w.y = cvt_pk_bf16(v0[2], v0[3]); w.z = cvt_pk_bf16(v1[0], v1[1]); w.w = cvt_pk_bf16(v1[2], v1[3]);
                            __builtin_nontemporal_store(w, (u32x4*)(base + (size_t)(ai * HALF + m * 16) * ldc + bj * HALF));
                        }
            }
            if (pn < 32 && ((u.pm & 7) == 7)) {
                int fro = fr; asm volatile("" : "+v"(fro));
                if (wr == 1 && fro >= 13) {
                    float* tail = out + O_CP + ((size_t)(u.pm >> 3) * 3 + (fro - 13)) * CONVCH + cbase + 8 * (fq) + wc * 32;
#pragma unroll
                    for (int bj = 0; bj < 2; ++bj) { *(f32x4*)(tail + bj * HALF) = acc[1][bj][3][0]; *(f32x4*)(tail + bj * HALF + 4) = acc[1][bj][3][1]; }
                }
            }
            if (pn < 32 && u.pm == MP / BM) {
                int fro = fr; asm volatile("" : "+v"(fro));
#pragma unroll
                for (int ai = 0; ai < 2; ++ai)
#pragma unroll
                    for (int m = 0; m < 4; ++m) { const int rr = ai * HALF + wr * 64 + m * 16 + fro, t = rr & 7;
                        if (t >= 5) { float* tail = out + O_CS + ((size_t)(rr >> 3) * 3 + (t - 5)) * CONVCH + cbase + cl;
#pragma unroll
                            for (int bj = 0; bj < 2; ++bj) { *(f32x4*)(tail + bj * HALF) = acc[ai][bj][m][0]; *(f32x4*)(tail + bj * HALF + 4) = acc[ai][bj][m][1]; } } }
            }
        } else if (pn < 58) {
#pragma unroll
            for (int ai = 0; ai < 2; ++ai)
#pragma unroll
                for (int m = 0; m < 4; ++m) {
                    const int row = row0 + ai * HALF + m * 16;
                    float* rowp = out + (row < MP ? (pn == 56 ? O_KP : O_VP) + (size_t)row * 256 : (pn == 56 ? O_KS : O_VS) + (size_t)(row - MP) * 256) + cl;
#pragma unroll
                    for (int bj = 0; bj < 2; ++bj) { const f32x4 v0 = acc[ai][bj][m][0], v1 = acc[ai][bj][m][1]; *(f32x4*)(rowp + bj * HALF) = v0; *(f32x4*)(rowp + bj * HALF + 4) = v1;
                        u32x4 w; w.x = cvt_pk_bf16(v0[0], v0[1]); w.y = cvt_pk_bf16(v0[2], v0[3]); w.z = cvt_pk_bf16(v1[0], v1[1]); w.w = cvt_pk_bf16(v1[2], v1[3]);
                        *(u32x4*)(BKV + (size_t)row * 512 + (pn == 57 ? 256 : 0) + cl + bj * HALF) = w; }
                }
        } else {
#pragma unroll
            for (int ai = 0; ai < 2; ++ai)
#pragma unroll
                for (int m = 0; m < 4; ++m) {
                    const int row = row0 + ai * HALF + m * 16;
                    {
                        const f32x4 v0 = acc[ai][0][m][0], v1 = acc[ai][0][m][1];
                        float* o = out + (row < MP ? O_KIP + (size_t)row * 128 : O_KIS + (size_t)(row - MP) * 128) + cl;
                        *(f32x4*)o = v0; *(f32x4*)(o + 4) = v1;
                        u32x4 w; w.x = cvt_pk_bf16(v0[0], v0[1]); w.y = cvt_pk_bf16(v0[2], v0[3]); w.z = cvt_pk_bf16(v1[0], v1[1]); w.w = cvt_pk_bf16(v1[2], v1[3]);
                        *(u32x4*)(IK + (size_t)row * 128 + cl) = w;
                    }
                    {
                        f32x4 v0 = acc[ai][1][m][0], v1 = acc[ai][1][m][1];
                        if (wc == 0) {
                            float* o = BETA + (size_t)row * 32 + cl;
                            v0 = act4(v0, 2); v1 = act4(v1, 2); *(f32x4*)o = v0; *(f32x4*)(o + 4) = v1;
                        } else if (wc == 1) {
                            const int h0 = cl - 32; float* o = GG + (size_t)row * 32 + h0;
                            float r[8];
#pragma unroll
                            for (int e = 0; e < 8; ++e) { const float x = (e < 4 ? v0[e & 3] : v1[e & 3]) + dt_bias[h0 + e]; const float sp = fmaxf(x, 0.f) + __logf(1.0f + __expf(-fabsf(x))); r[e] = -__expf(a_log[h0 + e]) * sp; }
                            *(f32x4*)o = (f32x4){r[0], r[1], r[2], r[3]}; *(f32x4*)(o + 4) = (f32x4){r[4], r[5], r[6], r[7]};
                        } else if (wc == 2 && fq < 2) {
                            float* o = IW + (size_t)row * 16 + (cl - 64);
                            *(f32x4*)o = v0; *(f32x4*)(o + 4) = v1;
                        }
                    }
                }
        }
    }
};
struct EpiM1 {
    static constexpr bool PERM = true, AFTER_DRAIN = false;
    const bf16_t* GA; bf16_t* TMP;
    __device__ __forceinline__ void operator()(const f32x4 (&acc)[2][2][4][2], const Unit& u, int wr, int wc, int fr, int fq) const {
        const int row0 = u.pm * BM + wr * 64 + fr, col0 = u.pn * BM + wc * 32 + 8 * fq;
        u32x4 gw[2][4][2];
#pragma unroll
        for (int ai = 0; ai < 2; ++ai)
#pragma unroll
            for (int m = 0; m < 4; ++m)
#pragma unroll
                for (int bj = 0; bj < 2; ++bj) gw[ai][m][bj] = *(const u32x4*)(GA + (size_t)(row0 + ai * HALF + m * 16) * D + col0 + bj * HALF);
#pragma unroll
        for (int ai = 0; ai < 2; ++ai)
#pragma unroll
            for (int m = 0; m < 4; ++m) { const size_t off = (size_t)(row0 + ai * HALF + m * 16) * D + col0;
#pragma unroll
                for (int bj = 0; bj < 2; ++bj) { const u32x4 g4 = gw[ai][m][bj]; const f32x4 v0 = acc[ai][bj][m][0], v1 = acc[ai][bj][m][1];
                    u32x4 w; w.x = cvt_pk_bf16(v0[0] * bf_lo(g4.x), v0[1] * bf_hi(g4.x)); w.y = cvt_pk_bf16(v0[2] * bf_lo(g4.y), v0[3] * bf_hi(g4.y));
                    w.z = cvt_pk_bf16(v1[0] * bf_lo(g4.z), v1[1] * bf_hi(g4.z)); w.w = cvt_pk_bf16(v1[2] * bf_lo(g4.w), v1[3] * bf_hi(g4.w));
                    *(u32x4*)(TMP + off + bj * HALF) = w; } }
    }
};
struct EpiM2 {
    static constexpr bool PERM = true, AFTER_DRAIN = false;
    const bf16_t* GB; const bf16_t* TMP; bf16_t* MG;
    __device__ __forceinline__ void operator()(const f32x4 (&acc)[2][2][4][2], const Unit& u, int wr, int wc, int fr, int fq) const {
        const int row0 = u.pm * BM + wr * 64 + fr, col0 = u.pn * BM + wc * 32 + 8 * fq;
#pragma unroll
        for (int ai = 0; ai < 2; ++ai)
#pragma unroll
            for (int mh = 0; mh < 2; ++mh) {
                u32x4 gw[2][2], tw[2][2];
#pragma unroll
                for (int mm = 0; mm < 2; ++mm)
#pragma unroll
                    for (int bj = 0; bj < 2; ++bj) { const size_t off = (size_t)(row0 + ai * HALF + (2 * mh + mm) * 16) * D + col0 + bj * HALF; gw[mm][bj] = *(const u32x4*)(GB + off); tw[mm][bj] = *(const u32x4*)(TMP + off); }
#pragma unroll
                for (int mm = 0; mm < 2; ++mm)
#pragma unroll
                    for (int bj = 0; bj < 2; ++bj) { const int m = 2 * mh + mm; const size_t off = (size_t)(row0 + ai * HALF + m * 16) * D + col0 + bj * HALF; const u32x4 g4 = gw[mm][bj], t4 = tw[mm][bj]; const f32x4 v0 = acc[ai][bj][m][0], v1 = acc[ai][bj][m][1];
                        u32x4 w; w.x = cvt_pk_bf16(bf_lo(t4.x) + v0[0] * bf_lo(g4.x), bf_hi(t4.x) + v0[1] * bf_hi(g4.x)); w.y = cvt_pk_bf16(bf_lo(t4.y) + v0[2] * bf_lo(g4.y), bf_hi(t4.y) + v0[3] * bf_hi(g4.y));
                        w.z = cvt_pk_bf16(bf_lo(t4.z) + v1[0] * bf_lo(g4.z), bf_hi(t4.z) + v1[1] * bf_hi(g4.z)); w.w = cvt_pk_bf16(bf_lo(t4.w) + v1[2] * bf_lo(g4.w), bf_hi(t4.w) + v1[3] * bf_hi(g4.w));
                        *(u32x4*)(MG + off) = w; }
            }
    }
};
struct EpiChain {
    static constexpr bool PERM = true, AFTER_DRAIN = false;
    const bf16_t *GA, *GB; bf16_t* MG;
    __device__ __forceinline__ void operator()(f32x4 (&acc)[2][2][4][2], const Unit& u, int wr, int wc, int fr, int fq) const {
        if (u.seg == 0) return;
        const int row0 = u.pm * BM + wr * 64 + fr, col0 = u.pn * BM + wc * 32 + 8 * fq;
        if (u.seg == 1) {
#pragma unroll
            for (int ai = 0; ai < 2; ++ai) {
                u32x4 ga[4][2], gb[4][2];
#pragma unroll
                for (int m = 0; m < 4; ++m)
#pragma unroll
                    for (int bj = 0; bj < 2; ++bj) { const size_t off = (size_t)(row0 + ai * HALF + m * 16) * D + col0 + bj * HALF; ga[m][bj] = *(const u32x4*)(GA + off); gb[m][bj] = *(const u32x4*)(GB + off); }
#pragma unroll
                for (int m = 0; m < 4; ++m)
#pragma unroll
                    for (int bj = 0; bj < 2; ++bj) { const u32x4 a4 = ga[m][bj], b4 = gb[m][bj];
                        acc[ai][bj][m][0] = acc[ai][bj][m][0] * (f32x4){bf_lo(a4.x) * __builtin_amdgcn_rcpf(fmaxf(bf_lo(b4.x), 1e-30f)), bf_hi(a4.x) * __builtin_amdgcn_rcpf(fmaxf(bf_hi(b4.x), 1e-30f)), bf_lo(a4.y) * __builtin_amdgcn_rcpf(fmaxf(bf_lo(b4.y), 1e-30f)), bf_hi(a4.y) * __builtin_amdgcn_rcpf(fmaxf(bf_hi(b4.y), 1e-30f))};
                        acc[ai][bj][m][1] = acc[ai][bj][m][1] * (f32x4){bf_lo(a4.z) * __builtin_amdgcn_rcpf(fmaxf(bf_lo(b4.z), 1e-30f)), bf_hi(a4.z) * __builtin_amdgcn_rcpf(fmaxf(bf_hi(b4.z), 1e-30f)), bf_lo(a4.w) * __builtin_amdgcn_rcpf(fmaxf(bf_lo(b4.w), 1e-30f)), bf_hi(a4.w) * __builtin_amdgcn_rcpf(fmaxf(bf_hi(b4.w), 1e-30f))}; }
            }
        } else {
            u32x4 gb[2][4][2];
#pragma unroll
            for (int ai = 0; ai < 2; ++ai)
#pragma unroll
                for (int m = 0; m < 4; ++m)
#pragma unroll
                    for (int bj = 0; bj < 2; ++bj) gb[ai][m][bj] = *(const u32x4*)(GB + (size_t)(row0 + ai * HALF + m * 16) * D + col0 + bj * HALF);
#pragma unroll
            for (int ai = 0; ai < 2; ++ai)
#pragma unroll
                for (int m = 0; m < 4; ++m)
#pragma unroll
                    for (int bj = 0; bj < 2; ++bj) { const u32x4 b4 = gb[ai][m][bj]; const f32x4 v0 = acc[ai][bj][m][0], v1 = acc[ai][bj][m][1];
                        u32x4 w; w.x = cvt_pk_bf16(v0[0] * bf_lo(b4.x), v0[1] * bf_hi(b4.x)); w.y = cvt_pk_bf16(v0[2] * bf_lo(b4.y), v0[3] * bf_hi(b4.y));
                        w.z = cvt_pk_bf16(v1[0] * bf_lo(b4.z), v1[1] * bf_hi(b4.z)); w.w = cvt_pk_bf16(v1[2] * bf_lo(b4.w), v1[3] * bf_hi(b4.w));
                        *(u32x4*)(MG + (size_t)(row0 + ai * HALF + m * 16) * D + col0 + bj * HALF) = w; }
        }
    }
};
struct EpiBf16P {
    static constexpr bool PERM = true, AFTER_DRAIN = false;
    bf16_t* C; int ldc;
    __device__ __forceinline__ void operator()(const f32x4 (&acc)[2][2][4][2], const Unit& u, int wr, int wc, int fr, int fq) const {
        const int row0 = u.pm * BM + wr * 64 + fr, col0 = u.pn * BM + wc * 32 + 8 * fq;
#pragma unroll
        for (int ai = 0; ai < 2; ++ai)
#pragma unroll
            for (int m = 0; m < 4; ++m) { bf16_t* rowp = C + (size_t)(row0 + ai * HALF + m * 16) * ldc + col0;
#pragma unroll
                for (int bj = 0; bj < 2; ++bj) { const f32x4 v0 = acc[ai][bj][m][0], v1 = acc[ai][bj][m][1];
                    u32x4 w; w.x = cvt_pk_bf16(v0[0], v0[1]); w.y = cvt_pk_bf16(v0[2], v0[3]); w.z = cvt_pk_bf16(v1[0], v1[1]); w.w = cvt_pk_bf16(v1[2], v1[3]);
                    *(u32x4*)(rowp + bj * HALF) = w; } }
    }
};
#ifndef PG8_B_AUX
#define PG8_B_AUX 0
#endif
template <class Epi, class Sched, bool ALIGN_EPI = false, bool SP2 = false>
__device__ __forceinline__ void gemm_phase(PG8_LAS unsigned char* lds, const Gemm g, const Sched& S, const Epi& E) {
    const int tid = threadIdx.x, wid = __builtin_amdgcn_readfirstlane(tid >> 6), lane = tid & 63, wr = wid >> 2, wc = wid & 3, fr = lane & 15, fq = lane >> 4;
    const int K = g.K, nt = K / BK;
    unsigned voffA[2], voffB[2];
#pragma unroll
    for (int i = 0; i < 2; ++i) { int R, C; stage_rc(tid * 16 + i * 8192, R, C); const int Rb = Epi::PERM ? ((R & ~31) + perm32(R & 31)) : R;
        voffA[i] = (unsigned)(R * K + C) * 2u; voffB[i] = (unsigned)(Rb * K + C) * 2u; }
    const size_t kstep = (size_t)(BK * 2);
    const size_t hstep = (size_t)HALF * K * 2;
    const size_t tstep = 2 * hstep;
    const unsigned ldsw = (unsigned)wid * 1024u;
    const int aoff = lds_byte(wr * 64 + fr, fq * 8), boff = lds_byte(wc * 32 + fr, fq * 8);
#define PG8_SA(b, h) (((b) * 2 + (h)) * HTB)
#define PG8_SB(b, h) ((4 + (b) * 2 + (h)) * HTB)
#define PG8_STAGE(bufoff, gbase, voff) do { _Pragma("unroll") for (int _i = 0; _i < 2; ++_i) \
        __builtin_amdgcn_global_load_lds((const unsigned*)((const char*)(gbase) + (voff)[_i]), (PG8_LAS unsigned*)(lds + (bufoff) + ldsw + _i * 8192), 16, 0, ((bufoff) >= 4 * HTB) ? PG8_B_AUX : 0); } while (0)
#define PG8_LDA(dst, b, h) do { _Pragma("unroll") for (int m = 0; m < 4; ++m) _Pragma("unroll") for (int k = 0; k < 2; ++k) dst[m][k] = *(const PG8_LAS bf16x8*)(lds + PG8_SA(b, h) + aoff + m * 2048 + k * 1024); } while (0)
#define PG8_LDB(dst, b, h) do { _Pragma("unroll") for (int n = 0; n < 2; ++n) _Pragma("unroll") for (int k = 0; k < 2; ++k) dst[n][k] = *(const PG8_LAS bf16x8*)(lds + PG8_SB(b, h) + boff + n * 2048 + k * 1024); } while (0)
#define PG8_MMA(ai, bj, At, Bt) do { __builtin_amdgcn_s_setprio(1); _Pragma("unroll") for (int m = 0; m < 4; ++m) _Pragma("unroll") for (int n = 0; n < 2; ++n) _Pragma("unroll") for (int k = 0; k < 2; ++k) \
        acc[ai][bj][m][n] = __builtin_amdgcn_mfma_f32_16x16x32_bf16(Bt[n][k], At[m][k], acc[ai][bj][m][n], 0, 0, 0); __builtin_amdgcn_s_setprio(0); } while (0)
#define PG8_WAIT_V(n) asm volatile("s_waitcnt vmcnt(" #n ")" ::: "memory")
#define PG8_WAIT_L(n) asm volatile("s_waitcnt lgkmcnt(" #n ")" ::: "memory")
#define PG8_BAR __builtin_amdgcn_s_barrier()
#define PG8_SCHED __builtin_amdgcn_sched_barrier(0)
    Unit cur, nxt; int ui = 0;
    if (!S.next(0, cur)) return;
    f32x4 acc[2][2][4][2];
#pragma unroll
    for (int a = 0; a < 2; ++a)
#pragma unroll
        for (int b = 0; b < 2; ++b)
#pragma unroll
            for (int m = 0; m < 4; ++m)
#pragma unroll
                for (int n = 0; n < 2; ++n) acc[a][b][m][n] = (f32x4){0.f, 0.f, 0.f, 0.f};
    bf16x8 At[4][2], B0[2][2], B1[2][2];
    const char* cA = (const char*)g.A + (size_t)cur.pm * tstep; const char* cB = (const char*)g.Bt + (size_t)cur.pn * tstep;
    S.a_ready(cur);
    if constexpr (SP2) {
        PG8_STAGE(PG8_SB(0, 0), cB, voffB); PG8_STAGE(PG8_SB(0, 1), cB + hstep, voffB); PG8_STAGE(PG8_SA(0, 0), cA, voffA); PG8_STAGE(PG8_SA(0, 1), cA + hstep, voffA);
        if (wr == 1) PG8_BAR;
        PG8_WAIT_V(2); PG8_BAR;
        PG8_STAGE(PG8_SB(1, 0), cB + kstep, voffB); PG8_STAGE(PG8_SA(1, 0), cA + kstep, voffA); PG8_STAGE(PG8_SB(1, 1), cB + hstep + kstep, voffB);
        PG8_WAIT_V(6); PG8_BAR;
    } else {
        PG8_STAGE(PG8_SB(0, 0), cB, voffB); PG8_STAGE(PG8_SA(0, 0), cA, voffA); PG8_STAGE(PG8_SB(0, 1), cB + hstep, voffB); PG8_STAGE(PG8_SA(0, 1), cA + hstep, voffA);
        if (wr == 1) PG8_BAR;
        PG8_WAIT_V(4); PG8_BAR;
        PG8_STAGE(PG8_SB(1, 0), cB + kstep, voffB); PG8_STAGE(PG8_SA(1, 0), cA + kstep, voffA); PG8_STAGE(PG8_SB(1, 1), cB + hstep + kstep, voffB);
        PG8_WAIT_V(6); PG8_BAR;
    }
    for (;;) {
        const bool has_next = S.next(ui + 1, nxt);
        const char* nA = has_next ? (const char*)g.A + (size_t)nxt.pm * tstep : cA; const char* nB = has_next ? (const char*)g.Bt + (size_t)nxt.pn * tstep : cB;
        for (int t = 0; t < nt; t += 2) {
            const bool last = (t == nt - 2);
            const char* a1 = cA + (size_t)(t + 1) * kstep;
            const char* a2 = last ? nA : cA + (size_t)(t + 2) * kstep; const char* b2 = last ? nB : cB + (size_t)(t + 2) * kstep;
            const char* a3 = a2 + kstep; const char* b3 = b2 + kstep;
            if (last && has_next) S.a_ready(nxt);
            if constexpr (SP2) {
            PG8_LDB(B0, 0, 0); PG8_LDB(B1, 0, 1); PG8_SCHED; PG8_LDA(At, 0, 0); PG8_STAGE(PG8_SA(1, 1), a1 + hstep, voffA);
            PG8_WAIT_V(8); PG8_WAIT_L(0); PG8_BAR; PG8_MMA(0, 0, At, B0); PG8_MMA(0, 1, At, B1); PG8_BAR; PG8_SCHED;
            PG8_LDA(At, 0, 1); PG8_STAGE(PG8_SB(0, 0), b2, voffB); PG8_STAGE(PG8_SB(0, 1), b2 + hstep, voffB); PG8_STAGE(PG8_SA(0, 0), a2, voffA);
            PG8_WAIT_V(8); PG8_WAIT_L(0); PG8_BAR; PG8_MMA(1, 0, At, B0); PG8_MMA(1, 1, At, B1); PG8_BAR; PG8_SCHED;
            PG8_LDB(B0, 1, 0); PG8_LDB(B1, 1, 1); PG8_SCHED; PG8_LDA(At, 1, 0); PG8_STAGE(PG8_SA(0, 1), a2 + hstep, voffA);
            PG8_WAIT_V(8); PG8_WAIT_L(0); PG8_BAR; PG8_MMA(0, 0, At, B0); PG8_MMA(0, 1, At, B1); PG8_BAR; PG8_SCHED;
            PG8_LDA(At, 1, 1); PG8_STAGE(PG8_SB(1, 0), b3, voffB); PG8_STAGE(PG8_SB(1, 1), b3 + hstep, voffB); PG8_STAGE(PG8_SA(1, 0), a3, voffA);
            PG8_WAIT_V(8); PG8_WAIT_L(0); PG8_BAR; PG8_MMA(1, 0, At, B0); PG8_MMA(1, 1, At, B1); PG8_BAR; PG8_SCHED;
            } else {
            PG8_LDB(B0, 0, 0); PG8_SCHED; PG8_LDA(At, 0, 0); PG8_STAGE(PG8_SA(1, 1), a1 + hstep, voffA);
            PG8_WAIT_L(8); PG8_BAR; PG8_WAIT_L(0); PG8_MMA(0, 0, At, B0); PG8_BAR; PG8_SCHED;
            PG8_LDB(B1, 0, 1); PG8_STAGE(PG8_SB(0, 0), b2, voffB);
            PG8_BAR; PG8_WAIT_L(0); PG8_MMA(0, 1, At, B1); PG8_BAR;
            PG8_LDA(At, 0, 1); PG8_STAGE(PG8_SA(0, 0), a2, voffA);
            PG8_BAR; PG8_WAIT_L(0); PG8_MMA(1, 0, At, B0); PG8_BAR; PG8_SCHED;
            PG8_STAGE(PG8_SB(0, 1), b2 + hstep, voffB);
            PG8_WAIT_V(6); PG8_BAR; PG8_MMA(1, 1, At, B1); PG8_BAR;
            PG8_LDB(B0, 1, 0); PG8_SCHED; PG8_LDA(At, 1, 0); PG8_STAGE(PG8_SA(0, 1), a2 + hstep, voffA);
            PG8_WAIT_L(8); PG8_BAR; PG8_WAIT_L(0); PG8_MMA(0, 0, At, B0); PG8_BAR; PG8_SCHED;
            PG8_LDB(B1, 1, 1); PG8_STAGE(PG8_SB(1, 0), b3, voffB);
            PG8_BAR; PG8_WAIT_L(0); PG8_MMA(0, 1, At, B1); PG8_BAR;
            PG8_LDA(At, 1, 1); PG8_STAGE(PG8_SA(1, 0), a3, voffA);
            PG8_BAR; PG8_WAIT_L(0); PG8_MMA(1, 0, At, B0); PG8_BAR; PG8_SCHED;
            PG8_STAGE(PG8_SB(1, 1), b3 + hstep, voffB);
            PG8_WAIT_V(6); PG8_BAR; PG8_MMA(1, 1, At, B1); PG8_BAR;
            }
        }
        if constexpr (ALIGN_EPI) { if (wr == 0) PG8_BAR; }
        if constexpr (!Epi::AFTER_DRAIN) { E(acc, cur, wr, wc, fr, fq); S.done(cur); }
        if (!has_next) break;
#pragma unroll
        for (int a = 0; a < 2; ++a)
#pragma unroll
            for (int b = 0; b < 2; ++b)
#pragma unroll
                for (int m = 0; m < 4; ++m)
#pragma unroll
                    for (int n = 0; n < 2; ++n) acc[a][b][m][n] = (f32x4){0.f, 0.f, 0.f, 0.f};
        cur = nxt; cA = nA; cB = nB; ++ui;
        if constexpr (ALIGN_EPI) { if (wr == 1) PG8_BAR; }
    }
    PG8_WAIT_V(0);
    if constexpr (!ALIGN_EPI) { if (wr == 0) PG8_BAR; }
    PG8_BAR;
    if constexpr (Epi::AFTER_DRAIN) { E.fused(acc, cur, wr, wc, fr, fq, lds, wid, lane); S.done(cur); }
#undef PG8_SA
#undef PG8_SB
#undef PG8_STAGE
#undef PG8_LDA
#undef PG8_LDB
#undef PG8_MMA
#undef PG8_WAIT_V
#undef PG8_WAIT_L
#undef PG8_BAR
#undef PG8_SCHED
}
struct GemmChain { const bf16_t* A; const bf16_t* Bt; size_t segA, segB; int M, N, K; };
struct ChainOrder : StaticOrder {
    __host__ __device__ bool next(int i, Unit& u) const { const int ti = i / 3; if (!StaticOrder::next(ti, u)) return false; u.seg = i - 3 * ti; return true; }
};
template <class Epi, class Sched, bool ALIGN_EPI = false, bool SP2 = false>
__device__ __forceinline__ void gemm_chain(PG8_LAS unsigned char* lds, const GemmChain g, const Sched& S, const Epi& E) {
    const int tid = threadIdx.x, wid = __builtin_amdgcn_readfirstlane(tid >> 6), lane = tid & 63, wr = wid >> 2, wc = wid & 3, fr = lane & 15, fq = lane >> 4;
    const int K = g.K, nt = K / BK;
    unsigned voffA[2], voffB[2];
#pragma unroll
    for (int i = 0; i < 2; ++i) { int R, C; stage_rc(tid * 16 + i * 8192, R, C); const int Rb = Epi::PERM ? ((R & ~31) + perm32(R & 31)) : R;
        voffA[i] = (unsigned)(R * K + C) * 2u; voffB[i] = (unsigned)(Rb * K + C) * 2u; }
    const size_t kstep = (size_t)(BK * 2);
    const size_t hstep = (size_t)HALF * K * 2;
    const size_t tstep = 2 * hstep;
    const unsigned ldsw = (unsigned)wid * 1024u;
    const int aoff = lds_byte(wr * 64 + fr, fq * 8), boff = lds_byte(wc * 32 + fr, fq * 8);
#define PG8_SA(b, h) (((b) * 2 + (h)) * HTB)
#define PG8_SB(b, h) ((4 + (b) * 2 + (h)) * HTB)
#define PG8_STAGE(bufoff, gbase, voff) do { _Pragma("unroll") for (int _i = 0; _i < 2; ++_i) \
        __builtin_amdgcn_global_load_lds((const unsigned*)((const char*)(gbase) + (voff)[_i]), (PG8_LAS unsigned*)(lds + (bufoff) + ldsw + _i * 8192), 16, 0, 0); } while (0)
#define PG8_LDA(dst, b, h) do { _Pragma("unroll") for (int m = 0; m < 4; ++m) _Pragma("unroll") for (int k = 0; k < 2; ++k) dst[m][k] = *(const PG8_LAS bf16x8*)(lds + PG8_SA(b, h) + aoff + m * 2048 + k * 1024); } while (0)
#define PG8_LDB(dst, b, h) do { _Pragma("unroll") for (int n = 0; n < 2; ++n) _Pragma("unroll") for (int k = 0; k < 2; ++k) dst[n][k] = *(const PG8_LAS bf16x8*)(lds + PG8_SB(b, h) + boff + n * 2048 + k * 1024); } while (0)
#define PG8_MMA(ai, bj, At, Bt) do { __builtin_amdgcn_s_setprio(1); _Pragma("unroll") for (int m = 0; m < 4; ++m) _Pragma("unroll") for (int n = 0; n < 2; ++n) _Pragma("unroll") for (int k = 0; k < 2; ++k) \
        acc[ai][bj][m][n] = __builtin_amdgcn_mfma_f32_16x16x32_bf16(Bt[n][k], At[m][k], acc[ai][bj][m][n], 0, 0, 0); __builtin_amdgcn_s_setprio(0); } while (0)
#define PG8_WAIT_V(n) asm volatile("s_waitcnt vmcnt(" #n ")" ::: "memory")
#define PG8_WAIT_L(n) asm volatile("s_waitcnt lgkmcnt(" #n ")" ::: "memory")
#define PG8_BAR __builtin_amdgcn_s_barrier()
#define PG8_SCHED __builtin_amdgcn_sched_barrier(0)
    Unit cur, nxt; int ui = 0;
    if (!S.next(0, cur)) return;
    f32x4 acc[2][2][4][2];
#pragma unroll
    for (int a = 0; a < 2; ++a)
#pragma unroll
        for (int b = 0; b < 2; ++b)
#pragma unroll
            for (int m = 0; m < 4; ++m)
#pragma unroll
                for (int n = 0; n < 2; ++n) acc[a][b][m][n] = (f32x4){0.f, 0.f, 0.f, 0.f};
    bf16x8 At[4][2], B0[2][2], B1[2][2];
    const char* cA = (const char*)(g.A + (size_t)cur.seg * g.segA) + (size_t)cur.pm * tstep; const char* cB = (const char*)(g.Bt + (size_t)cur.seg * g.segB) + (size_t)cur.pn * tstep;
    S.a_ready(cur);
    if constexpr (SP2) {
        PG8_STAGE(PG8_SB(0, 0), cB, voffB); PG8_STAGE(PG8_SB(0, 1), cB + hstep, voffB); PG8_STAGE(PG8_SA(0, 0), cA, voffA); PG8_STAGE(PG8_SA(0, 1), cA + hstep, voffA);
        if (wr == 1) PG8_BAR;
        PG8_WAIT_V(2); PG8_BAR;
        PG8_STAGE(PG8_SB(1, 0), cB + kstep, voffB); PG8_STAGE(PG8_SA(1, 0), cA + kstep, voffA); PG8_STAGE(PG8_SB(1, 1), cB + hstep + kstep, voffB);
        PG8_WAIT_V(6); PG8_BAR;
    } else {
        PG8_STAGE(PG8_SB(0, 0), cB, voffB); PG8_STAGE(PG8_SA(0, 0), cA, voffA); PG8_STAGE(PG8_SB(0, 1), cB + hstep, voffB); PG8_STAGE(PG8_SA(0, 1), cA + hstep, voffA);
        if (wr == 1) PG8_BAR;
        PG8_WAIT_V(4); PG8_BAR;
        PG8_STAGE(PG8_SB(1, 0), cB + kstep, voffB); PG8_STAGE(PG8_SA(1, 0), cA + kstep, voffA); PG8_STAGE(PG8_SB(1, 1), cB + hstep + kstep, voffB);
        PG8_WAIT_V(6); PG8_BAR;
    }
    for (;;) {
        const bool has_next = S.next(ui + 1, nxt);
        const char* nA = has_next ? (const char*)(g.A + (size_t)nxt.seg * g.segA) + (size_t)nxt.pm * tstep : cA; const char* nB = has_next ? (const char*)(g.Bt + (size_t)nxt.seg * g.segB) + (size_t)nxt.pn * tstep : cB;
        for (int t = 0; t < nt; t += 2) {
            const bool last = (t == nt - 2);
            const char* a1 = cA + (size_t)(t + 1) * kstep;
            const char* a2 = last ? nA : cA + (size_t)(t + 2) * kstep; const char* b2 = last ? nB : cB + (size_t)(t + 2) * kstep;
            const char* a3 = a2 + kstep; const char* b3 = b2 + kstep;
            if (last && has_next) S.a_ready(nxt);
            if constexpr (SP2) {
            PG8_LDB(B0, 0, 0); PG8_LDB(B1, 0, 1); PG8_SCHED; PG8_LDA(At, 0, 0); PG8_STAGE(PG8_SA(1, 1), a1 + hstep, voffA);
            PG8_WAIT_V(8); PG8_WAIT_L(0); PG8_BAR; PG8_MMA(0, 0, At, B0); PG8_MMA(0, 1, At, B1); PG8_BAR; PG8_SCHED;
            PG8_LDA(At, 0, 1); PG8_STAGE(PG8_SB(0, 0), b2, voffB); PG8_STAGE(PG8_SB(0, 1), b2 + hstep, voffB); PG8_STAGE(PG8_SA(0, 0), a2, voffA);
            PG8_WAIT_V(8); PG8_WAIT_L(0); PG8_BAR; PG8_MMA(1, 0, At, B0); PG8_MMA(1, 1, At, B1); PG8_BAR; PG8_SCHED;
            PG8_LDB(B0, 1, 0); PG8_LDB(B1, 1, 1); PG8_SCHED; PG8_LDA(At, 1, 0); PG8_STAGE(PG8_SA(0, 1), a2 + hstep, voffA);
            PG8_WAIT_V(8); PG8_WAIT_L(0); PG8_BAR; PG8_MMA(0, 0, At, B0); PG8_MMA(0, 1, At, B1); PG8_BAR; PG8_SCHED;
            PG8_LDA(At, 1, 1); PG8_STAGE(PG8_SB(1, 0), b3, voffB); PG8_STAGE(PG8_SB(1, 1), b3 + hstep, voffB); PG8_STAGE(PG8_SA(1, 0), a3, voffA);
            PG8_WAIT_V(8); PG8_WAIT_L(0); PG8_BAR; PG8_MMA(1, 0, At, B0); PG8_MMA(1, 1, At, B1); PG8_BAR; PG8_SCHED;
            } else {
            PG8_LDB(B0, 0, 0); PG8_SCHED; PG8_LDA(At, 0, 0); PG8_STAGE(PG8_SA(1, 1), a1 + hstep, voffA);
            PG8_WAIT_L(8); PG8_BAR; PG8_WAIT_L(0); PG8_MMA(0, 0, At, B0); PG8_BAR; PG8_SCHED;
            PG8_LDB(B1, 0, 1); PG8_STAGE(PG8_SB(0, 0), b2, voffB);
            PG8_BAR; PG8_WAIT_L(0); PG8_MMA(0, 1, At, B1); PG8_BAR;
            PG8_LDA(At, 0, 1); PG8_STAGE(PG8_SA(0, 0), a2, voffA);
            PG8_BAR; PG8_WAIT_L(0); PG8_MMA(1, 0, At, B0); PG8_BAR; PG8_SCHED;
            PG8_STAGE(PG8_SB(0, 1), b2 + hstep, voffB);
            PG8_WAIT_V(6); PG8_BAR; PG8_MMA(1, 1, At, B1); PG8_BAR;
            PG8_LDB(B0, 1, 0); PG8_SCHED; PG8_LDA(At, 1, 0); PG8_STAGE(PG8_SA(0, 1), a2 + hstep, voffA);
            PG8_WAIT_L(8); PG8_BAR; PG8_WAIT_L(0); PG8_MMA(0, 0, At, B0); PG8_BAR; PG8_SCHED;
            PG8_LDB(B1, 1, 1); PG8_STAGE(PG8_SB(1, 0), b3, voffB);
            PG8_BAR; PG8_WAIT_L(0); PG8_MMA(0, 1, At, B1); PG8_BAR;
            PG8_LDA(At, 1, 1); PG8_STAGE(PG8_SA(1, 0), a3, voffA);
            PG8_BAR; PG8_WAIT_L(0); PG8_MMA(1, 0, At, B0); PG8_BAR; PG8_SCHED;
            PG8_STAGE(PG8_SB(1, 1), b3 + hstep, voffB);
            PG8_WAIT_V(6); PG8_BAR; PG8_MMA(1, 1, At, B1); PG8_BAR;
            }
        }
        if constexpr (ALIGN_EPI) { if (wr == 0) PG8_BAR; }
        if constexpr (!Epi::AFTER_DRAIN) { E(acc, cur, wr, wc, fr, fq); S.done(cur); }
        if (!has_next) break;
        if (nxt.seg == 0)
#pragma unroll
        for (int a = 0; a < 2; ++a)
#pragma unroll
            for (int b = 0; b < 2; ++b)
#pragma unroll
                for (int m = 0; m < 4; ++m)
#pragma unroll
                    for (int n = 0; n < 2; ++n) acc[a][b][m][n] = (f32x4){0.f, 0.f, 0.f, 0.f};
        cur = nxt; cA = nA; cB = nB; ++ui;
        if constexpr (ALIGN_EPI) { if (wr == 1) PG8_BAR; }
    }
    PG8_WAIT_V(0);
    if constexpr (!ALIGN_EPI) { if (wr == 0) PG8_BAR; }
    PG8_BAR;
    if constexpr (Epi::AFTER_DRAIN) { E.fused(acc, cur, wr, wc, fr, fq, lds, wid, lane); S.done(cur); }
#undef PG8_SA
#undef PG8_SB
#undef PG8_STAGE
#undef PG8_LDA
#undef PG8_LDB
#undef PG8_MMA
#undef PG8_WAIT_V
#undef PG8_WAIT_L
#undef PG8_BAR
#undef PG8_SCHED
}
}
#ifndef MK_ONE_LAUNCH
#define MK_ONE_LAUNCH 1
#endif
constexpr int NWAVES = 8, NTHREADS = NWAVES * 64;
constexpr int N_PHASES = 9;
constexpr size_t MiB = 1u << 20;
constexpr size_t WS_CTL = 0, CTL_ZERO_BYTES = 32 * 1024 + 36 * 6144 * 4;
constexpr size_t WS_MOD = 32 * 1024;
constexpr size_t WS_WIN = 2 * MiB;
constexpr size_t WS_WPA = 94 * MiB;
constexpr size_t WS_WPB = 110 * MiB;
constexpr size_t WS_WOUT = 118 * MiB;
constexpr size_t WS_H = 126 * MiB;
constexpr size_t WS_QKV = 159 * MiB;
constexpr size_t WS_Z = 291 * MiB;
constexpr size_t WS_BQ = 357 * MiB;
constexpr size_t WS_BZ = 390 * MiB;
constexpr size_t WS_IQ = 423 * MiB;
constexpr size_t WS_GA = 456 * MiB, WS_GB = 489 * MiB;
constexpr size_t WS_IK = 522 * MiB;
constexpr size_t WS_BETA = 525 * MiB, WS_GG = 527 * MiB, WS_IW = 529 * MiB;
constexpr size_t WS_YA = 530 * MiB;
constexpr size_t WS_YB = 596 * MiB;
constexpr size_t WS_SC = 629 * MiB;
constexpr size_t WS_SCS = 693 * MiB;
constexpr size_t WS_SEL = 702 * MiB;
constexpr size_t WS_CNT = 711 * MiB;
constexpr size_t WS_TMP = 712 * MiB;
constexpr size_t WS_MG = 778 * MiB;
constexpr size_t WS_OUTF = 811 * MiB;
constexpr size_t WS_QNP = 712 * MiB, WS_KNP = 744 * MiB, WS_KTP = 776 * MiB, WS_VTP = 808 * MiB;
constexpr size_t WS_FR = 877 * MiB;
constexpr size_t WS_QNS = 1171 * MiB, WS_KNS = 1179 * MiB, WS_KTS = 1187 * MiB, WS_VTS = 1195 * MiB;
constexpr size_t WS_END = 1211 * MiB;
constexpr size_t WS_BKV = 1162 * MiB;
static_assert(WS_WIN + (size_t)NPAD * D * 2 <= WS_WPA && WS_H + (size_t)MROWS * D * 2 <= WS_QKV && WS_QKV + (size_t)MROWS * 8192 * 2 <= WS_Z && WS_Z + (size_t)MROWS * 4096 * 2 <= WS_BQ, "ws map");
static_assert(WS_SC + (size_t)MP * 2048 * 4 <= WS_SCS && WS_SCS + (size_t)MS * SCS_LD * 4 <= WS_SEL && WS_SEL + (size_t)MROWS * 256 * 4 <= WS_CNT && WS_TMP + (size_t)MROWS * D * 4 <= WS_MG && WS_OUTF + (size_t)MROWS * D * 4 <= WS_END, "ws map 2");
constexpr int CW_BAR = 4096;
constexpr int CW_Q0 = 32;
constexpr int CW_ATTQ = 64;
constexpr int RING_BYTES = 147456;
constexpr int LDSCTL_OFF = RING_BYTES, MISC_OFF = LDSCTL_OFF + 320;
constexpr int LDS_BYTES = 151552;

#define GAS __attribute__((address_space(1)))
#define LAS __attribute__((address_space(3)))
typedef unsigned short bf16;
typedef unsigned v4u __attribute__((ext_vector_type(4)));
typedef unsigned v2u __attribute__((ext_vector_type(2)));
typedef float f32x4 __attribute__((ext_vector_type(4)));
typedef short bf16x8 __attribute__((ext_vector_type(8)));
typedef short s16x4 __attribute__((ext_vector_type(4)));
typedef GAS unsigned gu32;
#define LDS_WAIT() asm volatile("s_waitcnt lgkmcnt(0)" ::: "memory")
#define VM_WAIT() asm volatile("s_waitcnt vmcnt(0)" ::: "memory")
__device__ __forceinline__ float bf2f(bf16 v) { return __uint_as_float(((unsigned)v) << 16); }
__device__ __forceinline__ unsigned pk2(float lo, float hi) { return pg8::cvt_pk_bf16(lo, hi); }
__device__ __forceinline__ bf16 f2bf(float f) { return (bf16)(pg8::cvt_pk_bf16(f, 0.f) & 0xffffu); }
__device__ __forceinline__ float wave_sum(float v) {
#pragma unroll
    for (int o = 1; o < 64; o <<= 1) v += __shfl_xor(v, o);
    return v;
}
__device__ __forceinline__ float row16_sum(float v) {
    v += __builtin_bit_cast(float, __builtin_amdgcn_mov_dpp(__builtin_bit_cast(int, v), 0xB1, 0xf, 0xf, true));
    v += __builtin_bit_cast(float, __builtin_amdgcn_mov_dpp(__builtin_bit_cast(int, v), 0x4E, 0xf, 0xf, true));
    v += __builtin_bit_cast(float, __builtin_amdgcn_mov_dpp(__builtin_bit_cast(int, v), 0x141, 0xf, 0xf, true));
    v += __builtin_bit_cast(float, __builtin_amdgcn_mov_dpp(__builtin_bit_cast(int, v), 0x140, 0xf, 0xf, true));
    return v;
}
__device__ __forceinline__ unsigned dpp_swap1(unsigned v) { return (unsigned)__builtin_amdgcn_mov_dpp((int)v, 0xB1, 0xf, 0xf, true); }
__device__ __forceinline__ int wave_sum_i(int v) {
#pragma unroll
    for (int o = 1; o < 64; o <<= 1) v += __shfl_xor(v, o);
    return v;
}

#define XB_TMO      128
#define XB_XCNT(j)  (256  + 64 * (j))
#define XB_XSUB(j)  (1280 + 64 * (j))
#define XB_XGEN(j)  (2304 + 64 * (j))
#define XB_TOP      3328
#define XB_TOPGEN   3392
#define XCD_BAR_WORDS 3456
#define XB_SPIN_CAP (1u << 18)
__device__ __forceinline__ unsigned xb_ld(unsigned* p)              { return __hip_atomic_load(p, __ATOMIC_RELAXED, __HIP_MEMORY_SCOPE_AGENT); }
__device__ __forceinline__ unsigned xb_add(unsigned* p, unsigned v) { return __hip_atomic_fetch_add(p, v, __ATOMIC_RELAXED, __HIP_MEMORY_SCOPE_AGENT); }
__device__ __forceinline__ unsigned xb_xcc_id() { return (unsigned)__builtin_amdgcn_s_getreg((3 << 11) | 20) & 0xFu; }
#define XB_SPIN(cond, bar) do { unsigned _sp = 0; while (cond) { __builtin_amdgcn_s_sleep(1); \
    if ((++_sp & 255u) == 0u) { if (xb_ld(&(bar)[XB_TMO])) break; if (_sp > XB_SPIN_CAP) { atomicAdd(&(bar)[XB_TMO], 1u); break; } } } } while (0)
struct XcdBarrier { unsigned* bar; unsigned x; volatile LAS unsigned* st; };
__device__ __forceinline__ XcdBarrier xcd_barrier_post(unsigned* bar, volatile LAS unsigned* st) {
    XcdBarrier b; b.bar = bar; b.x = xb_xcc_id(); b.st = st;
    if (threadIdx.x == 0) (void)xb_add(&bar[XB_XCNT(b.x)], 1u);
    return b;
}
__device__ __forceinline__ void xcd_barrier_complete(unsigned* bar, unsigned x, unsigned& nloc, unsigned& nx) {
    const unsigned G = gridDim.x * gridDim.y * gridDim.z;
    unsigned sum, cnt, mine, sp = 0u;
    for (;;) {
        sum = 0u; cnt = 0u; mine = 0u;
#pragma unroll
        for (unsigned j = 0; j < 16; ++j) { const unsigned c = xb_ld(&bar[XB_XCNT(j)]); sum += c; cnt += (c > 0u) ? 1u : 0u; mine = (j == x) ? c : mine; }
        if (sum == G) break;
        __builtin_amdgcn_s_sleep(1);
        if ((++sp & 255u) == 0u) { if (xb_ld(&bar[XB_TMO])) break; if (sp > XB_SPIN_CAP) { atomicAdd(&bar[XB_TMO], 1u); break; } }
    }
    nloc = mine > 0u ? mine : 1u; nx = cnt > 0u ? cnt : 1u;
}
__device__ __forceinline__ void xcd_barrier(const XcdBarrier& b) {
    asm volatile("s_waitcnt vmcnt(0)" ::: "memory");
    __syncthreads();
    if (threadIdx.x == 0) {
        unsigned* bar = b.bar;
        __builtin_amdgcn_s_waitcnt(0);
        unsigned nloc = b.st[0], nx = b.st[1];
        if (nloc == 0u) { xcd_barrier_complete(bar, b.x, nloc, nx); b.st[0] = nloc; b.st[1] = nx; }
        const unsigned old = xb_add(&bar[XB_XSUB(b.x)], 1u);
        const unsigned gen = old / nloc;
        if (old + 1u == (gen + 1u) * nloc) {
            __builtin_amdgcn_fence(__ATOMIC_RELEASE, "agent");
            asm volatile("s_waitcnt vmcnt(0)" ::: "memory");
            const unsigned og = xb_add(&bar[XB_TOP], 1u);
            const unsigned tg = og / nx;
            if (og + 1u == (tg + 1u) * nx) xb_add(&bar[XB_TOPGEN], 1u);
            else XB_SPIN(xb_ld(&bar[XB_TOPGEN]) == tg, bar);
            __builtin_amdgcn_fence(__ATOMIC_ACQUIRE, "agent");
            xb_add(&bar[XB_XGEN(b.x)], 1u);
            asm volatile("s_waitcnt vmcnt(0)" ::: "memory");
        } else {
            XB_SPIN(xb_ld(&bar[XB_XGEN(b.x)]) == gen, bar);
            __builtin_amdgcn_fence(__ATOMIC_ACQUIRE, "agent");
            asm volatile("s_waitcnt vmcnt(0)" ::: "memory");
        }
    }
    __syncthreads();
}

struct Args {
    const float *x_p, *x_s, *c_p, *c_s, *cache_k, *cache_v, *cache_kidx, *state_gdn, *state_conv; const int* page_table;
    const float *w_ada, *b_ada, *pre_g, *w_in, *conv_w, *a_log, *dt_bias, *gdn_g, *w_pa, *w_pb, *w_out, *post_g;
    float* out; unsigned char* ws; int ph_lo, ph_hi;
};
static_assert(sizeof(Args) == 24 * 8 + 8, "Args has no padding");
template <int OFF> __device__ __forceinline__ const void* karg_ptr() {
    unsigned long long v; const unsigned long long kp = (unsigned long long)__builtin_amdgcn_kernarg_segment_ptr();
    asm volatile("s_load_dwordx2 %0, %1, %2\n\ts_waitcnt lgkmcnt(0)" : "=s"(v) : "s"(kp), "n"(OFF));
    return (const void*)(const __attribute__((address_space(1))) void*)v;
}
#define KARG(A, f) (A).f = (decltype((A).f))karg_ptr<(int)__builtin_offsetof(Args, f)>()
__device__ __forceinline__ Args load_args(int lo, int hi) {
    Args A;
    KARG(A, x_p); KARG(A, x_s); KARG(A, c_p); KARG(A, c_s); KARG(A, cache_k); KARG(A, cache_v); KARG(A, cache_kidx); KARG(A, state_gdn); KARG(A, state_conv); KARG(A, page_table);
    KARG(A, w_ada); KARG(A, b_ada); KARG(A, pre_g); KARG(A, w_in); KARG(A, conv_w); KARG(A, a_log); KARG(A, dt_bias); KARG(A, gdn_g); KARG(A, w_pa); KARG(A, w_pb); KARG(A, w_out); KARG(A, post_g);
    KARG(A, out); KARG(A, ws); A.ph_lo = lo; A.ph_hi = hi;
    return A;
}


__device__ __forceinline__ void transpose_item(const float* W, int Nsrc, int K, bf16* WT, int n0, int k0, bool remap, LAS float* scr, int lane) {
    const int nl = lane & 31, nd = n0 + nl, sc = remap ? win_src_col(nd) : nd;
#pragma unroll 8
    for (int i = 0; i < 32; ++i) { const int kk = 2 * i + (lane >> 5); const float vl = __builtin_nontemporal_load(W + (size_t)(k0 + kk) * Nsrc + (sc >= 0 ? sc : 0)); scr[kk * 33 + nl] = sc >= 0 ? vl : 0.f; }
    LDS_WAIT(); asm volatile("" ::: "memory");
    const int c = lane & 7;
#pragma unroll
    for (int j = 0; j < 4; ++j) { const int n = (lane >> 3) + 8 * j; const LAS float* s = scr + (8 * c) * 33 + n;
        v4u o; o.x = pk2(s[0 * 33], s[1 * 33]); o.y = pk2(s[2 * 33], s[3 * 33]); o.z = pk2(s[4 * 33], s[5 * 33]); o.w = pk2(s[6 * 33], s[7 * 33]);
        *(GAS v4u*)(WT + (size_t)(n0 + n) * K + k0 + 8 * c) = o; }
    LDS_WAIT(); asm volatile("" ::: "memory");
}
__device__ __forceinline__ void win_tr_load(const float* W, int n0, int k0, float (&v)[32], int lane) {
    const int sc = win_src_col(n0 + (lane & 31)); const float* p = W + (size_t)(k0 + (lane >> 5)) * NIN + (sc >= 0 ? sc : 0);
#pragma unroll
    for (int i = 0; i < 32; ++i) v[i] = __builtin_nontemporal_load(p + (size_t)(2 * i) * NIN);
}
__device__ __forceinline__ void win_tr_store(const float (&v)[32], bf16* WT, int n0, int k0, LAS float* scr, int lane) {
    const int nl = lane & 31; const bool ok = win_src_col(n0 + nl) >= 0;
#pragma unroll
    for (int i = 0; i < 32; ++i) scr[(2 * i + (lane >> 5)) * 33 + nl] = ok ? v[i] : 0.f;
    LDS_WAIT(); asm volatile("" ::: "memory");
    const int c = lane & 7;
#pragma unroll
    for (int j = 0; j < 4; ++j) { const int n = (lane >> 3) + 8 * j; const LAS float* s = scr + (8 * c) * 33 + n;
        v4u o; o.x = pk2(s[0 * 33], s[1 * 33]); o.y = pk2(s[2 * 33], s[3 * 33]); o.z = pk2(s[4 * 33], s[5 * 33]); o.w = pk2(s[6 * 33], s[7 * 33]);
        *(GAS v4u*)(WT + (size_t)(n0 + n) * D + k0 + 8 * c) = o; }
    LDS_WAIT(); asm volatile("" ::: "memory");
}
__device__ __forceinline__ void mod_item(const Args& a, float* mod, int item, LAS float* scr, int lane) {
    const int kc = item / 96, cg = item % 96, col = cg * 64 + lane;
    float acc[36];
#pragma unroll
    for (int r = 0; r < 36; ++r) acc[r] = 0.f;
    {
        const int kb = kc * 64;
#pragma unroll 4
        for (int r = 0; r < 36; ++r) { const float cv = (r < 4) ? a.c_p[r * D + kb + lane] : a.c_s[(r - 4) * D + kb + lane]; scr[r * 64 + lane] = cv * __builtin_amdgcn_rcpf(1.0f + __expf(-cv)); }
        LDS_WAIT(); asm volatile("" ::: "memory");
        for (int k4 = 0; k4 < 16; ++k4) {
            const float* wp = a.w_ada + (size_t)(kb + 4 * k4) * 6144 + col;
            const float w0 = __builtin_nontemporal_load(wp), w1 = __builtin_nontemporal_load(wp + 6144), w2 = __builtin_nontemporal_load(wp + 2 * 6144), w3 = __builtin_nontemporal_load(wp + 3 * 6144);
#pragma unroll
            for (int r = 0; r < 36; ++r) { const f32x4 s = *(const LAS f32x4*)(scr + r * 64 + 4 * k4); acc[r] += s[0] * w0 + s[1] * w1 + s[2] * w2 + s[3] * w3; }
        }
        LDS_WAIT(); asm volatile("" ::: "memory");
    }
#pragma unroll
    for (int r = 0; r < 36; ++r) unsafeAtomicAdd(mod + r * 6144 + col, acc[r]);
}

__device__ __forceinline__ unsigned off_b(unsigned row, unsigned ch) { return 256u * row + 16u * (ch ^ (((row & 3) << 2) | ((row >> 2) & 3))); }
__device__ __forceinline__ unsigned tr_read_addr_16(unsigned lane, unsigned c, unsigned t) { const unsigned g = lane >> 4, q = (lane & 15) >> 2, p = lane & 3; return off_b(8 * g + 4 * t + q, 2 * c + (p >> 1)) + 8 * (p & 1); }
__device__ __forceinline__ s16x4 vtr(const LAS unsigned char* p) { return __builtin_bit_cast(s16x4, __builtin_amdgcn_ds_read_tr16_b64_v4i16((LAS s16x4*)p)); }
constexpr int NITEM_P = BP * HV * 32, NITEM_S = BS * HV, NITEM = NITEM_P + NITEM_S;
constexpr int GA_T1 = 0, GA_T2 = 8704, GA_GV = 17408, GA_BV = GA_GV + 256, GA_RK = GA_BV + 256, GA_RQ = GA_RK + 256, GA_WAVE_BYTES = GA_RQ + 256;
constexpr int SC_KI = 0, SC_QF = 16, SC_MF = 32, SC_GF = 40, SC_GF2 = 41, SC_TF = 42, SC_NROW = 50, SC_BUF_BYTES = SC_NROW * 1024, SC_SSQ = 2 * SC_BUF_BYTES, SC_GBASE = 32, SC_GROWS = 18;
__host__ __device__ __forceinline__ int sigma_dk(int t, int r) { return 32 * (t >> 1) + 8 * (r >> 2) + 4 * (t & 1) + (r & 3); }
struct GItem { const bf16 *KN, *QN, *KT, *VT; int Lt, grow, nvalid, id; };
__device__ __forceinline__ GItem gitem_of(const Args& a, int item) {
    GItem I;
    if (item < NITEM_P) { const int c = item & 31, hv = (item >> 5) & 31, b = item >> 10, hq = hv >> 1;
        I.KN = (const bf16*)(a.ws + WS_KNP) + ((size_t)(b * HQK + hq) * LP + 64 * c) * 128; I.QN = (const bf16*)(a.ws + WS_QNP) + ((size_t)(b * HQK + hq) * LP + 64 * c) * 128;
        I.KT = (const bf16*)(a.ws + WS_KTP) + (size_t)(b * HQK + hq) * 128 * LP + 64 * c; I.VT = (const bf16*)(a.ws + WS_VTP) + (size_t)(b * HV + hv) * 128 * LP + 64 * c;
        I.Lt = LP; I.grow = b * LP + 64 * c; I.nvalid = 64; I.id = item; }
    else { const int r = item - NITEM_P, hv = r & 31, b = r >> 5, hq = hv >> 1;
        I.KN = (const bf16*)(a.ws + WS_KNS) + (size_t)(b * HQK + hq) * 64 * 128; I.QN = (const bf16*)(a.ws + WS_QNS) + (size_t)(b * HQK + hq) * 64 * 128;
        I.KT = (const bf16*)(a.ws + WS_KTS) + (size_t)(b * HQK + hq) * 128 * 64; I.VT = (const bf16*)(a.ws + WS_VTS) + (size_t)(b * HV + hv) * 128 * 64;
        I.Lt = 64; I.grow = MP + b * LS; I.nvalid = LS; I.id = item; }
    return I;
}
__device__ __forceinline__ void prep_item(const Args& a, int item, int lane) {
    asm volatile("" : "+v"(lane));
    const bf16* QKV = (const bf16*)(a.ws + WS_QKV);
    const bool sample = item >= BP * 32 * 64;
    int slot, tc, b;
    if (!sample) { slot = item & 63; tc = (item >> 6) & 31; b = item >> 11; } else { const int r = item - BP * 32 * 64; slot = r & 63; tc = 0; b = r >> 6; }
    const int mode = slot < 16 ? 0 : (slot < 32 ? 1 : 2), hd = mode == 0 ? slot : (mode == 1 ? slot - 16 : slot - 32);
    const int ch = (mode == 0 ? 0 : (mode == 1 ? 2048 : 4096)) + hd * 128 + 2 * lane, t0 = tc * 64;
    const int Lt = sample ? 64 : LP, nreal = sample ? LS : 64;
    const size_t rowbase = sample ? (size_t)MP + b * LS : (size_t)b * LP + t0;
    bf16* drow = nullptr; bf16* dtr = nullptr;
    if (mode == 0) drow = (bf16*)(a.ws + (sample ? WS_QNS : WS_QNP)) + ((size_t)(b * HQK + hd) * Lt + t0) * 128;
    else if (mode == 1) drow = (bf16*)(a.ws + (sample ? WS_KNS : WS_KNP)) + ((size_t)(b * HQK + hd) * Lt + t0) * 128;
    else dtr = (bf16*)(a.ws + (sample ? WS_VTS : WS_VTP)) + ((size_t)(b * HV + hd) * 128 + 2 * lane) * Lt + t0;
    const int rpos = 2 * lane;
    float w0[4], w1[4];
#pragma unroll
    for (int i = 0; i < 4; ++i) { w0[i] = a.conv_w[i * CONVCH + ch]; w1[i] = a.conv_w[i * CONVCH + ch + 1]; }
    float xa[3][2];
#pragma unroll
    for (int i = 0; i < 3; ++i) {
        if (sample) { xa[i][0] = a.state_conv[((size_t)b * 3 + i) * CONVCH + ch]; xa[i][1] = a.state_conv[((size_t)b * 3 + i) * CONVCH + ch + 1]; }
        else { const int t = t0 - 3 + i; unsigned u = *(const unsigned*)(QKV + ((size_t)b * LP + (t >= 0 ? t : 0)) * CONVCH + ch); if (t < 0) u = 0u; xa[i][0] = pg8::bf_lo(u); xa[i][1] = pg8::bf_hi(u); }
    }
    unsigned uall[64];
#pragma unroll
    for (int e = 0; e < 64; ++e) { const unsigned ul = __builtin_nontemporal_load((const unsigned*)(QKV + (rowbase + (e < nreal ? e : nreal - 1)) * CONVCH + ch)); uall[e] = e < nreal ? ul : 0u; }
#pragma unroll
    for (int t8 = 0; t8 < 8; ++t8) {
        float y0[8], y1[8];
        if (8 * t8 < nreal) {
#pragma unroll
            for (int e = 0; e < 8; ++e) {
                const float x0 = pg8::bf_lo(uall[8 * t8 + e]), x1 = pg8::bf_hi(uall[8 * t8 + e]);
                float v0 = w0[0] * xa[0][0] + w0[1] * xa[1][0] + w0[2] * xa[2][0] + w0[3] * x0;
                float v1 = w1[0] * xa[0][1] + w1[1] * xa[1][1] + w1[2] * xa[2][1] + w1[3] * x1;
                xa[0][0] = xa[1][0]; xa[0][1] = xa[1][1]; xa[1][0] = xa[2][0]; xa[1][1] = xa[2][1]; xa[2][0] = x0; xa[2][1] = x1;
                v0 = v0 * __builtin_amdgcn_rcpf(1.0f + __expf(-v0)); v1 = v1 * __builtin_amdgcn_rcpf(1.0f + __expf(-v1));
                y0[e] = v0; y1[e] = v1;
            }
        } else {
#pragma unroll
            for (int e = 0; e < 8; ++e) { y0[e] = 0.f; y1[e] = 0.f; }
        }
        if (drow) {
#pragma unroll
            for (int e = 0; e < 8; ++e) *(unsigned*)(drow + (size_t)(8 * t8 + e) * 128 + rpos) = pk2(y0[e], y1[e]);
        }
        if (dtr) {
            v4u p0, p1; p0.x = pk2(y0[0], y0[1]); p0.y = pk2(y0[2], y0[3]); p0.z = pk2(y0[4], y0[5]); p0.w = pk2(y0[6], y0[7]);
            p1.x = pk2(y1[0], y1[1]); p1.y = pk2(y1[2], y1[3]); p1.z = pk2(y1[4], y1[5]); p1.w = pk2(y1[6], y1[7]);
            *(v4u*)(dtr + 8 * t8) = p0; *(v4u*)(dtr + Lt + 8 * t8) = p1;
        }
    }
}
template <int I> __device__ __forceinline__ void subst_row(float (&t)[64], const LAS float* Am, int lane) {
    if constexpr (I < 64) {
        float acc[4] = {(lane == I) ? 1.f : 0.f, 0.f, 0.f, 0.f};
#pragma unroll
        for (int j4 = 0; j4 < (I + 3) / 4; ++j4) { const f32x4 a4 = *(const LAS f32x4*)(Am + I * 68 + 4 * j4);
#pragma unroll
            for (int e = 0; e < 4; ++e) if (4 * j4 + e < I) acc[e] -= a4[e] * t[4 * j4 + e]; }
        t[I] = (acc[0] + acc[1]) + (acc[2] + acc[3]);
        if constexpr ((I & 7) == 7) __builtin_amdgcn_sched_barrier(0);
        subst_row<I + 1>(t, Am, lane);
    }
}
__device__ __forceinline__ bf16x8 ld_2x8(const bf16* p0, const bf16* p1) { const v2u a = *(const v2u*)p0, b = *(const v2u*)p1; const v4u w = {a.x, a.y, b.x, b.y}; return __builtin_bit_cast(bf16x8, w); }
__device__ __forceinline__ bf16x8 lds_2x8(const LAS bf16* p0, const LAS bf16* p1) { const v2u a = *(const LAS v2u*)p0, b = *(const LAS v2u*)p1; const v4u w = {a.x, a.y, b.x, b.y}; return __builtin_bit_cast(bf16x8, w); }
__device__ __forceinline__ void gdnA_item(const Args& a, LAS unsigned char* wl, int item, int lane) {
    asm volatile("" : "+v"(lane));
    const GItem I = gitem_of(a, item);
    const int m = lane & 15, g = lane >> 4;
    LAS float* Am = (LAS float*)(wl + GA_T1); LAS bf16* T1 = (LAS bf16*)(wl + GA_T1); LAS bf16* T2 = (LAS bf16*)(wl + GA_T2);
    LAS float* GV = (LAS float*)(wl + GA_GV); LAS float* BV = (LAS float*)(wl + GA_BV); LAS float* RK = (LAS float*)(wl + GA_RK); LAS float* RQ = (LAS float*)(wl + GA_RQ);
    float bl = 0.f, G = 0.f;
    {
        const int hvx = (item < NITEM_P) ? ((item >> 5) & 31) : ((item - NITEM_P) & 31), lr = lane < I.nvalid ? lane : I.nvalid - 1;
        const float blv = ((const float*)(a.ws + WS_BETA))[(size_t)(I.grow + lr) * 32 + hvx], gv = ((const float*)(a.ws + WS_GG))[(size_t)(I.grow + lr) * 32 + hvx];
        if (lane < I.nvalid) { bl = blv; G = gv; }
    }
#pragma unroll
    for (int o = 1; o < 64; o <<= 1) { const float t = __shfl_up(G, o); if (lane >= o) G += t; }
    const float Glast = __shfl(G, 63);
    GV[lane] = G; BV[lane] = bl;
    v4u* FR = (v4u*)(a.ws + WS_FR) + (size_t)I.id * SC_GROWS * 64;
    bf16x8 kf[4][4], qf[4][4];
#pragma unroll
    for (int t = 0; t < 4; ++t)
#pragma unroll
        for (int s = 0; s < 4; ++s) kf[t][s] = *(const bf16x8*)(I.KN + (size_t)(16 * t + m) * 128 + 32 * s + 8 * g);
#pragma unroll
    for (int t = 0; t < 4; ++t)
#pragma unroll
        for (int s = 0; s < 4; ++s) qf[t][s] = *(const bf16x8*)(I.QN + (size_t)(16 * t + m) * 128 + 32 * s + 8 * g);
    f32x4 kd[4];
#pragma unroll
    for (int it = 0; it < 4; ++it) {
        f32x4 aq = {0.f, 0.f, 0.f, 0.f}; kd[it] = (f32x4){0.f, 0.f, 0.f, 0.f};
#pragma unroll
        for (int s = 0; s < 4; ++s) { kd[it] = __builtin_amdgcn_mfma_f32_16x16x32_bf16(kf[it][s], kf[it][s], kd[it], 0, 0, 0); aq = __builtin_amdgcn_mfma_f32_16x16x32_bf16(qf[it][s], qf[it][s], aq, 0, 0, 0); }
        if (g == (m >> 2)) { const int e = m & 3; const float dk2 = e == 0 ? kd[it][0] : (e == 1 ? kd[it][1] : (e == 2 ? kd[it][2] : kd[it][3])), dq2 = e == 0 ? aq[0] : (e == 1 ? aq[1] : (e == 2 ? aq[2] : aq[3]));
            RK[16 * it + m] = rsqrtf(dk2 + L2_EPS); RQ[16 * it + m] = rsqrtf(dq2 + L2_EPS) * 0.08838834764831845f; }
    }
    const float rkl = RK[lane], rql = RQ[lane];
    { float* GF = (float*)(FR + (SC_GF - SC_GBASE) * 64); GF[lane] = __expf(G) * rql; if (lane < 32) GF[64 + lane] = __expf(Glast); GF[128 + lane] = __expf(Glast - G) * rkl;
      GF[256 + lane] = bl; GF[256 + 64 + lane] = __expf(G) * rkl; }
#pragma unroll
    for (int it = 0; it < 4; ++it) {
        const f32x4 gi = *(const LAS f32x4*)(GV + 16 * it + 4 * g), bi = *(const LAS f32x4*)(BV + 16 * it + 4 * g) * *(const LAS f32x4*)(RK + 16 * it + 4 * g);
#pragma unroll
        for (int jt = 0; jt <= it; ++jt) {
            f32x4 acc = kd[it];
            if (jt < it) { acc = (f32x4){0.f, 0.f, 0.f, 0.f};
#pragma unroll
                for (int s = 0; s < 4; ++s) acc = __builtin_amdgcn_mfma_f32_16x16x32_bf16(kf[it][s], kf[jt][s], acc, 0, 0, 0); }
            const float gj = GV[16 * jt + m], rj = RK[16 * jt + m];
#pragma unroll
            for (int e = 0; e < 4; ++e) { const int i = 16 * it + 4 * g + e, j = 16 * jt + m; Am[i * 68 + j] = (i > j) ? bi[e] * rj * acc[e] * __expf(gi[e] - gj) : 0.f; }
        }
    }
    {
        v4u* MF = FR + (SC_MF - SC_GBASE) * 64;
#pragma unroll
        for (int it = 0; it < 4; ++it) {
            const float gi = GV[16 * it + m], rqi = RQ[16 * it + m];
            f32x4 mt[4];
#pragma unroll
            for (int jt = 0; jt < 4; ++jt) {
                mt[jt] = (f32x4){0.f, 0.f, 0.f, 0.f};
                if (jt <= it) {
                    f32x4 acc = {0.f, 0.f, 0.f, 0.f};
#pragma unroll
                    for (int s = 0; s < 4; ++s) acc = __builtin_amdgcn_mfma_f32_16x16x32_bf16(kf[jt][s], qf[it][s], acc, 0, 0, 0);
                    const f32x4 gj = *(const LAS f32x4*)(GV + 16 * jt + 4 * g), rj = *(const LAS f32x4*)(RK + 16 * jt + 4 * g);
#pragma unroll
                    for (int e = 0; e < 4; ++e) { const int i = 16 * it + m, j = 16 * jt + 4 * g + e; mt[jt][e] = (i >= j) ? acc[e] * rqi * rj[e] * __expf(gi - gj[e]) : 0.f; }
                }
            }
#pragma unroll
            for (int s = 0; s < 2; ++s) { v4u w; w.x = pk2(mt[2 * s][0], mt[2 * s][1]); w.y = pk2(mt[2 * s][2], mt[2 * s][3]); w.z = pk2(mt[2 * s + 1][0], mt[2 * s + 1][1]); w.w = pk2(mt[2 * s + 1][2], mt[2 * s + 1][3]);
                MF[(it * 2 + s) * 64 + lane] = w; }
        }
    }
    asm volatile("" ::: "memory");
    float t[64];
    subst_row<0>(t, Am, lane);
#pragma unroll
    for (int i = 0; i < 64; ++i) T1[i * 68 + lane] = f2bf(t[i]);
    asm volatile("" ::: "memory");
#pragma unroll
    for (int it = 0; it < 4; ++it)
#pragma unroll
        for (int s2 = 0; s2 < 2; ++s2)
            FR[(SC_TF - SC_GBASE + it * 2 + s2) * 64 + lane] = __builtin_bit_cast(v4u, lds_2x8(T1 + (16 * it + m) * 68 + 32 * s2 + 4 * g, T1 + (16 * it + m) * 68 + 32 * s2 + 16 + 4 * g));
}
__device__ __forceinline__ void scan_stage_dma(const Args& a, int id, const bf16* qrows, const bf16* krows, LAS unsigned char* buf, int wave, int lane) {
    const v4u* src = (const v4u*)(a.ws + WS_FR) + (size_t)id * SC_GROWS * 64 + lane;
    const bf16* qsrc = qrows + (size_t)(lane & 15) * 128 + 8 * (lane >> 4);
#pragma unroll
    for (int k = 0; k < 8; ++k) { const int r = wave + 8 * k;
        if (r < SC_QF) { const int j = 4 * r + (lane >> 4), slot = lane & 15, ch = slot ^ (((j & 3) << 2) | ((j >> 2) & 3));
            __builtin_amdgcn_global_load_lds((const unsigned*)(krows + (size_t)j * 128 + 8 * ch), (LAS unsigned*)(buf + r * 1024), 16, 0, 0); }
        else if (r < SC_MF) { const int fq = r - SC_QF; __builtin_amdgcn_global_load_lds((const unsigned*)(qsrc + (size_t)(16 * (fq >> 2)) * 128 + 32 * (fq & 3)), (LAS unsigned*)(buf + r * 1024), 16, 0, 0); }
        else if (r < SC_NROW) __builtin_amdgcn_global_load_lds((const unsigned*)(src + (r - SC_GBASE) * 64), (LAS unsigned*)(buf + r * 1024), 16, 0, 0); }
}
__device__ __forceinline__ void scan_chunk(const LAS unsigned char* buf, f32x4 (&S)[8], const v4u (&vb)[2], f32x4 (&O)[4], int lane) {
    const LAS v4u* F = (const LAS v4u*)buf + lane; const LAS float* GFl = (const LAS float*)(buf + SC_GF * 1024);
    const int m = lane & 15, g = lane >> 4, g4 = 4 * g;
    bf16x8 Sb[4];
#pragma unroll
    for (int sp = 0; sp < 4; ++sp) { v4u w; w.x = pk2(S[2 * sp][0], S[2 * sp][1]); w.y = pk2(S[2 * sp][2], S[2 * sp][3]); w.z = pk2(S[2 * sp + 1][0], S[2 * sp + 1][1]); w.w = pk2(S[2 * sp + 1][2], S[2 * sp + 1][3]); Sb[sp] = __builtin_bit_cast(bf16x8, w); }
    f32x4 KS[4];
#pragma unroll
    for (int jt = 0; jt < 4; ++jt) {
        f32x4 ks = {0.f, 0.f, 0.f, 0.f}, qs = {0.f, 0.f, 0.f, 0.f};
#pragma unroll
        for (int sp = 0; sp < 4; ++sp) {
            ks = __builtin_amdgcn_mfma_f32_16x16x32_bf16(*(const LAS bf16x8*)(buf + off_b(16 * jt + m, 4 * sp + g)), Sb[sp], ks, 0, 0, 0);
            qs = __builtin_amdgcn_mfma_f32_16x16x32_bf16(__builtin_bit_cast(bf16x8, F[(SC_QF + jt * 4 + sp) * 64]), Sb[sp], qs, 0, 0, 0);
        }
        KS[jt] = ks; O[jt] = qs * *(const LAS f32x4*)(GFl + 16 * jt + g4);
        __builtin_amdgcn_sched_barrier(0);
    }
    const LAS float* GF2 = (const LAS float*)(buf + SC_GF2 * 1024);
    bf16x8 Rb[2];
#pragma unroll
    for (int s = 0; s < 2; ++s) {
        const f32x4 b0 = *(const LAS f32x4*)(GF2 + 32 * s + g4), b1 = *(const LAS f32x4*)(GF2 + 32 * s + 16 + g4), a0 = *(const LAS f32x4*)(GF2 + 64 + 32 * s + g4), a1 = *(const LAS f32x4*)(GF2 + 64 + 32 * s + 16 + g4);
        const f32x4 v0 = {pg8::bf_lo(vb[s].x), pg8::bf_hi(vb[s].x), pg8::bf_lo(vb[s].y), pg8::bf_hi(vb[s].y)}, v1 = {pg8::bf_lo(vb[s].z), pg8::bf_hi(vb[s].z), pg8::bf_lo(vb[s].w), pg8::bf_hi(vb[s].w)};
        const f32x4 r0 = b0 * (v0 - a0 * KS[2 * s]), r1 = b1 * (v1 - a1 * KS[2 * s + 1]);
        v4u w; w.x = pk2(r0[0], r0[1]); w.y = pk2(r0[2], r0[3]); w.z = pk2(r1[0], r1[1]); w.w = pk2(r1[2], r1[3]); Rb[s] = __builtin_bit_cast(bf16x8, w);
    }
    f32x4 U[4];
#pragma unroll
    for (int it = 0; it < 4; ++it) {
        f32x4 u = {0.f, 0.f, 0.f, 0.f};
#pragma unroll
        for (int s2 = 0; s2 < 2; ++s2) u = __builtin_amdgcn_mfma_f32_16x16x32_bf16(__builtin_bit_cast(bf16x8, F[(SC_TF + it * 2 + s2) * 64]), Rb[s2], u, 0, 0, 0);
        U[it] = u;
    }
    bf16x8 Ub[2], Uc[2];
#pragma unroll
    for (int s = 0; s < 2; ++s) {
        v4u w; w.x = pk2(U[2 * s][0], U[2 * s][1]); w.y = pk2(U[2 * s][2], U[2 * s][3]); w.z = pk2(U[2 * s + 1][0], U[2 * s + 1][1]); w.w = pk2(U[2 * s + 1][2], U[2 * s + 1][3]); Ub[s] = __builtin_bit_cast(bf16x8, w);
        const f32x4 c0 = *(const LAS f32x4*)(GFl + 128 + 32 * s + g4), c1 = *(const LAS f32x4*)(GFl + 128 + 32 * s + 16 + g4), a0 = U[2 * s] * c0, a1 = U[2 * s + 1] * c1;
        v4u x; x.x = pk2(a0[0], a0[1]); x.y = pk2(a0[2], a0[3]); x.z = pk2(a1[0], a1[1]); x.w = pk2(a1[2], a1[3]); Uc[s] = __builtin_bit_cast(bf16x8, x);
    }
#pragma unroll
    for (int it = 0; it < 4; ++it)
#pragma unroll
        for (int s = 0; s < 2; ++s) O[it] = __builtin_amdgcn_mfma_f32_16x16x32_bf16(__builtin_bit_cast(bf16x8, F[(SC_MF + it * 2 + s) * 64]), Ub[s], O[it], 0, 0, 0);
    const float gam = GFl[64];
    const int q4 = (lane & 15) >> 2, p4 = lane & 3;
#pragma unroll
    for (int t = 0; t < 8; ++t) {
        S[t] = S[t] * gam;
#pragma unroll
        for (int s = 0; s < 2; ++s) {
            const s16x4 v0 = vtr(buf + off_b(32 * s + 4 * g + q4, 4 * (t >> 1) + p4) + 8 * (t & 1)), v1 = vtr(buf + off_b(32 * s + 16 + 4 * g + q4, 4 * (t >> 1) + p4) + 8 * (t & 1));
            const bf16x8 kt = (bf16x8){v0[0], v0[1], v0[2], v0[3], v1[0], v1[1], v1[2], v1[3]};
            S[t] = __builtin_amdgcn_mfma_f32_16x16x32_bf16(kt, Uc[s], S[t], 0, 0, 0);
        }
    }
}
__device__ __forceinline__ void scan_norm_partial(LAS float* ssq, const f32x4 (&O)[4], int wave, int lane) {
    const int m = lane & 15, g = lane >> 4;
#pragma unroll
    for (int it = 0; it < 4; ++it) {
        f32x4 q = O[it] * O[it];
        q[0] = row16_sum(q[0]); q[1] = row16_sum(q[1]); q[2] = row16_sum(q[2]); q[3] = row16_sum(q[3]);
        if (m == 0) *(LAS f32x4*)(ssq + wave * 64 + 16 * it + 4 * g) = q;
    }
}
__device__ __forceinline__ void scan_norm_finish(const Args& a, const LAS float* ssq, const f32x4 (&O)[4], const unsigned (&zq)[8], int hv, size_t yrow0, int nrows, int wave, int lane) {
    const int m = lane & 15, g = lane >> 4, odd = lane & 1;
    bf16* YA = (bf16*)(a.ws + WS_YA);
    const float gn = a.gdn_g[16 * wave + m];
#pragma unroll
    for (int it = 0; it < 4; ++it) {
        f32x4 tot = {0.f, 0.f, 0.f, 0.f};
#pragma unroll
        for (int w = 0; w < NWAVES; ++w) tot += *(const LAS f32x4*)(ssq + w * 64 + 16 * it + 4 * g);
#pragma unroll
        for (int pp = 0; pp < 2; ++pp) {
            const unsigned own = zq[it * 2 + pp], nbr = dpp_swap1(own);
            const float z0 = odd ? pg8::bf_hi(nbr) : pg8::bf_lo(own), z1 = odd ? pg8::bf_hi(own) : pg8::bf_lo(nbr);
            const float y0 = O[it][2 * pp] * rsqrtf(tot[2 * pp] * (1.0f / 128.0f) + NORM_EPS) * gn * z0, y1 = O[it][2 * pp + 1] * rsqrtf(tot[2 * pp + 1] * (1.0f / 128.0f) + NORM_EPS) * gn * z1;
            const float r = __builtin_bit_cast(float, dpp_swap1(__builtin_bit_cast(unsigned, odd ? y0 : y1)));
            const unsigned word = odd ? pk2(r, y1) : pk2(y0, r);
            const int row = 16 * it + 4 * g + 2 * pp + odd;
            if (row < nrows) *(unsigned*)(YA + (size_t)(hv >> 4) * MROWS * 2048 + (yrow0 + row) * 2048 + (hv & 15) * 128 + 16 * wave + m - odd) = word;
        }
    }
}
#define SCAN_BAR() do { asm volatile("s_waitcnt vmcnt(0) lgkmcnt(0)" ::: "memory"); __builtin_amdgcn_s_barrier(); asm volatile("" ::: "memory"); } while (0)
__device__ __forceinline__ void scan_prompt_unit(const Args& a, LAS unsigned char* lds, int unit) {
    const int tid = threadIdx.x; int lane = tid & 63; asm volatile("" : "+v"(lane)); const int wave = __builtin_amdgcn_readfirstlane(tid >> 6), m = lane & 15, g = lane >> 4;
    const int hv = unit & 31, b = unit >> 5;
    const bf16* Z = (const bf16*)(a.ws + WS_Z);
    LAS float* ssq = (LAS float*)(lds + SC_SSQ);
    f32x4 S[8];
#pragma unroll
    for (int d = 0; d < 8; ++d) S[d] = (f32x4){0.f, 0.f, 0.f, 0.f};
    const bf16* QN = (const bf16*)(a.ws + WS_QNP) + (size_t)(b * HQK + (hv >> 1)) * LP * 128; const bf16* KN = (const bf16*)(a.ws + WS_KNP) + (size_t)(b * HQK + (hv >> 1)) * LP * 128;
    scan_stage_dma(a, unit * 32, QN, KN, lds, wave, lane);
    scan_stage_dma(a, unit * 32 + 1, QN + (size_t)64 * 128, KN + (size_t)64 * 128, lds + SC_BUF_BYTES, wave, lane);
    const bf16* VTw = (const bf16*)(a.ws + WS_VTP) + ((size_t)unit * 128 + 16 * wave + m) * LP + 4 * g;
    v4u vbn[2];
#pragma unroll
    for (int s2 = 0; s2 < 2; ++s2) { const v2u p0 = *(const v2u*)(VTw + 32 * s2), p1 = *(const v2u*)(VTw + 32 * s2 + 16); vbn[s2] = (v4u){p0.x, p0.y, p1.x, p1.y}; }
    SCAN_BAR();
#pragma unroll 1
    for (int c = 0; c < 32; ++c) {
        const int id = unit * 32 + c;
        unsigned zq[8];
        const size_t yrow0 = (size_t)b * LP + 64 * c;
#pragma unroll
        for (int it = 0; it < 4; ++it)
#pragma unroll
            for (int e2 = 0; e2 < 2; ++e2) zq[it * 2 + e2] = *(const unsigned*)(Z + (yrow0 + 16 * it + 4 * g + 2 * e2 + (lane & 1)) * 4096 + hv * 128 + 16 * wave + m - (lane & 1));
        f32x4 O[4];
        scan_chunk(lds + (c & 1) * SC_BUF_BYTES, S, vbn, O, lane);
        if (c + 1 < 32) {
#pragma unroll
            for (int s2 = 0; s2 < 2; ++s2) { const v2u p0 = *(const v2u*)(VTw + 64 * (c + 1) + 32 * s2), p1 = *(const v2u*)(VTw + 64 * (c + 1) + 32 * s2 + 16); vbn[s2] = (v4u){p0.x, p0.y, p1.x, p1.y}; }
        }
        scan_norm_partial(ssq + (c & 1) * 512, O, wave, lane);
        SCAN_BAR();
        scan_norm_finish(a, ssq + (c & 1) * 512, O, zq, hv, yrow0, 64, wave, lane);
        if (c + 2 < 32) { int l2 = lane; asm volatile("" : "+v"(l2)); scan_stage_dma(a, id + 2, QN + (size_t)(64 * (c + 2)) * 128, KN + (size_t)(64 * (c + 2)) * 128, lds + (c & 1) * SC_BUF_BYTES, wave, l2); }
    }
    float* so = a.out + O_GP + (size_t)unit * DK * DV + 16 * wave + m;
#pragma unroll
    for (int d = 0; d < 8; ++d)
#pragma unroll
        for (int e = 0; e < 4; ++e) so[(size_t)sigma_dk(d, 4 * g + e) * DV] = S[d][e];
    SCAN_BAR();
}
__device__ __forceinline__ void scan_sample_unit(const Args& a, LAS unsigned char* lds, int unit) {
    const int tid = threadIdx.x; int lane = tid & 63; asm volatile("" : "+v"(lane)); const int wave = __builtin_amdgcn_readfirstlane(tid >> 6), m = lane & 15, g = lane >> 4;
    const int hv = unit & 31, b = unit >> 5, id = NITEM_P + unit;
    const bf16* Z = (const bf16*)(a.ws + WS_Z);
    LAS float* ssq = (LAS float*)(lds + SC_SSQ);
    scan_stage_dma(a, id, (const bf16*)(a.ws + WS_QNS) + (size_t)(b * HQK + (hv >> 1)) * 64 * 128, (const bf16*)(a.ws + WS_KNS) + (size_t)(b * HQK + (hv >> 1)) * 64 * 128, lds, wave, lane);
    f32x4 S[8];
    const float* s0 = a.state_gdn + (size_t)unit * DK * DV + 16 * wave + m;
#pragma unroll
    for (int d = 0; d < 8; ++d)
#pragma unroll
        for (int e = 0; e < 4; ++e) S[d][e] = s0[(size_t)sigma_dk(d, 4 * g + e) * DV];
    v4u vb[2];
    { const bf16* VTw = (const bf16*)(a.ws + WS_VTS) + ((size_t)unit * 128 + 16 * wave + m) * 64 + 4 * g;
#pragma unroll
      for (int s2 = 0; s2 < 2; ++s2) { const v2u p0 = *(const v2u*)(VTw + 32 * s2), p1 = *(const v2u*)(VTw + 32 * s2 + 16); vb[s2] = (v4u){p0.x, p0.y, p1.x, p1.y}; } }
    unsigned zq[8];
    const size_t yrow0 = (size_t)MP + b * LS;
#pragma unroll
    for (int e = 0; e < 8; ++e) zq[e] = 0u;
    if (g < 2) {
#pragma unroll
        for (int e2 = 0; e2 < 2; ++e2) zq[e2] = *(const unsigned*)(Z + (yrow0 + 4 * g + 2 * e2 + (lane & 1)) * 4096 + hv * 128 + 16 * wave + m - (lane & 1));
    }
    SCAN_BAR();
    f32x4 O[4];
    scan_chunk(lds, S, vb, O, lane);
    scan_norm_partial(ssq, O, wave, lane);
    SCAN_BAR();
    scan_norm_finish(a, ssq, O, zq, hv, yrow0, LS, wave, lane);
    float* so = a.out + O_GS + (size_t)unit * DK * DV + 16 * wave + m;
#pragma unroll
    for (int d = 0; d < 8; ++d)
#pragma unroll
        for (int e = 0; e < 4; ++e) so[(size_t)sigma_dk(d, 4 * g + e) * DV] = S[d][e];
    __syncthreads();
}

constexpr float IDX_SCALE = 0.08838834764831845f * 0.25f;
__device__ __forceinline__ void idx_reduce4(const f32x4 (&acc)[4], const f32x4 (&wv)[4], float (&v)[4]) {
#pragma unroll
    for (int qq = 0; qq < 4; ++qq) v[qq] = fmaxf(acc[qq][0], 0.f) * wv[qq][0] + fmaxf(acc[qq][1], 0.f) * wv[qq][1] + fmaxf(acc[qq][2], 0.f) * wv[qq][2] + fmaxf(acc[qq][3], 0.f) * wv[qq][3];
    float t[4];
#pragma unroll
    for (int qq = 0; qq < 4; ++qq) t[qq] = __shfl_xor(v[qq], 16);
#pragma unroll
    for (int qq = 0; qq < 4; ++qq) v[qq] += t[qq];
#pragma unroll
    for (int qq = 0; qq < 4; ++qq) t[qq] = __shfl_xor(v[qq], 32);
#pragma unroll
    for (int qq = 0; qq < 4; ++qq) v[qq] = (v[qq] + t[qq]) * IDX_SCALE;
}
__device__ __forceinline__ void idx_prompt_item(const Args& a, LAS unsigned char* wl, int b, int j, int hf, int lane) {
    const bf16* IQ = (const bf16*)(a.ws + WS_IQ); const bf16* IK = (const bf16*)(a.ws + WS_IK); const float* IW = (const float*)(a.ws + WS_IW); _Float16* SC = (_Float16*)(a.ws + WS_SC);
    const int m = lane & 15, g = lane >> 4, rq = b * LP + 4 * j;
    bf16x8 afr[4][4]; f32x4 wv[4];
#pragma unroll
    for (int qq = 0; qq < 4; ++qq) {
#pragma unroll
        for (int s = 0; s < 4; ++s) afr[qq][s] = *(const bf16x8*)(IQ + (size_t)(rq + qq) * 2048 + m * 128 + 32 * s + 8 * g);
        wv[qq] = *(const f32x4*)(IW + (size_t)(rq + qq) * 16 + 4 * g);
    }
    const int nkt = (4 * j + 3) / 16 + 1, k0 = hf ? nkt / 2 : 0, k1 = hf ? nkt : nkt / 2;
    if (k0 >= k1) return;
    const bf16* kb = IK + (size_t)(b * LP + g) * 128 + 8 * m;
    const int g0 = k0 >> 2, g1 = (k1 - 1) >> 2;
    v4u stg[16];
#pragma unroll
    for (int i = 0; i < 16; ++i) stg[i] = *(const v4u*)(kb + (size_t)(64 * g0 + 4 * i) * 128);
#pragma unroll 1
    for (int gi = g0; gi <= g1; ++gi) {
#pragma unroll
        for (int i = 0; i < 16; ++i) *(LAS v4u*)(wl + off_b(4 * i + g, m)) = stg[i];
        const int gn = gi < g1 ? gi + 1 : gi;
#pragma unroll
        for (int i = 0; i < 16; ++i) stg[i] = *(const v4u*)(kb + (size_t)(64 * gn + 4 * i) * 128);
#pragma unroll
        for (int u = 0; u < 4; ++u) {
            const int kt = 4 * gi + u;
            if (kt >= k0 && kt < k1) {
                f32x4 acc[4]; float v[4];
                bf16x8 bf[4];
#pragma unroll
                for (int s = 0; s < 4; ++s) bf[s] = *(const LAS bf16x8*)(wl + off_b(16 * u + m, 4 * s + g));
#pragma unroll
                for (int qq = 0; qq < 4; ++qq) { acc[qq] = (f32x4){0.f, 0.f, 0.f, 0.f};
#pragma unroll
                    for (int s = 0; s < 4; ++s) acc[qq] = __builtin_amdgcn_mfma_f32_16x16x32_bf16(afr[qq][s], bf[s], acc[qq], 0, 0, 0); }
                idx_reduce4(acc, wv, v);
                const int key = 16 * kt + m;
#pragma unroll
                for (int qq = 0; qq < 4; ++qq) { if (key > 4 * j + qq) v[qq] = -__builtin_inff(); if (g == 0) SC[(size_t)(rq + qq) * 2048 + key] = (_Float16)v[qq]; }
            }
        }
    }
}
__device__ __forceinline__ void idx_sample_item(const Args& a, int b, int p, int lane) {
    const bf16* IQ = (const bf16*)(a.ws + WS_IQ); const bf16* IK = (const bf16*)(a.ws + WS_IK); const float* IW = (const float*)(a.ws + WS_IW); float* SCS = (float*)(a.ws + WS_SCS);
    const int m = lane & 15, g = lane >> 4;
    if (p < NPAGES) {
        const float* kr = a.cache_kidx + (size_t)a.page_table[b * NPAGES + p] * PAGE * 128 + (size_t)m * 128 + 8 * g;
#pragma unroll 1
        for (int qh = 0; qh < 2; ++qh) {
            const int rq = MP + b * LS + qh * 4;
            bf16x8 afr[4][4]; f32x4 wv[4];
#pragma unroll
            for (int qq = 0; qq < 4; ++qq) {
#pragma unroll
                for (int s = 0; s < 4; ++s) afr[qq][s] = *(const bf16x8*)(IQ + (size_t)(rq + qq) * 2048 + m * 128 + 32 * s + 8 * g);
                wv[qq] = *(const f32x4*)(IW + (size_t)(rq + qq) * 16 + 4 * g);
            }
            f32x4 fc[8], fn[8];
#pragma unroll
            for (int s = 0; s < 4; ++s) { fc[2 * s] = *(const f32x4*)(kr + 32 * s); fc[2 * s + 1] = *(const f32x4*)(kr + 32 * s + 4); }
#pragma unroll 1
            for (int kt = 0; kt < 8; ++kt) {
                const int ktn = kt + 1 < 8 ? kt + 1 : kt;
#pragma unroll
                for (int s = 0; s < 4; ++s) { fn[2 * s] = *(const f32x4*)(kr + (size_t)(16 * ktn) * 128 + 32 * s); fn[2 * s + 1] = *(const f32x4*)(kr + (size_t)(16 * ktn) * 128 + 32 * s + 4); }
                bf16x8 bfr[4];
#pragma unroll
                for (int s = 0; s < 4; ++s) { v4u w; w.x = pk2(fc[2 * s][0], fc[2 * s][1]); w.y = pk2(fc[2 * s][2], fc[2 * s][3]); w.z = pk2(fc[2 * s + 1][0], fc[2 * s + 1][1]); w.w = pk2(fc[2 * s + 1][2], fc[2 * s + 1][3]); bfr[s] = __builtin_bit_cast(bf16x8, w); }
                f32x4 acc[4]; float v[4];
#pragma unroll
                for (int qq = 0; qq < 4; ++qq) { acc[qq] = (f32x4){0.f, 0.f, 0.f, 0.f};
#pragma unroll
                    for (int s = 0; s < 4; ++s) acc[qq] = __builtin_amdgcn_mfma_f32_16x16x32_bf16(afr[qq][s], bfr[s], acc[qq], 0, 0, 0); }
                idx_reduce4(acc, wv, v);
#pragma unroll
                for (int qq = 0; qq < 4; ++qq) if (g == 0) SCS[(size_t)(b * LS + qh * 4 + qq) * SCS_LD + p * PAGE + 16 * kt + m] = v[qq];
#pragma unroll
                for (int s = 0; s < 8; ++s) fc[s] = fn[s];
            }
        }
    } else {
        const int jr = m < LS ? m : LS - 1;
        bf16x8 bfr[4];
#pragma unroll
        for (int s = 0; s < 4; ++s) bfr[s] = *(const bf16x8*)(IK + (size_t)(MP + b * LS + jr) * 128 + 32 * s + 8 * g);
#pragma unroll 1
        for (int qh = 0; qh < 2; ++qh) {
            const int rq = MP + b * LS + qh * 4;
            f32x4 acc[4], wv[4]; float v[4];
#pragma unroll
            for (int qq = 0; qq < 4; ++qq) { acc[qq] = (f32x4){0.f, 0.f, 0.f, 0.f}; wv[qq] = *(const f32x4*)(IW + (size_t)(rq + qq) * 16 + 4 * g);
#pragma unroll
                for (int s = 0; s < 4; ++s) acc[qq] = __builtin_amdgcn_mfma_f32_16x16x32_bf16(*(const bf16x8*)(IQ + (size_t)(rq + qq) * 2048 + m * 128 + 32 * s + 8 * g), bfr[s], acc[qq], 0, 0, 0); }
            idx_reduce4(acc, wv, v);
#pragma unroll
            for (int qq = 0; qq < 4; ++qq) { if (m > qh * 4 + qq) v[qq] = -__builtin_inff(); if (g == 0 && m < LS) SCS[(size_t)(b * LS + qh * 4 + qq) * SCS_LD + PAST + m] = v[qq]; }
        }
    }
}

template <int NPL> __device__ __forceinline__ void topk_query(const float* sc, int n, int* sel, int* cnt, int lane) {
    if (n <= NTOPK) {
#pragma unroll
        for (int j = 0; j < NTOPK / 64; ++j) { const int i = j * 64 + lane; sel[i] = i < n ? i : 0; }
        if (lane == 0) *cnt = n;
        return;
    }
    unsigned key[NPL];
#pragma unroll
    for (int i = 0; i < NPL; ++i) { const int idx = i * 64 + lane; unsigned k = 0u;
        { const unsigned uu = __float_as_uint(sc[idx < n ? idx : n - 1]); if (idx < n) k = (uu & 0x80000000u) ? ~uu : (uu | 0x80000000u); }
        key[i] = k; }
    unsigned tau = 0u;
    for (int bit = 31; bit >= 0; --bit) {
        const unsigned tr = tau | (1u << bit); int c = 0;
#pragma unroll
        for (int i = 0; i < NPL; ++i) c += __popcll(__ballot(key[i] >= tr));
        if (c >= NTOPK) tau = tr;
        if (c == NTOPK) break;
    }
    int base = 0;
#pragma unroll
    for (int i = 0; i < NPL; ++i) {
        const bool f = key[i] >= tau;
        const unsigned long long bal = __ballot(f);
        const int pos = base + __popcll(bal & ((1ull << lane) - 1ull));
        if (f && pos < NTOPK) sel[pos] = i * 64 + lane;
        base += __popcll(bal);
    }
    if (lane == 0) *cnt = base < NTOPK ? base : NTOPK;
}

__device__ __forceinline__ void topk_query16(const _Float16* sc, int n, int* sel, int* cnt, int lane) {
    if (n <= NTOPK) {
#pragma unroll
        for (int j = 0; j < NTOPK / 64; ++j) { const int i = j * 64 + lane; sel[i] = i < n ? i : 0; }
        if (lane == 0) *cnt = n;
        return;
    }
    unsigned key[32];
#pragma unroll
    for (int i = 0; i < 4; ++i) {
        const int base = (i * 64 + lane) * 8;
        const v4u w = *(const v4u*)(sc + base);
        const unsigned ww[4] = {w.x, w.y, w.z, w.w};
#pragma unroll
        for (int e = 0; e < 8; ++e) { const unsigned uu = (e & 1) ? (ww[e >> 1] >> 16) : (ww[e >> 1] & 0xffffu); const unsigned k = (uu & 0x8000u) ? (~uu & 0xffffu) : (uu | 0x8000u); key[i * 8 + e] = (base + e < n) ? k : 0u; }
    }
    unsigned tau = 0u;
    for (int bit = 15; bit >= 0; --bit) {
        const unsigned tr = tau | (1u << bit); int c = 0;
#pragma unroll
        for (int i = 0; i < 32; ++i) c += __popcll(__ballot(key[i] >= tr));
        if (c >= NTOPK) tau = tr;
        if (c == NTOPK) break;
    }
    int base = 0;
#pragma unroll
    for (int i = 0; i < 32; ++i) {
        const bool f = key[i] >= tau;
        const unsigned long long bal = __ballot(f);
        const int pos = base + __popcll(bal & ((1ull << lane) - 1ull));
        if (f && pos < NTOPK) sel[pos] = ((i >> 3) * 64 + lane) * 8 + (i & 7);
        base += __popcll(bal);
    }
    if (lane == 0) *cnt = base < NTOPK ? base : NTOPK;
}
__device__ __forceinline__ void topk_block(const float* sc, int n, int* sel, int* cnt, LAS int* sl) {
    constexpr int NPT = 17;
    const int tid = threadIdx.x, lane = tid & 63, wave = tid >> 6;
    unsigned key[NPT];
#pragma unroll
    for (int i = 0; i < NPT; ++i) { const int idx = i * NTHREADS + tid; unsigned k = 0u;
        { const unsigned uu = __float_as_uint(sc[idx < n ? idx : n - 1]); if (idx < n) k = (uu & 0x80000000u) ? ~uu : (uu | 0x80000000u); }
        key[i] = k; }
    unsigned tau = 0u;
    for (int bit = 31; bit >= 0; --bit) {
        const unsigned tr = tau | (1u << bit); int c = 0;
#pragma unroll
        for (int i = 0; i < NPT; ++i) c += __popcll(__ballot(key[i] >= tr));
        LAS int* pb = sl + (bit & 1) * 8;
        if (lane == 0) pb[wave] = c;
        __syncthreads();
        int tot = 0;
#pragma unroll
        for (int w = 0; w < NWAVES; ++w) tot += pb[w];
        if (tot >= NTOPK) tau = tr;
        if (tot == NTOPK) break;
    }
    LAS int* wc = sl + 16;
    unsigned long long bal[NPT];
#pragma unroll
    for (int i = 0; i < NPT; ++i) { bal[i] = __ballot(key[i] >= tau); if (lane == 0) wc[i * 8 + wave] = __popcll(bal[i]); }
    __syncthreads();
    int base = 0;
#pragma unroll
    for (int i = 0; i < NPT; ++i) {
        int mybase = base;
#pragma unroll
        for (int w = 0; w < NWAVES; ++w) { const int v = wc[i * 8 + w]; if (w < wave) mybase += v; base += v; }
        const int pos = mybase + __popcll(bal[i] & ((1ull << lane) - 1ull));
        if ((key[i] >= tau) && pos < NTOPK) sel[pos] = i * NTHREADS + tid;
    }
    if (tid == 0) *cnt = base < NTOPK ? base : NTOPK;
    __syncthreads();
}

__device__ __forceinline__ const float* kv_row(const Args& a, bool isv, bool sample, int b, int key, int kvh) {
    if (!sample) return a.out + (isv ? O_VP : O_KP) + ((size_t)(b * LP + key) * 2 + kvh) * 128;
    if (key < PAST) { const int phys = a.page_table[b * NPAGES + (key >> 7)]; return (isv ? a.cache_v : a.cache_k) + (((size_t)phys * PAGE + (key & 127)) * 2 + kvh) * 128; }
    return a.out + (isv ? O_VS : O_KS) + ((size_t)(b * LS + (key - PAST)) * 2 + kvh) * 128;
}
constexpr int ATT_WAVE_BYTES = 17408;
template <bool SAMPLE> __device__ __forceinline__ void attn_query(const Args& a, LAS unsigned char* wl, int row, int lane) {
    const bf16* BQ = (const bf16*)(a.ws + WS_BQ); const bf16* BZ = (const bf16*)(a.ws + WS_BZ); bf16* YB = (bf16*)(a.ws + WS_YB);
    const int* sel = (const int*)(a.ws + WS_SEL) + (size_t)row * NTOPK; const int cnt = ((const int*)(a.ws + WS_CNT))[row];
    const int b = SAMPLE ? (row - MP) >> 3 : row >> 11;
    const int m = lane & 15, g = lane >> 4;
    LAS unsigned char* Kb = wl; LAS unsigned char* Vb = wl + 8192; LAS int* SL = (LAS int*)(wl + 16384);
    { v4u sv = *(const v4u*)(sel + 4 * lane); if constexpr (!SAMPLE) { sv.x <<= 10; sv.y <<= 10; sv.z <<= 10; sv.w <<= 10; } *(LAS v4u*)(SL + 4 * lane) = sv; }
    const int ntile = (cnt + 31) >> 5;
#pragma unroll 1
    for (int kvh = 0; kvh < 2; ++kvh) {
        bf16x8 qf[4];
#pragma unroll
        for (int s = 0; s < 4; ++s) { const bf16x8 ql = *(const bf16x8*)(BQ + (size_t)row * 2048 + (kvh * 8 + (m & 7)) * 128 + 32 * s + 8 * g); qf[s] = m < 8 ? ql : (bf16x8){0, 0, 0, 0, 0, 0, 0, 0}; }
        f32x4 o[8];
#pragma unroll
        for (int cc = 0; cc < 8; ++cc) o[cc] = (f32x4){0.f, 0.f, 0.f, 0.f};
        float mrun = -__builtin_inff(), lrun = 0.f;
        v4u pw_[8], px_[8];
        const unsigned char* kvbase = a.ws + WS_BKV + (size_t)b * LP * 1024 + kvh * 256 + 16 * m;
        if constexpr (!SAMPLE) {
#pragma unroll
            for (int i = 0; i < 8; ++i) { int slot = 4 * i + g; slot = slot < cnt ? slot : cnt - 1;
                const unsigned char* src = kvbase + (unsigned)SL[slot];
                pw_[i] = *(const v4u*)src; px_[i] = *(const v4u*)(src + 512); }
        }
#pragma unroll 1
        for (int T = 0; T < ntile; ++T) {
            if constexpr (!SAMPLE) {
#pragma unroll
                for (int i = 0; i < 8; ++i) { const int kap = 4 * i + g, nu = 8 * ((kap >> 2) & 3) + 4 * (kap >> 4) + (kap & 3);
                    *(LAS v4u*)(Kb + off_b(kap, m)) = pw_[i]; *(LAS v4u*)(Vb + off_b(nu, m)) = px_[i]; }
                if (T + 1 < ntile) {
#pragma unroll
                    for (int i = 0; i < 8; ++i) { int slot = 32 * (T + 1) + 4 * i + g; slot = slot < cnt ? slot : cnt - 1;
                        const unsigned char* src = kvbase + (unsigned)SL[slot];
                        pw_[i] = *(const v4u*)src; px_[i] = *(const v4u*)(src + 512); }
                }
            } else {
#pragma unroll
                for (int hb = 0; hb < 2; ++hb) {
                    int key[4], phys[4];
#pragma unroll
                    for (int i = 0; i < 4; ++i) { int slot = 32 * T + 4 * (4 * hb + i) + g; slot = slot < cnt ? slot : cnt - 1; key[i] = SL[slot]; }
#pragma unroll
                    for (int i = 0; i < 4; ++i) { const int pg = key[i] >> 7; phys[i] = a.page_table[b * NPAGES + (pg < NPAGES ? pg : NPAGES - 1)]; }
                    f32x4 f[4][4];
#pragma unroll
                    for (int i = 0; i < 4; ++i) {
                        const bool past = key[i] < PAST; const int jn = past ? 0 : key[i] - PAST;
                        const size_t oc = (((size_t)phys[i] * PAGE + (key[i] & 127)) * 2 + kvh) * 128 + 8 * m, on = ((size_t)(b * LS + jn) * 2 + kvh) * 128 + 8 * m;
                        const float* ks = past ? a.cache_k + oc : a.out + O_KS + on; const float* vs = past ? a.cache_v + oc : a.out + O_VS + on;
                        f[i][0] = *(const f32x4*)ks; f[i][1] = *(const f32x4*)(ks + 4); f[i][2] = *(const f32x4*)vs; f[i][3] = *(const f32x4*)(vs + 4);
                    }
#pragma unroll
                    for (int i = 0; i < 4; ++i) { const int kap = 4 * (4 * hb + i) + g, nu = 8 * ((kap >> 2) & 3) + 4 * (kap >> 4) + (kap & 3);
                        v4u w, x; w.x = pk2(f[i][0][0], f[i][0][1]); w.y = pk2(f[i][0][2], f[i][0][3]); w.z = pk2(f[i][1][0], f[i][1][1]); w.w = pk2(f[i][1][2], f[i][1][3]);
                        x.x = pk2(f[i][2][0], f[i][2][1]); x.y = pk2(f[i][2][2], f[i][2][3]); x.z = pk2(f[i][3][0], f[i][3][1]); x.w = pk2(f[i][3][2], f[i][3][3]);
                        *(LAS v4u*)(Kb + off_b(kap, m)) = w; *(LAS v4u*)(Vb + off_b(nu, m)) = x; }
                }
            }
            f32x4 c[2];
#pragma unroll
            for (int rb = 0; rb < 2; ++rb) {
                f32x4 acc = {0.f, 0.f, 0.f, 0.f};
#pragma unroll
                for (int s = 0; s < 4; ++s) { const bf16x8 kf = *(const LAS bf16x8*)(Kb + off_b(m + 16 * rb, 4 * s + g)); acc = __builtin_amdgcn_mfma_f32_16x16x32_bf16(kf, qf[s], acc, 0, 0, 0); }
                c[rb] = acc;
            }
#pragma unroll
            for (int rb = 0; rb < 2; ++rb)
#pragma unroll
                for (int i = 0; i < 4; ++i) { const int slot = 32 * T + 16 * rb + 4 * g + i; if (slot >= cnt) c[rb][i] = -__builtin_inff(); }
            if (T == 0) {
                float tm = fmaxf(fmaxf(fmaxf(c[0][0], c[0][1]), fmaxf(c[0][2], c[0][3])), fmaxf(fmaxf(c[1][0], c[1][1]), fmaxf(c[1][2], c[1][3])));
                tm = fmaxf(tm, __shfl_xor(tm, 16)); tm = fmaxf(tm, __shfl_xor(tm, 32));
                mrun = tm;
            }
            float ps = 0.f;
#pragma unroll
            for (int rb = 0; rb < 2; ++rb)
#pragma unroll
                for (int i = 0; i < 4; ++i) { const float pe = __expf(fminf(c[rb][i] - mrun, 80.0f)); c[rb][i] = pe; ps += pe; }
            lrun += ps;
            v4u pw; pw.x = pk2(c[0][0], c[0][1]); pw.y = pk2(c[0][2], c[0][3]); pw.z = pk2(c[1][0], c[1][1]); pw.w = pk2(c[1][2], c[1][3]);
            const bf16x8 pa = __builtin_bit_cast(bf16x8, pw);
#pragma unroll
            for (int cc = 0; cc < 8; ++cc) {
                const s16x4 v0 = vtr(Vb + tr_read_addr_16(lane, cc, 0)), v1 = vtr(Vb + tr_read_addr_16(lane, cc, 1));
                const bf16x8 vf = (bf16x8){v0[0], v0[1], v0[2], v0[3], v1[0], v1[1], v1[2], v1[3]};
                o[cc] = __builtin_amdgcn_mfma_f32_16x16x32_bf16(pa, vf, o[cc], 0, 0, 0);
            }
        }
        float l = lrun; l += __shfl_xor(l, 16); l += __shfl_xor(l, 32);
        float linv[4];
#pragma unroll
        for (int i = 0; i < 4; ++i) linv[i] = 1.0f / __shfl(l, (4 * g + i) & 15);
        {
            const int gg = g & 1;
            bf16 zz[4][8];
#pragma unroll
            for (int i = 0; i < 4; ++i)
#pragma unroll
                for (int cc = 0; cc < 8; ++cc) zz[i][cc] = BZ[(size_t)row * 2048 + (kvh * 8 + 4 * gg + i) * 128 + m + 16 * cc];
            if (g < 2) {
#pragma unroll
                for (int i = 0; i < 4; ++i) { const size_t ro = (size_t)row * 2048 + (kvh * 8 + 4 * g + i) * 128 + m;
#pragma unroll
                    for (int cc = 0; cc < 8; ++cc) YB[ro + 16 * cc] = f2bf(o[cc][i] * linv[i] * bf2f(zz[i][cc])); }
            }
        }
    }
}

template <int KSTEPS> __device__ __forceinline__ void sgemm_32x64(const bf16* A, const bf16* Bt, int K, int k0, int lane, f32x4 (&acc)[2][4]) {
    const bf16* ap = A + (size_t)(lane & 15) * K + k0 + 8 * (lane >> 4); const bf16* bp = Bt + (size_t)(lane & 15) * K + k0 + 8 * (lane >> 4);
#pragma unroll 1
    for (int kk = 0; kk < KSTEPS; kk += 4) {
        bf16x8 af[4][2], bfv[4][4];
#pragma unroll
        for (int s2 = 0; s2 < 4; ++s2) {
#pragma unroll
            for (int ri = 0; ri < 2; ++ri) af[s2][ri] = *(const bf16x8*)(ap + (size_t)(16 * ri) * K + 32 * (kk + s2));
#pragma unroll
            for (int ci = 0; ci < 4; ++ci) bfv[s2][ci] = *(const bf16x8*)(bp + (size_t)(16 * ci) * K + 32 * (kk + s2));
        }
#pragma unroll
        for (int s2 = 0; s2 < 4; ++s2)
#pragma unroll
            for (int ri = 0; ri < 2; ++ri)
#pragma unroll
                for (int ci = 0; ci < 4; ++ci) acc[ri][ci] = __builtin_amdgcn_mfma_f32_16x16x32_bf16(af[s2][ri], bfv[s2][ci], acc[ri][ci], 0, 0, 0);
    }
}
__device__ __forceinline__ void sample_merge_block(const Args& a, LAS unsigned char* lds, int bt) {
    const int tid = threadIdx.x, lane = tid & 63, wave = tid >> 6, m = lane & 15, g = lane >> 4;
    const int rt = bt >> 5, ct = bt & 31, r0 = MP + 32 * rt, c0 = 64 * ct;
    f32x4 a1[2][4], a2[2][4];
#pragma unroll
    for (int ri = 0; ri < 2; ++ri)
#pragma unroll
        for (int ci = 0; ci < 4; ++ci) { a1[ri][ci] = (f32x4){0.f, 0.f, 0.f, 0.f}; a2[ri][ci] = (f32x4){0.f, 0.f, 0.f, 0.f}; }
    sgemm_32x64<8>((const bf16*)(a.ws + WS_YA) + (size_t)r0 * D, (const bf16*)(a.ws + WS_WPA) + (size_t)c0 * D, D, 256 * wave, lane, a1);
    sgemm_32x64<8>((const bf16*)(a.ws + WS_YA) + (size_t)MROWS * D + (size_t)r0 * D, (const bf16*)(a.ws + WS_WPA) + (size_t)D * D + (size_t)c0 * D, D, 256 * wave, lane, a1);
    sgemm_32x64<8>((const bf16*)(a.ws + WS_YB) + (size_t)r0 * D, (const bf16*)(a.ws + WS_WPB) + (size_t)c0 * D, D, 256 * wave, lane, a2);
    LAS f32x4* P = (LAS f32x4*)lds;
#pragma unroll
    for (int ri = 0; ri < 2; ++ri)
#pragma unroll
        for (int ci = 0; ci < 4; ++ci) { P[(wave * 16 + ri * 4 + ci) * 64 + lane] = a1[ri][ci]; P[(wave * 16 + 8 + ri * 4 + ci) * 64 + lane] = a2[ri][ci]; }
    __syncthreads();
    f32x4 s1 = {0.f, 0.f, 0.f, 0.f}, s2 = {0.f, 0.f, 0.f, 0.f};
#pragma unroll
    for (int w = 0; w < NWAVES; ++w) { s1 += P[(w * 16 + wave) * 64 + lane]; s2 += P[(w * 16 + 8 + wave) * 64 + lane]; }
    const int ri = wave >> 2, ci = wave & 3;
    const bf16* GA = (const bf16*)(a.ws + WS_GA); const bf16* GB = (const bf16*)(a.ws + WS_GB); bf16* MG = (bf16*)(a.ws + WS_MG);
#pragma unroll
    for (int e = 0; e < 4; ++e) { const size_t o = (size_t)(r0 + 16 * ri + 4 * g + e) * D + c0 + 16 * ci + m; MG[o] = f2bf(bf2f(GA[o]) * s1[e] + bf2f(GB[o]) * s2[e]); }
    __syncthreads();
}
__device__ __forceinline__ void sample_out_block(const Args& a, LAS unsigned char* lds, int bt) {
    const int tid = threadIdx.x, lane = tid & 63, wave = tid >> 6, m = lane & 15, g = lane >> 4;
    const int rt = bt >> 5, ct = bt & 31, r0 = MP + 32 * rt, c0 = 64 * ct;
    f32x4 acc[2][4];
#pragma unroll
    for (int ri = 0; ri < 2; ++ri)
#pragma unroll
        for (int ci = 0; ci < 4; ++ci) acc[ri][ci] = (f32x4){0.f, 0.f, 0.f, 0.f};
    sgemm_32x64<8>((const bf16*)(a.ws + WS_MG) + (size_t)r0 * D, (const bf16*)(a.ws + WS_WOUT) + (size_t)c0 * D, D, 256 * wave, lane, acc);
    LAS f32x4* P = (LAS f32x4*)lds;
#pragma unroll
    for (int ri = 0; ri < 2; ++ri)
#pragma unroll
        for (int ci = 0; ci < 4; ++ci) P[(wave * 8 + ri * 4 + ci) * 64 + lane] = acc[ri][ci];
    __syncthreads();
    f32x4 s1 = {0.f, 0.f, 0.f, 0.f};
#pragma unroll
    for (int w = 0; w < NWAVES; ++w) s1 += P[(w * 8 + wave) * 64 + lane];
    const int ri = wave >> 2, ci = wave & 3;
    bf16* OUTF = (bf16*)(a.ws + WS_OUTF);
#pragma unroll
    for (int e = 0; e < 4; ++e) OUTF[(size_t)(r0 + 16 * ri + 4 * g + e) * D + c0 + 16 * ci + m] = f2bf(s1[e]);
    __syncthreads();
}

__global__ void __launch_bounds__(NTHREADS, 2) fwd(Args a0) {
    extern __shared__ __attribute__((aligned(16))) unsigned char lds_raw[];
    LAS unsigned char* lds = (LAS unsigned char*)lds_raw;
    const int tid = threadIdx.x, lane0 = tid & 63, wave = __builtin_amdgcn_readfirstlane(tid >> 6);
    const int G = gridDim.x, bid = blockIdx.x;
    const int gw = bid * NWAVES + wave, NGW = G * NWAVES;
    unsigned char* ws = a0.ws;
    gu32* ctl = (gu32*)(ws + WS_CTL);
    for (int u = tid; u < (LDS_BYTES - LDSCTL_OFF) / 4; u += NTHREADS) ((LAS unsigned*)(lds + LDSCTL_OFF))[u] = 0u;
    __syncthreads();
    volatile LAS unsigned* MISC = (volatile LAS unsigned*)(lds + MISC_OFF);
#if MK_ONE_LAUNCH
    XcdBarrier bar = xcd_barrier_post((unsigned*)ctl + CW_BAR, MISC + 8);
#define GRID_BAR() xcd_barrier(bar)
#else
    (void)MISC; (void)ctl;
#define GRID_BAR() do {} while (0)
#endif
    const int lo = a0.ph_lo, hi = a0.ph_hi;
#ifndef PH_MASK
#define PH_MASK 0x1ff
#endif
#define IN(k) (((PH_MASK >> (k)) & 1) && lo <= (k) && (k) < hi)
#define BOTH(k) (IN(k) && IN((k) + 1))
#ifndef REP_MASK
#define REP_MASK 0
#endif
#define NREP(k) (1 + ((REP_MASK >> (k)) & 1))
    float* MOD = (float*)(ws + WS_MOD);
    bf16* WIN = (bf16*)(ws + WS_WIN); bf16* WPA = (bf16*)(ws + WS_WPA); bf16* WPB = (bf16*)(ws + WS_WPB); bf16* WOUT = (bf16*)(ws + WS_WOUT);
    bf16* H = (bf16*)(ws + WS_H);

    if (IN(0)) {
        int ln = lane0; asm volatile("" : "+v"(ln)); const Args a = load_args(lo, hi);
        LAS float* scr = (LAS float*)(lds + wave * 16384);
        constexpr int I_IN = (D / 64) * (NPAD / 32), I_MOD = 32 * 96;
        {
            constexpr int nblk = NPAD / 32;
            LAS unsigned* lctr = (LAS unsigned*)(lds + 8 * 16384);
            if (threadIdx.x == 0) *lctr = 0u;
            __syncthreads();
            for (int r = bid + G * wave; r < I_MOD; r += G * NWAVES) mod_item(a, MOD, r, scr, ln);
            constexpr int NPAIR = I_IN / 2;
            float v0[32], v1[32];
            unsigned q = 0; if (ln == 0) q = __hip_atomic_fetch_add(lctr, 1u, __ATOMIC_RELAXED, __HIP_MEMORY_SCOPE_WORKGROUP);
            int pa = (int)__builtin_amdgcn_readfirstlane(q) * G + bid;
            { const int t = 2 * (pa < NPAIR ? pa : NPAIR - 1); win_tr_load(a.w_in, 32 * (t % nblk), 64 * (t / nblk), v0, ln); win_tr_load(a.w_in, 32 * ((t + 1) % nblk), 64 * ((t + 1) / nblk), v1, ln); }
            while (pa < NPAIR) {
                const int ia = 2 * pa;
                win_tr_store(v0, WIN, 32 * (ia % nblk), 64 * (ia / nblk), scr, ln);
                q = 0; if (ln == 0) q = __hip_atomic_fetch_add(lctr, 1u, __ATOMIC_RELAXED, __HIP_MEMORY_SCOPE_WORKGROUP);
                const int pn = (int)__builtin_amdgcn_readfirstlane(q) * G + bid;
                const int tn = 2 * (pn < NPAIR ? pn : NPAIR - 1);
                win_tr_load(a.w_in, 32 * (tn % nblk), 64 * (tn / nblk), v0, ln);
                win_tr_store(v1, WIN, 32 * ((ia + 1) % nblk), 64 * ((ia + 1) / nblk), scr, ln);
                win_tr_load(a.w_in, 32 * ((tn + 1) % nblk), 64 * ((tn + 1) / nblk), v1, ln);
                pa = pn;
            }
        }
        if (BOTH(0)) GRID_BAR();
    }
    if (IN(1)) for (int rep = 0; rep < NREP(1); ++rep) {
        int ln = lane0; asm volatile("" : "+v"(ln)); const Args a = load_args(lo, hi);
        for (int mrow = gw; mrow < MROWS; mrow += NGW) {
            const float* xr = mrow < MP ? a.x_p + (size_t)mrow * D : a.x_s + (size_t)(mrow - MP) * D;
            const int bi = mrow < MP ? (mrow >> 11) : 4 + ((mrow - MP) >> 3);
            const float* md = MOD + bi * 6144;
            f32x4 v[8], ms[8], mb[8]; float s = 0.f;
#pragma unroll
            for (int j = 0; j < 8; ++j) v[j] = __builtin_nontemporal_load((const f32x4*)xr + ln + 64 * j);
#pragma unroll
            for (int j = 0; j < 8; ++j) { const int col = 4 * (ln + 64 * j);
                ms[j] = *(const f32x4*)(a.pre_g + col) * (*(const f32x4*)(md + 2048 + col) + *(const f32x4*)(a.b_ada + 2048 + col) + 1.0f); mb[j] = *(const f32x4*)(md + col) + *(const f32x4*)(a.b_ada + col); }
#pragma unroll
            for (int j = 0; j < 8; ++j) s += (v[j][0] * v[j][0] + v[j][1] * v[j][1]) + (v[j][2] * v[j][2] + v[j][3] * v[j][3]);
            const float rstd = rsqrtf(wave_sum(s) * (1.0f / D) + NORM_EPS);
#pragma unroll
            for (int j = 0; j < 8; ++j) { const int col = 4 * (ln + 64 * j);
                const f32x4 hv = v[j] * rstd * ms[j] + mb[j];
                v2u w; w.x = pk2(hv[0], hv[1]); w.y = pk2(hv[2], hv[3]);
                *(v2u*)(H + (size_t)mrow * D + col) = w; }
        }
        if (BOTH(1)) GRID_BAR();
    }
    if (IN(2)) for (int rep = 0; rep < NREP(2); ++rep) {
        int ln = lane0; asm volatile("" : "+v"(ln)); const Args a = load_args(lo, hi);
        pg8::Gemm g{H, WIN, MROWS, NPAD, D}; pg8::StaticOrder S; S.init(MROWS, NPAD, G, bid);
        pg8::EpiIn E{(bf16*)(ws + WS_QKV), (bf16*)(ws + WS_Z), (bf16*)(ws + WS_BQ), (bf16*)(ws + WS_BZ), (bf16*)(ws + WS_IQ), (bf16*)(ws + WS_GA), (bf16*)(ws + WS_GB), (bf16*)(ws + WS_IK),
                     (float*)(ws + WS_BETA), (float*)(ws + WS_GG), (float*)(ws + WS_IW), a.out, a.a_log, a.dt_bias, (bf16*)(ws + WS_BKV)};
        pg8::gemm_phase<pg8::EpiIn, pg8::StaticOrder, true, true>(lds, g, S, E);
        {
            constexpr int I_PA = (4096 / 64) * (D / 32), I_PB = (D / 64) * (D / 32), I_OUT = I_PB, NUN = (MROWS / 256) * (NPAD / 256);
            const int nshort = (NUN % G) ? G - NUN % G : G, first = G - nshort;
            if (bid >= first) {
                LAS float* scr = (LAS float*)(lds + wave * 16384);
                for (int it = (bid - first) * NWAVES + wave; it < I_PA + I_PB + I_OUT; it += nshort * NWAVES) {
                    int r = it; const int nblk = D / 32;
                    if (r < I_PA) { const int kb = r / nblk, hh = kb >> 5; transpose_item(a.w_pa + (size_t)hh * D * D, D, D, WPA + (size_t)hh * D * D, 32 * (r % nblk), 64 * (kb & 31), false, scr, ln); continue; } r -= I_PA;
                    if (r < I_PB) { transpose_item(a.w_pb, D, D, WPB, 32 * (r % nblk), 64 * (r / nblk), false, scr, ln); continue; } r -= I_PB;
                    transpose_item(a.w_out, D, D, WOUT, 32 * (r % nblk), 64 * (r / nblk), false, scr, ln);
                }
            }
        }
        if (BOTH(2)) GRID_BAR();
    }
    if (IN(3)) for (int rep = 0; rep < NREP(3); ++rep) {
        int ln = lane0; asm volatile("" : "+v"(ln)); const Args a = load_args(lo, hi);
#pragma unroll 1
        for (int pass = 0; pass < 2; ++pass) {
            if ((pass == 0) == (wave < 4)) {
                for (int it = gw; it < BP * 32 * 64 + BS * 64; it += NGW) prep_item(a, it, ln);
            } else {
                constexpr int NPI = BP * (LP / 4) * 2, NSI = BS * (NPAGES + 1);
                for (int it = gw; it < NPI + NSI; it += NGW) {
                    if (it < NPI) { int i2 = it < NPI / 2 ? it : (NPI - 1) - (it - NPI / 2); idx_prompt_item(a, lds + wave * 16384, i2 & 3, (LP / 4 - 1) - (i2 >> 3), (i2 >> 2) & 1, ln); }
                    else { const int r = it - NPI; idx_sample_item(a, r / (NPAGES + 1), r % (NPAGES + 1), ln); }
                }
            }
        }
        if (BOTH(3)) GRID_BAR();
    }
    if (IN(4)) for (int rep = 0; rep < NREP(4); ++rep) {
        int ln = lane0; asm volatile("" : "+v"(ln)); const Args a = load_args(lo, hi);
        const int nfull = (NITEM / NGW) * NGW, nrem = NITEM - nfull, rper = (nrem + G - 1) / G;
        for (int k = 0; k <= NITEM / NGW; ++k) {
            int it;
            if (k < NITEM / NGW) it = k * NGW + gw; else { if (wave >= rper) break; it = nfull + bid * rper + wave; if (it >= NITEM) break; }
            int item;
            if (it < NITEM_P) { const int par = it & 1, c = (it >> 1) & 31, hq = (it >> 6) & 15, b = it >> 10; item = (b * HV + 2 * hq + par) * 32 + c; }
            else { const int r = it - NITEM_P, par = r & 1, hq = (r >> 1) & 15, b = r >> 5; item = NITEM_P + b * HV + 2 * hq + par; }
            gdnA_item(a, lds + wave * GA_WAVE_BYTES, item, ln);
        }
        int* SEL = (int*)(ws + WS_SEL); int* CNT = (int*)(ws + WS_CNT);
        for (int r = gw; r < MP; r += NGW) topk_query16((const _Float16*)(ws + WS_SC) + (size_t)r * 2048, (r & (LP - 1)) + 1, SEL + (size_t)r * NTOPK, CNT + r, ln);
        __syncthreads();
        for (int r = MP + bid; r < MROWS; r += G) topk_block((const float*)(ws + WS_SCS) + (size_t)(r - MP) * SCS_LD, PAST + ((r - MP) & 7) + 1, SEL + (size_t)r * NTOPK, CNT + r, (LAS int*)lds);
        if (BOTH(4)) GRID_BAR();
    }
    if (IN(5)) for (int rep = 0; rep < NREP(5); ++rep) {
        const Args a = load_args(lo, hi);
        if (G >= 2 * BP * HV) {
            if (bid < BP * HV) scan_prompt_unit(a, lds, bid);
            else for (int u = bid - BP * HV; u < BS * HV; u += G - BP * HV) scan_sample_unit(a, lds, u);
        } else {
            for (int u = bid; u < BP * HV + BS * HV; u += G) { if (u < BP * HV) scan_prompt_unit(a, lds, u); else scan_sample_unit(a, lds, u - BP * HV); }
        }
        __syncthreads();
        {
            int ln = lane0; asm volatile("" : "+v"(ln));
            const int x = bid & 7;
            gu32* qctr = ctl + CW_ATTQ + 16 * x;
            for (;;) {
                unsigned q = 0; if (ln == 0) q = __hip_atomic_fetch_add(qctr, 1u, __ATOMIC_RELAXED, __HIP_MEMORY_SCOPE_AGENT);
                q = __builtin_amdgcn_readfirstlane(q);
                if (q >= (unsigned)(MS / 8 + MP / 8)) break;
                if (q < (unsigned)(MS / 8)) attn_query<true>(a, lds + wave * ATT_WAVE_BYTES, MP + (MS / 8) * x + (int)q, ln);
                else { const int i = (int)q - MS / 8; attn_query<false>(a, lds + wave * ATT_WAVE_BYTES, (x >> 1) * LP + 2 * (LP / 2 - 1 - i) + (x & 1), ln); }
            }
        }
        if (BOTH(5)) GRID_BAR();
    }
    if (IN(6)) for (int rep = 0; rep < NREP(6); ++rep) {
        int ln = lane0; asm volatile("" : "+v"(ln)); const Args a = load_args(lo, hi);
        for (int t = bid; t < (MS / 32) * (D / 64); t += G) sample_merge_block(a, lds, t);
        static_assert(WS_YB == WS_YA + 2 * (size_t)MROWS * D * 2 && WS_WPB == WS_WPA + 2 * (size_t)D * D * 2, "the chain's three segments are contiguous: y_a lo | y_a hi | y_b and w_pa lo | w_pa hi | w_pb");
        pg8::GemmChain g{(const bf16*)(ws + WS_YA), WPA, (size_t)MROWS * D, (size_t)D * D, MP, D, D}; pg8::ChainOrder S; S.init(MP, D, G, bid);
        pg8::EpiChain E{(const bf16*)(ws + WS_GA), (const bf16*)(ws + WS_GB), (bf16*)(ws + WS_MG)};
        pg8::gemm_chain<pg8::EpiChain, pg8::ChainOrder, true, true>(lds, g, S, E);
        if (BOTH(6)) GRID_BAR();
    }
    if (IN(7)) for (int rep = 0; rep < NREP(7); ++rep) {
        int ln = lane0; asm volatile("" : "+v"(ln)); const Args a = load_args(lo, hi);
        for (int t = bid; t < (MS / 32) * (D / 64); t += G) sample_out_block(a, lds, t);
        pg8::Gemm g{(const bf16*)(ws + WS_MG), WOUT, MP, D, D}; pg8::StaticOrder S; S.init(MP, D, G, bid);
        pg8::EpiBf16P E{(bf16*)(ws + WS_OUTF), D};
        pg8::gemm_phase<pg8::EpiBf16P, pg8::StaticOrder, true, true>(lds, g, S, E);
        if (BOTH(7)) GRID_BAR();
    }
    if (IN(8)) for (int rep = 0; rep < NREP(8); ++rep) {
        int ln = lane0; asm volatile("" : "+v"(ln)); const Args a = load_args(lo, hi);
        const bf16* OUTF = (const bf16*)(ws + WS_OUTF);
        for (int mrow = gw; mrow < MROWS; mrow += NGW) {
            const float* xr = mrow < MP ? a.x_p + (size_t)mrow * D : a.x_s + (size_t)(mrow - MP) * D;
            float* yr = mrow < MP ? a.out + O_YP + (size_t)mrow * D : a.out + O_YS + (size_t)(mrow - MP) * D;
            const int bi = mrow < MP ? (mrow >> 11) : 4 + ((mrow - MP) >> 3);
            const float* md = MOD + bi * 6144 + 4096;
            const bf16* orow = OUTF + (size_t)mrow * D;
            v4u ow[4]; f32x4 v[8], xv[8], ms[8]; float s = 0.f;
#pragma unroll
            for (int j = 0; j < 4; ++j) { ow[j] = __builtin_nontemporal_load((const v4u*)(orow + 8 * (ln + 64 * j))); xv[2 * j] = __builtin_nontemporal_load((const f32x4*)(xr + 8 * (ln + 64 * j))); xv[2 * j + 1] = __builtin_nontemporal_load((const f32x4*)(xr + 8 * (ln + 64 * j) + 4)); }
#pragma unroll
            for (int j = 0; j < 8; ++j) { const int col = 8 * (ln + 64 * (j >> 1)) + 4 * (j & 1); ms[j] = *(const f32x4*)(a.post_g + col) * (*(const f32x4*)(md + col) + *(const f32x4*)(a.b_ada + 4096 + col)); }
#pragma unroll
            for (int j = 0; j < 4; ++j) { v[2 * j] = (f32x4){pg8::bf_lo(ow[j].x), pg8::bf_hi(ow[j].x), pg8::bf_lo(ow[j].y), pg8::bf_hi(ow[j].y)}; v[2 * j + 1] = (f32x4){pg8::bf_lo(ow[j].z), pg8::bf_hi(ow[j].z), pg8::bf_lo(ow[j].w), pg8::bf_hi(ow[j].w)}; }
#pragma unroll
            for (int j = 0; j < 8; ++j) s += (v[j][0] * v[j][0] + v[j][1] * v[j][1]) + (v[j][2] * v[j][2] + v[j][3] * v[j][3]);
            const float rstd = rsqrtf(wave_sum(s) * (1.0f / D) + NORM_EPS);
#pragma unroll
            for (int j = 0; j < 8; ++j) *(f32x4*)(yr + 8 * (ln + 64 * (j >> 1)) + 4 * (j & 1)) = xv[j] + ms[j] * (v[j] * rstd);
        }
    }
#undef IN
#undef BOTH
}

extern "C" void kernel_launch(void* const* d_in, const int* in_sizes, int n_in, void* d_out, int out_size, void* d_ws, size_t ws_size, hipStream_t stream) {
    static int grid = 0;
    if (grid == 0) {
        if (n_in != 22 || (size_t)out_size != O_END || ws_size < WS_END) { fprintf(stderr, "kernel_launch: unexpected shapes (n_in %d, out %d, ws %zu); nothing launched\n", n_in, out_size, ws_size); grid = -1; return; }
        int dev = 0, cus = 0;
        if (hipGetDevice(&dev) != hipSuccess || hipDeviceGetAttribute(&cus, hipDeviceAttributeMultiprocessorCount, dev) != hipSuccess) { grid = -1; return; }
        if (hipFuncSetAttribute((const void*)fwd, hipFuncAttributeMaxDynamicSharedMemorySize, LDS_BYTES) != hipSuccess) { fprintf(stderr, "kernel_launch: hipFuncSetAttribute failed\n"); grid = -1; return; }
        int per_cu = 0;
        if (hipOccupancyMaxActiveBlocksPerMultiprocessor(&per_cu, (const void*)fwd, NTHREADS, LDS_BYTES) != hipSuccess || per_cu < 1) fprintf(stderr, "kernel_launch: note: occupancy query reports %d\n", per_cu);
        (void)hipGetLastError();
        grid = cus;
    }
    if (grid < 0) return;
    (void)hipMemsetAsync((char*)d_ws + WS_CTL, 0, CTL_ZERO_BYTES, stream);
    Args a{};
    a.x_p = (const float*)d_in[0]; a.x_s = (const float*)d_in[1]; a.c_p = (const float*)d_in[2]; a.c_s = (const float*)d_in[3];
    a.cache_k = (const float*)d_in[4]; a.cache_v = (const float*)d_in[5]; a.cache_kidx = (const float*)d_in[6]; a.state_gdn = (const float*)d_in[7]; a.state_conv = (const float*)d_in[8];
    a.page_table = (const int*)d_in[9];
    a.w_ada = (const float*)d_in[10]; a.b_ada = (const float*)d_in[11]; a.pre_g = (const float*)d_in[12]; a.w_in = (const float*)d_in[13]; a.conv_w = (const float*)d_in[14];
    a.a_log = (const float*)d_in[15]; a.dt_bias = (const float*)d_in[16]; a.gdn_g = (const float*)d_in[17]; a.w_pa = (const float*)d_in[18]; a.w_pb = (const float*)d_in[19];
    a.w_out = (const float*)d_in[20]; a.post_g = (const float*)d_in[21];
    a.out = (float*)d_out; a.ws = (unsigned char*)d_ws;
#if MK_ONE_LAUNCH
    a.ph_lo = 0; a.ph_hi = N_PHASES;
    hipLaunchKernelGGL(fwd, dim3(grid), dim3(NTHREADS), LDS_BYTES, stream, a);
#else
    for (int ph = 0; ph < N_PHASES; ++ph) { a.ph_lo = ph; a.ph_hi = ph + 1; hipLaunchKernelGGL(fwd, dim3(grid), dim3(NTHREADS), LDS_BYTES, stream, a); }
#endif
}
```

```cpp
#include <hip/hip_runtime.h>
#include <cstdio>
#include <cstdint>
constexpr int D = 2048, BP = 4, LP = 2048, BS = 32, LS = 8, MP = BP * LP, MS = BS * LS, MROWS = MP + MS;
constexpr int NPAGES = 64, PAGE = 128, PAST = NPAGES * PAGE;
constexpr int HV = 32, HQK = 16, DK = 128, DV = 128, CONVCH = 8192;
constexpr int NIN = 23248, NPAD = 23296;
constexpr int NTOPK = 256;
constexpr float NORM_EPS = 1e-6f, L2_EPS = 1e-6f;
constexpr int SCS_LD = 8256;
constexpr size_t O_YP = 0, O_YS = O_YP + (size_t)MP * D, O_KP = O_YS + (size_t)MS * D, O_VP = O_KP + (size_t)MP * 256, O_KIP = O_VP + (size_t)MP * 256,
                 O_GP = O_KIP + (size_t)MP * 128, O_CP = O_GP + (size_t)BP * HV * DK * DV, O_KS = O_CP + (size_t)BP * 3 * CONVCH, O_VS = O_KS + (size_t)MS * 256,
                 O_KIS = O_VS + (size_t)MS * 256, O_GS = O_KIS + (size_t)MS * 128, O_CS = O_GS + (size_t)BS * HV * DK * DV, O_END = O_CS + (size_t)BS * 3 * CONVCH;
static_assert(O_END == 42467328, "output size");
__host__ __device__ __forceinline__ int win_src_col(int n) {
    if (n < 12288) return n;
    if (n < 18944) return n + 64;
    if (n < 23040) return n + 208;
    if (n < 23168) return n - 23040 + 19008;
    if (n < 23200) return n - 23168 + 12288;
    if (n < 23232) return n - 23200 + 12320;
    if (n < 23248) return n - 23232 + 19136;
    return -1;
}
namespace pg8 {
#define PG8_LAS __attribute__((address_space(3)))
typedef unsigned short bf16_t;
typedef short bf16x8 __attribute__((ext_vector_type(8)));
typedef float f32x4 __attribute__((ext_vector_type(4)));
typedef unsigned u32x4 __attribute__((ext_vector_type(4)));
constexpr int BM = 256, BK = 64, HALF = 128, HTB = HALF * BK * 2  , STAGE_BYTES = 8 * HTB, NXCD = 8, WGM = 4;

__host__ __device__ __forceinline__ int lds_byte(int r, int c) { const int st = (r >> 4) * 2 + (c >> 5), rr = r & 15, cc = c & 31, ob = rr * 64 + cc * 2; return st * 1024 + (ob ^ (((ob >> 9) & 1) << 5)); }
__host__ __device__ __forceinline__ void stage_rc(int b, int& R, int& C) { const int st = b / 1024, sb = b % 1024, swz = sb ^ (((sb >> 9) & 1) << 5); R = (st >> 1) * 16 + swz / 64; C = (st & 1) * 32 + (swz % 64) / 2; }
__host__ __device__ __forceinline__ int perm32(int rho) { const int n = rho >> 4, i = rho & 15; return 8 * (i >> 2) + 4 * n + (i & 3); }

struct Unit { int pm, pn, seg; };
struct Gemm { const bf16_t* A; const bf16_t* Bt; int M, N, K; };

struct StaticOrder {
    int nM, nN, nwg, G, c;
    __host__ __device__ void init(int M, int N, int G_, int c_) { nM = M / BM; nN = N / BM; nwg = nM * nN; G = G_; c = c_; }
    __host__ __device__ bool next(int i, Unit& u) const {
        const long L = (long)i * G + c; if (L >= nwg) return false;
        int wgid = (int)L; { const int q = nwg / NXCD, r = nwg % NXCD, xcd = wgid % NXCD, off = wgid / NXCD; wgid = (xcd < r ? xcd * (q + 1) : r * (q + 1) + (xcd - r) * q) + off; }
        const int nig = WGM * nN, gid = wgid / nig, fm = gid * WGM, gsz = (nM - fm) < WGM ? (nM - fm) : WGM;
        u.pm = fm + ((wgid % nig) % gsz); u.pn = (wgid % nig) / gsz; return true;
    }
    __device__ __forceinline__ void a_ready(const Unit&) const {}
    __device__ __forceinline__ void done(const Unit&) const {}
};

typedef __bf16 bf16x2_t __attribute__((ext_vector_type(2)));
typedef float f32x2_t __attribute__((ext_vector_type(2)));
__device__ __forceinline__ unsigned cvt_pk_bf16(float lo, float hi) { const f32x2_t v = {lo, hi}; const bf16x2_t b = __builtin_convertvector(v, bf16x2_t); return __builtin_bit_cast(unsigned, b); }
__device__ __forceinline__ float bf_lo(unsigned w) { return __uint_as_float(w << 16); }
__device__ __forceinline__ float bf_hi(unsigned w) { return __uint_as_float(w & 0xffff0000u); }
__device__ __forceinline__ float fsigmoid(float x) { return __builtin_amdgcn_rcpf(1.0f + __expf(-x)); }
__device__ __forceinline__ float fsilu(float x) { return x * fsigmoid(x); }
__device__ __forceinline__ f32x4 act4(f32x4 v, int act) {
    if (act == 1) { v[0] = fsilu(v[0]); v[1] = fsilu(v[1]); v[2] = fsilu(v[2]); v[3] = fsilu(v[3]); }
    else if (act == 2) { v[0] = fsigmoid(v[0]); v[1] = fsigmoid(v[1]); v[2] = fsigmoid(v[2]); v[3] = fsigmoid(v[3]); }
    else if (act == 3) { v = v * 0.08838834764831845f; }
    return v;
}
struct EpiIn {
    static constexpr bool PERM = true, AFTER_DRAIN = false;
    bf16_t *QKV, *Z, *BQ, *BZ, *IQ, *GA, *GB, *IK; float *BETA, *GG, *IW; float* out; const float* a_log; const float* dt_bias; bf16_t* BKV;
    __device__ __forceinline__ void operator()(const f32x4 (&acc)[2][2][4][2], const Unit& u, int wr, int wc, int fr, int fq) const {
        const int pn = u.pn, row0 = u.pm * BM + wr * 64 + fr, cl = wc * 32 + 8 * fq;
        if (pn < 56 || (pn >= 58 && pn < 90)) {
            bf16_t* dst; int ldc, cbase, act;
            if (pn < 32) { dst = QKV; ldc = 8192; cbase = pn * 256; act = 0; }
            else if (pn < 48) { dst = Z; ldc = 4096; cbase = (pn - 32) * 256; act = 1; }
            else if (pn < 56) { dst = BQ; ldc = 2048; cbase = (pn - 48) * 256; act = 3; }
            else if (pn < 66) { dst = BZ; ldc = 2048; cbase = (pn - 58) * 256; act = 1; }
            else if (pn < 74) { dst = IQ; ldc = 2048; cbase = (pn - 66) * 256; act = 0; }
            else if (pn < 82) { dst = GA; ldc = 2048; cbase = (pn - 74) * 256; act = 2; }
            else { dst = GB; ldc = 2048; cbase = (pn - 82) * 256; act = 2; }
            const float csc = act == 3 ? 0.08838834764831845f : 1.0f;
            const bool use_sig = (act == 1) || (act == 2), keep_x = act != 2;
            bf16_t* base = dst + (size_t)row0 * ldc + cbase + cl;
            if (use_sig) {
#pragma unroll
                for (int ai = 0; ai < 2; ++ai)
#pragma unroll
                    for (int m = 0; m < 4; ++m)
#pragma unroll
                        for (int bj = 0; bj < 2; ++bj) {
                            f32x4 v0 = acc[ai][bj][m][0], v1 = acc[ai][bj][m][1];
#pragma unroll
                            for (int e = 0; e < 4; ++e) { const float s0 = fsigmoid(v0[e]), s1 = fsigmoid(v1[e]); v0[e] = keep_x ? v0[e] * s0 : s0; v1[e] = keep_x ? v1[e] * s1 : s1; }
                            u32x4 w; w.x = cvt_pk_bf16(v0[0], v0[1]); w.y = cvt_pk_bf16(v0[2], v0[3]); w.z = cvt_pk_bf16(v1[0], v1[1]); w.w = cvt_pk_bf16(v1[2], v1[3]);
                            __builtin_nontemporal_store(w, (u32x4*)(base + (size_t)(ai * HALF + m * 16) * ldc + bj * HALF));
                        }
            } else {
#pragma unroll
                for (int ai = 0; ai < 2; ++ai)
#pragma unroll
                    for (int m = 0; m < 4; ++m)
#pragma unroll
                        for (int bj = 0; bj < 2; ++bj) {
                            const f32x4 v0 = acc[ai][bj][m][0] * csc, v1 = acc[ai][bj][m][1] * csc;
                            u32x4 w; w.x = cvt_pk_bf16(v0[0], v0[1]); w.y = cvt_pk_bf16(v0[2], v0[3]); w.z = cvt_pk_bf16(v1[0], v1[1]); w.w = cvt_pk_bf16(v1[2], v1[3]);
                            __builtin_nontemporal_store(w, (u32x4*)(base + (size_t)(ai * HALF + m * 16) * ldc + bj * HALF));
                        }
            }
            if (pn < 32 && ((u.pm & 7) == 7)) {
                int fro = fr; asm volatile("" : "+v"(fro));
                if (wr == 1 && fro >= 13) {
                    float* tail = out + O_CP + ((size_t)(u.pm >> 3) * 3 + (fro - 13)) * CONVCH + cbase + 8 * (fq) + wc * 32;
#pragma unroll
                    for (int bj = 0; bj < 2; ++bj) { *(f32x4*)(tail + bj * HALF) = acc[1][bj][3][0]; *(f32x4*)(tail + bj * HALF + 4) = acc[1][bj][3][1]; }
                }
            }
            if (pn < 32 && u.pm == MP / BM) {
                int fro = fr; asm volatile("" : "+v"(fro));
#pragma unroll
                for (int ai = 0; ai < 2; ++ai)
#pragma unroll
                    for (int m = 0; m < 4; ++m) { const int rr = ai * HALF + wr * 64 + m * 16 + fro, t = rr & 7;
                        if (t >= 5) { float* tail = out + O_CS + ((size_t)(rr >> 3) * 3 + (t - 5)) * CONVCH + cbase + cl;
#pragma unroll
                            for (int bj = 0; bj < 2; ++bj) { *(f32x4*)(tail + bj * HALF) = acc[ai][bj][m][0]; *(f32x4*)(tail + bj * HALF + 4) = acc[ai][bj][m][1]; } } }
            }
        } else if (pn < 58) {
#pragma unroll
            for (int ai = 0; ai < 2; ++ai)
#pragma unroll
                for (int m = 0; m < 4; ++m) {
                    const int row = row0 + ai * HALF + m * 16;
                    float* rowp = out + (row < MP ? (pn == 56 ? O_KP : O_VP) + (size_t)row * 256 : (pn == 56 ? O_KS : O_VS) + (size_t)(row - MP) * 256) + cl;
#pragma unroll
                    for (int bj = 0; bj < 2; ++bj) { const f32x4 v0 = acc[ai][bj][m][0], v1 = acc[ai][bj][m][1]; *(f32x4*)(rowp + bj * HALF) = v0; *(f32x4*)(rowp + bj * HALF + 4) = v1;
                        u32x4 w; w.x = cvt_pk_bf16(v0[0], v0[1]); w.y = cvt_pk_bf16(v0[2], v0[3]); w.z = cvt_pk_bf16(v1[0], v1[1]); w.w = cvt_pk_bf16(v1[2], v1[3]);
                        *(u32x4*)(BKV + (size_t)row * 512 + (pn == 57 ? 256 : 0) + cl + bj * HALF) = w; }
                }
        } else {
#pragma unroll
            for (int ai = 0; ai < 2; ++ai)
#pragma unroll
                for (int m = 0; m < 4; ++m) {
                    const int row = row0 + ai * HALF + m * 16;
                    {
                        const f32x4 v0 = acc[ai][0][m][0], v1 = acc[ai][0][m][1];
                        float* o = out + (row < MP ? O_KIP + (size_t)row * 128 : O_KIS + (size_t)(row - MP) * 128) + cl;
                        *(f32x4*)o = v0; *(f32x4*)(o + 4) = v1;
                        u32x4 w; w.x = cvt_pk_bf16(v0[0], v0[1]); w.y = cvt_pk_bf16(v0[2], v0[3]); w.z = cvt_pk_bf16(v1[0], v1[1]); w.w = cvt_pk_bf16(v1[2], v1[3]);
                        *(u32x4*)(IK + (size_t)row * 128 + cl) = w;
                    }
                    {
                        f32x4 v0 = acc[ai][1][m][0], v1 = acc[ai][1][m][1];
                        if (wc == 0) {
                            float* o = BETA + (size_t)row * 32 + cl;
                            v0 = act4(v0, 2); v1 = act4(v1, 2); *(f32x4*)o = v0; *(f32x4*)(o + 4) = v1;
                        } else if (wc == 1) {
                            const int h0 = cl - 32; float* o = GG + (size_t)row * 32 + h0;
                            float r[8];
#pragma unroll
                            for (int e = 0; e < 8; ++e) { const float x = (e < 4 ? v0[e & 3] : v1[e & 3]) + dt_bias[h0 + e]; const float sp = fmaxf(x, 0.f) + __logf(1.0f + __expf(-fabsf(x))); r[e] = -__expf(a_log[h0 + e]) * sp; }
                            *(f32x4*)o = (f32x4){r[0], r[1], r[2], r[3]}; *(f32x4*)(o + 4) = (f32x4){r[4], r[5], r[6], r[7]};
                        } else if (wc == 2 && fq < 2) {
                            float* o = IW + (size_t)row * 16 + (cl - 64);
                            *(f32x4*)o = v0; *(f32x4*)(o + 4) = v1;
                        }
                    }
                }
        }
    }
};
struct EpiM1 {
    static constexpr bool PERM = true, AFTER_DRAIN = false;
    const bf16_t* GA; bf16_t* TMP;
    __device__ __forceinline__ void operator()(const f32x4 (&acc)[2][2][4][2], const Unit& u, int wr, int wc, int fr, int fq) const {
        const int row0 = u.pm * BM + wr * 64 + fr, col0 = u.pn * BM + wc * 32 + 8 * fq;
        u32x4 gw[2][4][2];
#pragma unroll
        for (int ai = 0; ai < 2; ++ai)
#pragma unroll
            for (int m = 0; m < 4; ++m)
#pragma unroll
                for (int bj = 0; bj < 2; ++bj) gw[ai][m][bj] = *(const u32x4*)(GA + (size_t)(row0 + ai * HALF + m * 16) * D + col0 + bj * HALF);
#pragma unroll
        for (int ai = 0; ai < 2; ++ai)
#pragma unroll
            for (int m = 0; m < 4; ++m) { const size_t off = (size_t)(row0 + ai * HALF + m * 16) * D + col0;
#pragma unroll
                for (int bj = 0; bj < 2; ++bj) { const u32x4 g4 = gw[ai][m][bj]; const f32x4 v0 = acc[ai][bj][m][0], v1 = acc[ai][bj][m][1];
                    u32x4 w; w.x = cvt_pk_bf16(v0[0] * bf_lo(g4.x), v0[1] * bf_hi(g4.x)); w.y = cvt_pk_bf16(v0[2] * bf_lo(g4.y), v0[3] * bf_hi(g4.y));
                    w.z = cvt_pk_bf16(v1[0] * bf_lo(g4.z), v1[1] * bf_hi(g4.z)); w.w = cvt_pk_bf16(v1[2] * bf_lo(g4.w), v1[3] * bf_hi(g4.w));
                    *(u32x4*)(TMP + off + bj * HALF) = w; } }
    }
};
struct EpiM2 {
    static constexpr bool PERM = true, AFTER_DRAIN = false;
    const bf16_t* GB; const bf16_t* TMP; bf16_t* MG;
    __device__ __forceinline__ void operator()(const f32x4 (&acc)[2][2][4][2], const Unit& u, int wr, int wc, int fr, int fq) const {
        const int row0 = u.pm * BM + wr * 64 + fr, col0 = u.pn * BM + wc * 32 + 8 * fq;
#pragma unroll
        for (int ai = 0; ai < 2; ++ai)
#pragma unroll
            for (int mh = 0; mh < 2; ++mh) {
                u32x4 gw[2][2], tw[2][2];
#pragma unroll
                for (int mm = 0; mm < 2; ++mm)
#pragma unroll
                    for (int bj = 0; bj < 2; ++bj) { const size_t off = (size_t)(row0 + ai * HALF + (2 * mh + mm) * 16) * D + col0 + bj * HALF; gw[mm][bj] = *(const u32x4*)(GB + off); tw[mm][bj] = *(const u32x4*)(TMP + off); }
#pragma unroll
                for (int mm = 0; mm < 2; ++mm)
#pragma unroll
                    for (int bj = 0; bj < 2; ++bj) { const int m = 2 * mh + mm; const size_t off = (size_t)(row0 + ai * HALF + m * 16) * D + col0 + bj * HALF; const u32x4 g4 = gw[mm][bj], t4 = tw[mm][bj]; const f32x4 v0 = acc[ai][bj][m][0], v1 = acc[ai][bj][m][1];
                        u32x4 w; w.x = cvt_pk_bf16(bf_lo(t4.x) + v0[0] * bf_lo(g4.x), bf_hi(t4.x) + v0[1] * bf_hi(g4.x)); w.y = cvt_pk_bf16(bf_lo(t4.y) + v0[2] * bf_lo(g4.y), bf_hi(t4.y) + v0[3] * bf_hi(g4.y));
                        w.z = cvt_pk_bf16(bf_lo(t4.z) + v1[0] * bf_lo(g4.z), bf_hi(t4.z) + v1[1] * bf_hi(g4.z)); w.w = cvt_pk_bf16(bf_lo(t4.w) + v1[2] * bf_lo(g4.w), bf_hi(t4.w) + v1[3] * bf_hi(g4.w));
                        *(u32x4*)(MG + off) = w; }
            }
    }
};
struct EpiChain {
    static constexpr bool PERM = true, AFTER_DRAIN = false;
    const bf16_t *GA, *GB; bf16_t* MG;
    __device__ __forceinline__ void operator()(f32x4 (&acc)[2][2][4][2], const Unit& u, int wr, int wc, int fr, int fq) const {
        if (u.seg == 0) return;
        const int row0 = u.pm * BM + wr * 64 + fr, col0 = u.pn * BM + wc * 32 + 8 * fq;
        if (u.seg == 1) {
#pragma unroll
            for (int ai = 0; ai < 2; ++ai) {
                u32x4 ga[4][2], gb[4][2];
#pragma unroll
                for (int m = 0; m < 4; ++m)
#pragma unroll
                    for (int bj = 0; bj < 2; ++bj) { const size_t off = (size_t)(row0 + ai * HALF + m * 16) * D + col0 + bj * HALF; ga[m][bj] = *(const u32x4*)(GA + off); gb[m][bj] = *(const u32x4*)(GB + off); }
#pragma unroll
                for (int m = 0; m < 4; ++m)
#pragma unroll
                    for (int bj = 0; bj < 2; ++bj) { const u32x4 a4 = ga[m][bj], b4 = gb[m][bj];
                        acc[ai][bj][m][0] = acc[ai][bj][m][0] * (f32x4){bf_lo(a4.x) * __builtin_amdgcn_rcpf(fmaxf(bf_lo(b4.x), 1e-30f)), bf_hi(a4.x) * __builtin_amdgcn_rcpf(fmaxf(bf_hi(b4.x), 1e-30f)), bf_lo(a4.y) * __builtin_amdgcn_rcpf(fmaxf(bf_lo(b4.y), 1e-30f)), bf_hi(a4.y) * __builtin_amdgcn_rcpf(fmaxf(bf_hi(b4.y), 1e-30f))};
                        acc[ai][bj][m][1] = acc[ai][bj][m][1] * (f32x4){bf_lo(a4.z) * __builtin_amdgcn_rcpf(fmaxf(bf_lo(b4.z), 1e-30f)), bf_hi(a4.z) * __builtin_amdgcn_rcpf(fmaxf(bf_hi(b4.z), 1e-30f)), bf_lo(a4.w) * __builtin_amdgcn_rcpf(fmaxf(bf_lo(b4.w), 1e-30f)), bf_hi(a4.w) * __builtin_amdgcn_rcpf(fmaxf(bf_hi(b4.w), 1e-30f))}; }
            }
        } else {
            u32x4 gb[2][4][2];
#pragma unroll
            for (int ai = 0; ai < 2; ++ai)
#pragma unroll
                for (int m = 0; m < 4; ++m)
#pragma unroll
                    for (int bj = 0; bj < 2; ++bj) gb[ai][m][bj] = *(const u32x4*)(GB + (size_t)(row0 + ai * HALF + m * 16) * D + col0 + bj * HALF);
#pragma unroll
            for (int ai = 0; ai < 2; ++ai)
#pragma unroll
                for (int m = 0; m < 4; ++m)
#pragma unroll
                    for (int bj = 0; bj < 2; ++bj) { const u32x4 b4 = gb[ai][m][bj]; const f32x4 v0 = acc[ai][bj][m][0], v1 = acc[ai][bj][m][1];
                        u32x4 w; w.x = cvt_pk_bf16(v0[0] * bf_lo(b4.x), v0[1] * bf_hi(b4.x)); w.y = cvt_pk_bf16(v0[2] * bf_lo(b4.y), v0[3] * bf_hi(b4.y));
                        w.z = cvt_pk_bf16(v1[0] * bf_lo(b4.z), v1[1] * bf_hi(b4.z)); w.w = cvt_pk_bf16(v1[2] * bf_lo(b4.w), v1[3] * bf_hi(b4.w));
                        *(u32x4*)(MG + (size_t)(row0 + ai * HALF + m * 16) * D + col0 + bj * HALF) = w; }
        }
    }
};
struct EpiBf16P {
    static constexpr bool PERM = true, AFTER_DRAIN = false;
    bf16_t* C; int ldc;
    __device__ __forceinline__ void operator()(const f32x4 (&acc)[2][2][4][2], const Unit& u, int wr, int wc, int fr, int fq) const {
        const int row0 = u.pm * BM + wr * 64 + fr, col0 = u.pn * BM + wc * 32 + 8 * fq;
#pragma unroll
        for (int ai = 0; ai < 2; ++ai)
#pragma unroll
            for (int m = 0; m < 4; ++m) { bf16_t* rowp = C + (size_t)(row0 + ai * HALF + m * 16) * ldc + col0;
#pragma unroll
                for (int bj = 0; bj < 2; ++bj) { const f32x4 v0 = acc[ai][bj][m][0], v1 = acc[ai][bj][m][1];
                    u32x4 w; w.x = cvt_pk_bf16(v0[0], v0[1]); w.y = cvt_pk_bf16(v0[2], v0[3]); w.z = cvt_pk_bf16(v1[0], v1[1]); w.w = cvt_pk_bf16(v1[2], v1[3]);
                    *(u32x4*)(rowp + bj * HALF) = w; } }
    }
};
#ifndef PG8_B_AUX
#define PG8_B_AUX 0
#endif
template <class Epi, class Sched, bool ALIGN_EPI = false, bool SP2 = false>
__device__ __forceinline__ void gemm_phase(PG8_LAS unsigned char* lds, const Gemm g, const Sched& S, const Epi& E) {
    const int tid = threadIdx.x, wid = __builtin_amdgcn_readfirstlane(tid >> 6), lane = tid & 63, wr = wid >> 2, wc = wid & 3, fr = lane & 15, fq = lane >> 4;
    const int K = g.K, nt = K / BK;
    unsigned voffA[2], voffB[2];
#pragma unroll
    for (int i = 0; i < 2; ++i) { int R, C; stage_rc(tid * 16 + i * 8192, R, C); const int Rb = Epi::PERM ? ((R & ~31) + perm32(R & 31)) : R;
        voffA[i] = (unsigned)(R * K + C) * 2u; voffB[i] = (unsigned)(Rb * K + C) * 2u; }
    const size_t kstep = (size_t)(BK * 2);
    const size_t hstep = (size_t)HALF * K * 2;
    const size_t tstep = 2 * hstep;
    const unsigned ldsw = (unsigned)wid * 1024u;
    const int aoff = lds_byte(wr * 64 + fr, fq * 8), boff = lds_byte(wc * 32 + fr, fq * 8);
#define PG8_SA(b, h) (((b) * 2 + (h)) * HTB)
#define PG8_SB(b, h) ((4 + (b) * 2 + (h)) * HTB)
#define PG8_STAGE(bufoff, gbase, voff) do { _Pragma("unroll") for (int _i = 0; _i < 2; ++_i) \
        __builtin_amdgcn_global_load_lds((const unsigned*)((const char*)(gbase) + (voff)[_i]), (PG8_LAS unsigned*)(lds + (bufoff) + ldsw + _i * 8192), 16, 0, ((bufoff) >= 4 * HTB) ? PG8_B_AUX : 0); } while (0)
#define PG8_LDA(dst, b, h) do { _Pragma("unroll") for (int m = 0; m < 4; ++m) _Pragma("unroll") for (int k = 0; k < 2; ++k) dst[m][k] = *(const PG8_LAS bf16x8*)(lds + PG8_SA(b, h) + aoff + m * 2048 + k * 1024); } while (0)
#define PG8_LDB(dst, b, h) do { _Pragma("unroll") for (int n = 0; n < 2; ++n) _Pragma("unroll") for (int k = 0; k < 2; ++k) dst[n][k] = *(const PG8_LAS bf16x8*)(lds + PG8_SB(b, h) + boff + n * 2048 + k * 1024); } while (0)
#define PG8_MMA(ai, bj, At, Bt) do { __builtin_amdgcn_s_setprio(1); _Pragma("unroll") for (int m = 0; m < 4; ++m) _Pragma("unroll") for (int n = 0; n < 2; ++n) _Pragma("unroll") for (int k = 0; k < 2; ++k) \
        acc[ai][bj][m][n] = __builtin_amdgcn_mfma_f32_16x16x32_bf16(Bt[n][k], At[m][k], acc[ai][bj][m][n], 0, 0, 0); __builtin_amdgcn_s_setprio(0); } while (0)
#define PG8_WAIT_V(n) asm volatile("s_waitcnt vmcnt(" #n ")" ::: "memory")
#define PG8_WAIT_L(n) asm volatile("s_waitcnt lgkmcnt(" #n ")" ::: "memory")
#define PG8_BAR __builtin_amdgcn_s_barrier()
#define PG8_SCHED __builtin_amdgcn_sched_barrier(0)
    Unit cur, nxt; int ui = 0;
    if (!S.next(0, cur)) return;
    f32x4 acc[2][2][4][2];
#pragma unroll
    for (int a = 0; a < 2; ++a)
#pragma unroll
        for (int b = 0; b < 2; ++b)
#pragma unroll
            for (int m = 0; m < 4; ++m)
#pragma unroll
                for (int n = 0; n < 2; ++n) acc[a][b][m][n] = (f32x4){0.f, 0.f, 0.f, 0.f};
    bf16x8 At[4][2], B0[2][2], B1[2][2];
    const char* cA = (const char*)g.A + (size_t)cur.pm * tstep; const char* cB = (const char*)g.Bt + (size_t)cur.pn * tstep;
    S.a_ready(cur);
    if constexpr (SP2) {
        PG8_STAGE(PG8_SB(0, 0), cB, voffB); PG8_STAGE(PG8_SB(0, 1), cB + hstep, voffB); PG8_STAGE(PG8_SA(0, 0), cA, voffA); PG8_STAGE(PG8_SA(0, 1), cA + hstep, voffA);
        if (wr == 1) PG8_BAR;
        PG8_WAIT_V(2); PG8_BAR;
        PG8_STAGE(PG8_SB(1, 0), cB + kstep, voffB); PG8_STAGE(PG8_SA(1, 0), cA + kstep, voffA); PG8_STAGE(PG8_SB(1, 1), cB + hstep + kstep, voffB);
        PG8_WAIT_V(6); PG8_BAR;
    } else {
        PG8_STAGE(PG8_SB(0, 0), cB, voffB); PG8_STAGE(PG8_SA(0, 0), cA, voffA); PG8_STAGE(PG8_SB(0, 1), cB + hstep, voffB); PG8_STAGE(PG8_SA(0, 1), cA + hstep, voffA);
        if (wr == 1) PG8_BAR;
        PG8_WAIT_V(4); PG8_BAR;
        PG8_STAGE(PG8_SB(1, 0), cB + kstep, voffB); PG8_STAGE(PG8_SA(1, 0), cA + kstep, voffA); PG8_STAGE(PG8_SB(1, 1), cB + hstep + kstep, voffB);
        PG8_WAIT_V(6); PG8_BAR;
    }
    for (;;) {
        const bool has_next = S.next(ui + 1, nxt);
        const char* nA = has_next ? (const char*)g.A + (size_t)nxt.pm * tstep : cA; const char* nB = has_next ? (const char*)g.Bt + (size_t)nxt.pn * tstep : cB;
        for (int t = 0; t < nt; t += 2) {
            const bool last = (t == nt - 2);
            const char* a1 = cA + (size_t)(t + 1) * kstep;
            const char* a2 = last ? nA : cA + (size_t)(t + 2) * kstep; const char* b2 = last ? nB : cB + (size_t)(t + 2) * kstep;
            const char* a3 = a2 + kstep; const char* b3 = b2 + kstep;
            if (last && has_next) S.a_ready(nxt);
            if constexpr (SP2) {
            PG8_LDB(B0, 0, 0); PG8_LDB(B1, 0, 1); PG8_SCHED; PG8_LDA(At, 0, 0); PG8_STAGE(PG8_SA(1, 1), a1 + hstep, voffA);
            PG8_WAIT_V(8); PG8_WAIT_L(0); PG8_BAR; PG8_MMA(0, 0, At, B0); PG8_MMA(0, 1, At, B1); PG8_BAR; PG8_SCHED;
            PG8_LDA(At, 0, 1); PG8_STAGE(PG8_SB(0, 0), b2, voffB); PG8_STAGE(PG8_SB(0, 1), b2 + hstep, voffB); PG8_STAGE(PG8_SA(0, 0), a2, voffA);
            PG8_WAIT_V(8); PG8_WAIT_L(0); PG8_BAR; PG8_MMA(1, 0, At, B0); PG8_MMA(1, 1, At, B1); PG8_BAR; PG8_SCHED;
            PG8_LDB(B0, 1, 0); PG8_LDB(B1, 1, 1); PG8_SCHED; PG8_LDA(At, 1, 0); PG8_STAGE(PG8_SA(0, 1), a2 + hstep, voffA);
            PG8_WAIT_V(8); PG8_WAIT_L(0); PG8_BAR; PG8_MMA(0, 0, At, B0); PG8_MMA(0, 1, At, B1); PG8_BAR; PG8_SCHED;
            PG8_LDA(At, 1, 1); PG8_STAGE(PG8_SB(1, 0), b3, voffB); PG8_STAGE(PG8_SB(1, 1), b3 + hstep, voffB); PG8_STAGE(PG8_SA(1, 0), a3, voffA);
            PG8_WAIT_V(8); PG8_WAIT_L(0); PG8_BAR; PG8_MMA(1, 0, At, B0); PG8_MMA(1, 1, At, B1); PG8_BAR; PG8_SCHED;
            } else {
            PG8_LDB(B0, 0, 0); PG8_SCHED; PG8_LDA(At, 0, 0); PG8_STAGE(PG8_SA(1, 1), a1 + hstep, voffA);
            PG8_WAIT_L(8); PG8_BAR; PG8_WAIT_L(0); PG8_MMA(0, 0, At, B0); PG8_BAR; PG8_SCHED;
            PG8_LDB(B1, 0, 1); PG8_STAGE(PG8_SB(0, 0), b2, voffB);
            PG8_BAR; PG8_WAIT_L(0); PG8_MMA(0, 1, At, B1); PG8_BAR;
            PG8_LDA(At, 0, 1); PG8_STAGE(PG8_SA(0, 0), a2, voffA);
            PG8_BAR; PG8_WAIT_L(0); PG8_MMA(1, 0, At, B0); PG8_BAR; PG8_SCHED;
            PG8_STAGE(PG8_SB(0, 1), b2 + hstep, voffB);
            PG8_WAIT_V(6); PG8_BAR; PG8_MMA(1, 1, At, B1); PG8_BAR;
            PG8_LDB(B0, 1, 0); PG8_SCHED; PG8_LDA(At, 1, 0); PG8_STAGE(PG8_SA(0, 1), a2 + hstep, voffA);
            PG8_WAIT_L(8); PG8_BAR; PG8_WAIT_L(0); PG8_MMA(0, 0, At, B0); PG8_BAR; PG8_SCHED;
            PG8_LDB(B1, 1, 1); PG8_STAGE(PG8_SB(1, 0), b3, voffB);
            PG8_BAR; PG8_WAIT_L(0); PG8_MMA(0, 1, At, B1); PG8_BAR;
            PG8_LDA(At, 1, 1); PG8_STAGE(PG8_SA(1, 0), a3, voffA);
            PG8_BAR; PG8_WAIT_L(0); PG8_MMA(1, 0, At, B0); PG8_BAR; PG8_SCHED;
            PG8_STAGE(PG8_SB(1, 1), b3 + hstep, voffB);
            PG8_WAIT_V(6); PG8_BAR; PG8_MMA(1, 1, At, B1); PG8_BAR;
            }
        }
        if constexpr (ALIGN_EPI) { if (wr == 0) PG8_BAR; }
        if constexpr (!Epi::AFTER_DRAIN) { E(acc, cur, wr, wc, fr, fq); S.done(cur); }
        if (!has_next) break;
#pragma unroll
        for (int a = 0; a < 2; ++a)
#pragma unroll
            for (int b = 0; b < 2; ++b)
#pragma unroll
                for (int m = 0; m < 4; ++m)
#pragma unroll
                    for (int n = 0; n < 2; ++n) acc[a][b][m][n] = (f32x4){0.f, 0.f, 0.f, 0.f};
        cur = nxt; cA = nA; cB = nB; ++ui;
        if constexpr (ALIGN_EPI) { if (wr == 1) PG8_BAR; }
    }
    PG8_WAIT_V(0);
    if constexpr (!ALIGN_EPI) { if (wr == 0) PG8_BAR; }
    PG8_BAR;
    if constexpr (Epi::AFTER_DRAIN) { E.fused(acc, cur, wr, wc, fr, fq, lds, wid, lane); S.done(cur); }
#undef PG8_SA
#undef PG8_SB
#undef PG8_STAGE
#undef PG8_LDA
#undef PG8_LDB
#undef PG8_MMA
#undef PG8_WAIT_V
#undef PG8_WAIT_L
#undef PG8_BAR
#undef PG8_SCHED
}
struct GemmChain { const bf16_t* A; const bf16_t* Bt; size_t segA, segB; int M, N, K; };
struct ChainOrder : StaticOrder {
    __host__ __device__ bool next(int i, Unit& u) const { const int ti = i / 3; if (!StaticOrder::next(ti, u)) return false; u.seg = i - 3 * ti; return true; }
};
template <class Epi, class Sched, bool ALIGN_EPI = false, bool SP2 = false>
__device__ __forceinline__ void gemm_chain(PG8_LAS unsigned char* lds, const GemmChain g, const Sched& S, const Epi& E) {
    const int tid = threadIdx.x, wid = __builtin_amdgcn_readfirstlane(tid >> 6), lane = tid & 63, wr = wid >> 2, wc = wid & 3, fr = lane & 15, fq = lane >> 4;
    const int K = g.K, nt = K / BK;
    unsigned voffA[2], voffB[2];
#pragma unroll
    for (int i = 0; i < 2; ++i) { int R, C; stage_rc(tid * 16 + i * 8192, R, C); const int Rb = Epi::PERM ? ((R & ~31) + perm32(R & 31)) : R;
        voffA[i] = (unsigned)(R * K + C) * 2u; voffB[i] = (unsigned)(Rb * K + C) * 2u; }
    const size_t kstep = (size_t)(BK * 2);
    const size_t hstep = (size_t)HALF * K * 2;
    const size_t tstep = 2 * hstep;
    const unsigned ldsw = (unsigned)wid * 1024u;
    const int aoff = lds_byte(wr * 64 + fr, fq * 8), boff = lds_byte(wc * 32 + fr, fq * 8);
#define PG8_SA(b, h) (((b) * 2 + (h)) * HTB)
#define PG8_SB(b, h) ((4 + (b) * 2 + (h)) * HTB)
#define PG8_STAGE(bufoff, gbase, voff) do { _Pragma("unroll") for (int _i = 0; _i < 2; ++_i) \
        __builtin_amdgcn_global_load_lds((const unsigned*)((const char*)(gbase) + (voff)[_i]), (PG8_LAS unsigned*)(lds + (bufoff) + ldsw + _i * 8192), 16, 0, 0); } while (0)
#define PG8_LDA(dst, b, h) do { _Pragma("unroll") for (int m = 0; m < 4; ++m) _Pragma("unroll") for (int k = 0; k < 2; ++k) dst[m][k] = *(const PG8_LAS bf16x8*)(lds + PG8_SA(b, h) + aoff + m * 2048 + k * 1024); } while (0)
#define PG8_LDB(dst, b, h) do { _Pragma("unroll") for (int n = 0; n < 2; ++n) _Pragma("unroll") for (int k = 0; k < 2; ++k) dst[n][k] = *(const PG8_LAS bf16x8*)(lds + PG8_SB(b, h) + boff + n * 2048 + k * 1024); } while (0)
#define PG8_MMA(ai, bj, At, Bt) do { __builtin_amdgcn_s_setprio(1); _Pragma("unroll") for (int m = 0; m < 4; ++m) _Pragma("unroll") for (int n = 0; n < 2; ++n) _Pragma("unroll") for (int k = 0; k < 2; ++k) \
        acc[ai][bj][m][n] = __builtin_amdgcn_mfma_f32_16x16x32_bf16(Bt[n][k], At[m][k], acc[ai][bj][m][n], 0, 0, 0); __builtin_amdgcn_s_setprio(0); } while (0)
#define PG8_WAIT_V(n) asm volatile("s_waitcnt vmcnt(" #n ")" ::: "memory")
#define PG8_WAIT_L(n) asm volatile("s_waitcnt lgkmcnt(" #n ")" ::: "memory")
#define PG8_BAR __builtin_amdgcn_s_barrier()
#define PG8_SCHED __builtin_amdgcn_sched_barrier(0)
    Unit cur, nxt; int ui = 0;
    if (!S.next(0, cur)) return;
    f32x4 acc[2][2][4][2];
#pragma unroll
    for (int a = 0; a < 2; ++a)
#pragma unroll
        for (int b = 0; b < 2; ++b)
#pragma unroll
            for (int m = 0; m < 4; ++m)
#pragma unroll
                for (int n = 0; n < 2; ++n) acc[a][b][m][n] = (f32x4){0.f, 0.f, 0.f, 0.f};
    bf16x8 At[4][2], B0[2][2], B1[2][2];
    const char* cA = (const char*)(g.A + (size_t)cur.seg * g.segA) + (size_t)cur.pm * tstep; const char* cB = (const char*)(g.Bt + (size_t)cur.seg * g.segB) + (size_t)cur.pn * tstep;
    S.a_ready(cur);
    if constexpr (SP2) {
        PG8_STAGE(PG8_SB(0, 0), cB, voffB); PG8_STAGE(PG8_SB(0, 1), cB + hstep, voffB); PG8_STAGE(PG8_SA(0, 0), cA, voffA); PG8_STAGE(PG8_SA(0, 1), cA + hstep, voffA);
        if (wr == 1) PG8_BAR;
        PG8_WAIT_V(2); PG8_BAR;
        PG8_STAGE(PG8_SB(1, 0), cB + kstep, voffB); PG8_STAGE(PG8_SA(1, 0), cA + kstep, voffA); PG8_STAGE(PG8_SB(1, 1), cB + hstep + kstep, voffB);
        PG8_WAIT_V(6); PG8_BAR;
    } else {
        PG8_STAGE(PG8_SB(0, 0), cB, voffB); PG8_STAGE(PG8_SA(0, 0), cA, voffA); PG8_STAGE(PG8_SB(0, 1), cB + hstep, voffB); PG8_STAGE(PG8_SA(0, 1), cA + hstep, voffA);
        if (wr == 1) PG8_BAR;
        PG8_WAIT_V(4); PG8_BAR;
        PG8_STAGE(PG8_SB(1, 0), cB + kstep, voffB); PG8_STAGE(PG8_SA(1, 0), cA + kstep, voffA); PG8_STAGE(PG8_SB(1, 1), cB + hstep + kstep, voffB);
        PG8_WAIT_V(6); PG8_BAR;
    }
    for (;;) {
        const bool has_next = S.next(ui + 1, nxt);
        const char* nA = has_next ? (const char*)(g.A + (size_t)nxt.seg * g.segA) + (size_t)nxt.pm * tstep : cA; const char* nB = has_next ? (const char*)(g.Bt + (size_t)nxt.seg * g.segB) + (size_t)nxt.pn * tstep : cB;
        for (int t = 0; t < nt; t += 2) {
            const bool last = (t == nt - 2);
            const char* a1 = cA + (size_t)(t + 1) * kstep;
            const char* a2 = last ? nA : cA + (size_t)(t + 2) * kstep; const char* b2 = last ? nB : cB + (size_t)(t + 2) * kstep;
            const char* a3 = a2 + kstep; const char* b3 = b2 + kstep;
            if (last && has_next) S.a_ready(nxt);
            if constexpr (SP2) {
            PG8_LDB(B0, 0, 0); PG8_LDB(B1, 0, 1); PG8_SCHED; PG8_LDA(At, 0, 0); PG8_STAGE(PG8_SA(1, 1), a1 + hstep, voffA);
            PG8_WAIT_V(8); PG8_WAIT_L(0); PG8_BAR; PG8_MMA(0, 0, At, B0); PG8_MMA(0, 1, At, B1); PG8_BAR; PG8_SCHED;
            PG8_LDA(At, 0, 1); PG8_STAGE(PG8_SB(0, 0), b2, voffB); PG8_STAGE(PG8_SB(0, 1), b2 + hstep, voffB); PG8_STAGE(PG8_SA(0, 0), a2, voffA);
            PG8_WAIT_V(8); PG8_WAIT_L(0); PG8_BAR; PG8_MMA(1, 0, At, B0); PG8_MMA(1, 1, At, B1); PG8_BAR; PG8_SCHED;
            PG8_LDB(B0, 1, 0); PG8_LDB(B1, 1, 1); PG8_SCHED; PG8_LDA(At, 1, 0); PG8_STAGE(PG8_SA(0, 1), a2 + hstep, voffA);
            PG8_WAIT_V(8); PG8_WAIT_L(0); PG8_BAR; PG8_MMA(0, 0, At, B0); PG8_MMA(0, 1, At, B1); PG8_BAR; PG8_SCHED;
            PG8_LDA(At, 1, 1); PG8_STAGE(PG8_SB(1, 0), b3, voffB); PG8_STAGE(PG8_SB(1, 1), b3 + hstep, voffB); PG8_STAGE(PG8_SA(1, 0), a3, voffA);
            PG8_WAIT_V(8); PG8_WAIT_L(0); PG8_BAR; PG8_MMA(1, 0, At, B0); PG8_MMA(1, 1, At, B1); PG8_BAR; PG8_SCHED;
            } else {
            PG8_LDB(B0, 0, 0); PG8_SCHED; PG8_LDA(At, 0, 0); PG8_STAGE(PG8_SA(1, 1), a1 + hstep, voffA);
            PG8_WAIT_L(8); PG8_BAR; PG8_WAIT_L(0); PG8_MMA(0, 0, At, B0); PG8_BAR; PG8_SCHED;
            PG8_LDB(B1, 0, 1); PG8_STAGE(PG8_SB(0, 0), b2, voffB);
            PG8_BAR; PG8_WAIT_L(0); PG8_MMA(0, 1, At, B1); PG8_BAR;
            PG8_LDA(At, 0, 1); PG8_STAGE(PG8_SA(0, 0), a2, voffA);
            PG8_BAR; PG8_WAIT_L(0); PG8_MMA(1, 0, At, B0); PG8_BAR; PG8_SCHED;
            PG8_STAGE(PG8_SB(0, 1), b2 + hstep, voffB);
            PG8_WAIT_V(6); PG8_BAR; PG8_MMA(1, 1, At, B1); PG8_BAR;
            PG8_LDB(B0, 1, 0); PG8_SCHED; PG8_LDA(At, 1, 0); PG8_STAGE(PG8_SA(0, 1), a2 + hstep, voffA);
            PG8_WAIT_L(8); PG8_BAR; PG8_WAIT_L(0); PG8_MMA(0, 0, At, B0); PG8_BAR; PG8_SCHED;
            PG8_LDB(B1, 1, 1); PG8_STAGE(PG8_SB(1, 0), b3, voffB);
            PG8_BAR; PG8_WAIT_L(0); PG8_MMA(0, 1, At, B1); PG8_BAR;
            PG8_LDA(At, 1, 1); PG8_STAGE(PG8_SA(1, 0), a3, voffA);
            PG8_BAR; PG8_WAIT_L(0); PG8_MMA(1, 0, At, B0); PG8_BAR; PG8_SCHED;
            PG8_STAGE(PG8_SB(1, 1), b3 + hstep, voffB);
            PG8_WAIT_V(6); PG8_BAR; PG8_MMA(1, 1, At, B1); PG8_BAR;
            }
        }
        if constexpr (ALIGN_EPI) { if (wr == 0) PG8_BAR; }
        if constexpr (!Epi::AFTER_DRAIN) { E(acc, cur, wr, wc, fr, fq); S.done(cur); }
        if (!has_next) break;
        if (nxt.seg == 0)
#pragma unroll
        for (int a = 0; a < 2; ++a)
#pragma unroll
            for (int b = 0; b < 2; ++b)
#pragma unroll
                for (int m = 0; m < 4; ++m)
#pragma unroll
                    for (int n = 0; n < 2; ++n) acc[a][b][m][n] = (f32x4){0.f, 0.f, 0.f, 0.f};
        cur = nxt; cA = nA; cB = nB; ++ui;
        if constexpr (ALIGN_EPI) { if (wr == 1) PG8_BAR; }
    }
    PG8_WAIT_V(0);
    if constexpr (!ALIGN_EPI) { if (wr == 0) PG8_BAR; }
    PG8_BAR;
    if constexpr (Epi::AFTER_DRAIN) { E.fused(acc, cur, wr, wc, fr, fq, lds, wid, lane); S.done(cur); }
#undef PG8_SA
#undef PG8_SB
#undef PG8_STAGE
#undef PG8_LDA
#undef PG8_LDB
#undef PG8_MMA
#undef PG8_WAIT_V
#undef PG8_WAIT_L
#undef PG8_BAR
#undef PG8_SCHED
}
}
#ifndef MK_ONE_LAUNCH
#define MK_ONE_LAUNCH 1
#endif
constexpr int NWAVES = 8, NTHREADS = NWAVES * 64;
constexpr int N_PHASES = 9;
constexpr size_t MiB = 1u << 20;
constexpr size_t WS_CTL = 0, CTL_ZERO_BYTES = 32 * 1024 + 36 * 6144 * 4;
constexpr size_t WS_MOD = 32 * 1024;
constexpr size_t WS_WIN = 2 * MiB;
constexpr size_t WS_WPA = 94 * MiB;
constexpr size_t WS_WPB = 110 * MiB;
constexpr size_t WS_WOUT = 118 * MiB;
constexpr size_t WS_H = 126 * MiB;
constexpr size_t WS_QKV = 159 * MiB;
constexpr size_t WS_Z = 291 * MiB;
constexpr size_t WS_BQ = 357 * MiB;
constexpr size_t WS_BZ = 390 * MiB;
constexpr size_t WS_IQ = 423 * MiB;
constexpr size_t WS_GA = 456 * MiB, WS_GB = 489 * MiB;
constexpr size_t WS_IK = 522 * MiB;
constexpr size_t WS_BETA = 525 * MiB, WS_GG = 527 * MiB, WS_IW = 529 * MiB;
constexpr size_t WS_YA = 530 * MiB;
constexpr size_t WS_YB = 596 * MiB;
constexpr size_t WS_SC = 629 * MiB;
constexpr size_t WS_SCS = 693 * MiB;
constexpr size_t WS_SEL = 702 * MiB;
constexpr size_t WS_CNT = 711 * MiB;
constexpr size_t WS_TMP = 712 * MiB;
constexpr size_t WS_MG = 778 * MiB;
constexpr size_t WS_OUTF = 811 * MiB;
constexpr size_t WS_QNP = 712 * MiB, WS_KNP = 744 * MiB, WS_KTP = 776 * MiB, WS_VTP = 808 * MiB;
constexpr size_t WS_FR = 877 * MiB;
constexpr size_t WS_QNS = 1171 * MiB, WS_KNS = 1179 * MiB, WS_KTS = 1187 * MiB, WS_VTS = 1195 * MiB;
constexpr size_t WS_END = 1211 * MiB;
constexpr size_t WS_BKV = 1162 * MiB;
static_assert(WS_WIN + (size_t)NPAD * D * 2 <= WS_WPA && WS_H + (size_t)MROWS * D * 2 <= WS_QKV && WS_QKV + (size_t)MROWS * 8192 * 2 <= WS_Z && WS_Z + (size_t)MROWS * 4096 * 2 <= WS_BQ, "ws map");
static_assert(WS_SC + (size_t)MP * 2048 * 4 <= WS_SCS && WS_SCS + (size_t)MS * SCS_LD * 4 <= WS_SEL && WS_SEL + (size_t)MROWS * 256 * 4 <= WS_CNT && WS_TMP + (size_t)MROWS * D * 4 <= WS_MG && WS_OUTF + (size_t)MROWS * D * 4 <= WS_END, "ws map 2");
constexpr int CW_BAR = 4096;
constexpr int CW_Q0 = 32;
constexpr int CW_ATTQ = 64;
constexpr int RING_BYTES = 147456;
constexpr int LDSCTL_OFF = RING_BYTES, MISC_OFF = LDSCTL_OFF + 320;
constexpr int LDS_BYTES = 151552;

#define GAS __attribute__((address_space(1)))
#define LAS __attribute__((address_space(3)))
typedef unsigned short bf16;
typedef unsigned v4u __attribute__((ext_vector_type(4)));
typedef unsigned v2u __attribute__((ext_vector_type(2)));
typedef float f32x4 __attribute__((ext_vector_type(4)));
typedef short bf16x8 __attribute__((ext_vector_type(8)));
typedef short s16x4 __attribute__((ext_vector_type(4)));
typedef GAS unsigned gu32;
#define LDS_WAIT() asm volatile("s_waitcnt lgkmcnt(0)" ::: "memory")
#define VM_WAIT() asm volatile("s_waitcnt vmcnt(0)" ::: "memory")
__device__ __forceinline__ float bf2f(bf16 v) { return __uint_as_float(((unsigned)v) << 16); }
__device__ __forceinline__ unsigned pk2(float lo, float hi) { return pg8::cvt_pk_bf16(lo, hi); }
__device__ __forceinline__ bf16 f2bf(float f) { return (bf16)(pg8::cvt_pk_bf16(f, 0.f) & 0xffffu); }
__device__ __forceinline__ float wave_sum(float v) {
#pragma unroll
    for (int o = 1; o < 64; o <<= 1) v += __shfl_xor(v, o);
    return v;
}
__device__ __forceinline__ float row16_sum(float v) {
    v += __builtin_bit_cast(float, __builtin_amdgcn_mov_dpp(__builtin_bit_cast(int, v), 0xB1, 0xf, 0xf, true));
    v += __builtin_bit_cast(float, __builtin_amdgcn_mov_dpp(__builtin_bit_cast(int, v), 0x4E, 0xf, 0xf, true));
    v += __builtin_bit_cast(float, __builtin_amdgcn_mov_dpp(__builtin_bit_cast(int, v), 0x141, 0xf, 0xf, true));
    v += __builtin_bit_cast(float, __builtin_amdgcn_mov_dpp(__builtin_bit_cast(int, v), 0x140, 0xf, 0xf, true));
    return v;
}
__device__ __forceinline__ unsigned dpp_swap1(unsigned v) { return (unsigned)__builtin_amdgcn_mov_dpp((int)v, 0xB1, 0xf, 0xf, true); }
__device__ __forceinline__ int wave_sum_i(int v) {
#pragma unroll
    for (int o = 1; o < 64; o <<= 1) v += __shfl_xor(v, o);
    return v;
}

#define XB_TMO      128
#define XB_XCNT(j)  (256  + 64 * (j))
#define XB_XSUB(j)  (1280 + 64 * (j))
#define XB_XGEN(j)  (2304 + 64 * (j))
#define XB_TOP      3328
#define XB_TOPGEN   3392
#define XCD_BAR_WORDS 3456
#define XB_SPIN_CAP (1u << 18)
__device__ __forceinline__ unsigned xb_ld(unsigned* p)              { return __hip_atomic_load(p, __ATOMIC_RELAXED, __HIP_MEMORY_SCOPE_AGENT); }
__device__ __forceinline__ unsigned xb_add(unsigned* p, unsigned v) { return __hip_atomic_fetch_add(p, v, __ATOMIC_RELAXED, __HIP_MEMORY_SCOPE_AGENT); }
__device__ __forceinline__ unsigned xb_xcc_id() { return (unsigned)__builtin_amdgcn_s_getreg((3 << 11) | 20) & 0xFu; }
#define XB_SPIN(cond, bar) do { unsigned _sp = 0; while (cond) { __builtin_amdgcn_s_sleep(1); \
    if ((++_sp & 255u) == 0u) { if (xb_ld(&(bar)[XB_TMO])) break; if (_sp > XB_SPIN_CAP) { atomicAdd(&(bar)[XB_TMO], 1u); break; } } } } while (0)
struct XcdBarrier { unsigned* bar; unsigned x; volatile LAS unsigned* st; };
__device__ __forceinline__ XcdBarrier xcd_barrier_post(unsigned* bar, volatile LAS unsigned* st) {
    XcdBarrier b; b.bar = bar; b.x = xb_xcc_id(); b.st = st;
    if (threadIdx.x == 0) (void)xb_add(&bar[XB_XCNT(b.x)], 1u);
    return b;
}
__device__ __forceinline__ void xcd_barrier_complete(unsigned* bar, unsigned x, unsigned& nloc, unsigned& nx) {
    const unsigned G = gridDim.x * gridDim.y * gridDim.z;
    unsigned sum, cnt, mine, sp = 0u;
    for (;;) {
        sum = 0u; cnt = 0u; mine = 0u;
#pragma unroll
        for (unsigned j = 0; j < 16; ++j) { const unsigned c = xb_ld(&bar[XB_XCNT(j)]); sum += c; cnt += (c > 0u) ? 1u : 0u; mine = (j == x) ? c : mine; }
        if (sum == G) break;
        __builtin_amdgcn_s_sleep(1);
        if ((++sp & 255u) == 0u) { if (xb_ld(&bar[XB_TMO])) break; if (sp > XB_SPIN_CAP) { atomicAdd(&bar[XB_TMO], 1u); break; } }
    }
    nloc = mine > 0u ? mine : 1u; nx = cnt > 0u ? cnt : 1u;
}
__device__ __forceinline__ void xcd_barrier(const XcdBarrier& b) {
    asm volatile("s_waitcnt vmcnt(0)" ::: "memory");
    __syncthreads();
    if (threadIdx.x == 0) {
        unsigned* bar = b.bar;
        __builtin_amdgcn_s_waitcnt(0);
        unsigned nloc = b.st[0], nx = b.st[1];
        if (nloc == 0u) { xcd_barrier_complete(bar, b.x, nloc, nx); b.st[0] = nloc; b.st[1] = nx; }
        const unsigned old = xb_add(&bar[XB_XSUB(b.x)], 1u);
        const unsigned gen = old / nloc;
        if (old + 1u == (gen + 1u) * nloc) {
            __builtin_amdgcn_fence(__ATOMIC_RELEASE, "agent");
            asm volatile("s_waitcnt vmcnt(0)" ::: "memory");
            const unsigned og = xb_add(&bar[XB_TOP], 1u);
            const unsigned tg = og / nx;
            if (og + 1u == (tg + 1u) * nx) xb_add(&bar[XB_TOPGEN], 1u);
            else XB_SPIN(xb_ld(&bar[XB_TOPGEN]) == tg, bar);
            __builtin_amdgcn_fence(__ATOMIC_ACQUIRE, "agent");
            xb_add(&bar[XB_XGEN(b.x)], 1u);
            asm volatile("s_waitcnt vmcnt(0)" ::: "memory");
        } else {
            XB_SPIN(xb_ld(&bar[XB_XGEN(b.x)]) == gen, bar);
            __builtin_amdgcn_fence(__ATOMIC_ACQUIRE, "agent");
            asm volatile("s_waitcnt vmcnt(0)" ::: "memory");
        }
    }
    __syncthreads();
}

struct Args {
    const float *x_p, *x_s, *c_p, *c_s, *cache_k, *cache_v, *cache_kidx, *state_gdn, *state_conv; const int* page_table;
    const float *w_ada, *b_ada, *pre_g, *w_in, *conv_w, *a_log, *dt_bias, *gdn_g, *w_pa, *w_pb, *w_out, *post_g;
    float* out; unsigned char* ws; int ph_lo, ph_hi;
};
static_assert(sizeof(Args) == 24 * 8 + 8, "Args has no padding");
template <int OFF> __device__ __forceinline__ const void* karg_ptr() {
    unsigned long long v; const unsigned long long kp = (unsigned long long)__builtin_amdgcn_kernarg_segment_ptr();
    asm volatile("s_load_dwordx2 %0, %1, %2\n\ts_waitcnt lgkmcnt(0)" : "=s"(v) : "s"(kp), "n"(OFF));
    return (const void*)(const __attribute__((address_space(1))) void*)v;
}
#define KARG(A, f) (A).f = (decltype((A).f))karg_ptr<(int)__builtin_offsetof(Args, f)>()
__device__ __forceinline__ Args load_args(int lo, int hi) {
    Args A;
    KARG(A, x_p); KARG(A, x_s); KARG(A, c_p); KARG(A, c_s); KARG(A, cache_k); KARG(A, cache_v); KARG(A, cache_kidx); KARG(A, state_gdn); KARG(A, state_conv); KARG(A, page_table);
    KARG(A, w_ada); KARG(A, b_ada); KARG(A, pre_g); KARG(A, w_in); KARG(A, conv_w); KARG(A, a_log); KARG(A, dt_bias); KARG(A, gdn_g); KARG(A, w_pa); KARG(A, w_pb); KARG(A, w_out); KARG(A, post_g);
    KARG(A, out); KARG(A, ws); A.ph_lo = lo; A.ph_hi = hi;
    return A;
}


__device__ __forceinline__ void transpose_item(const float* W, int Nsrc, int K, bf16* WT, int n0, int k0, bool remap, LAS float* scr, int lane) {
    const int nl = lane & 31, nd = n0 + nl, sc = remap ? win_src_col(nd) : nd;
#pragma unroll 8
    for (int i = 0; i < 32; ++i) { const int kk = 2 * i + (lane >> 5); const float vl = W[(size_t)(k0 + kk) * Nsrc + (sc >= 0 ? sc : 0)]; scr[kk * 33 + nl] = sc >= 0 ? vl : 0.f; }
    LDS_WAIT(); asm volatile("" ::: "memory");
    const int c = lane & 7;
#pragma unroll
    for (int j = 0; j < 4; ++j) { const int n = (lane >> 3) + 8 * j; const LAS float* s = scr + (8 * c) * 33 + n;
        v4u o; o.x = pk2(s[0 * 33], s[1 * 33]); o.y = pk2(s[2 * 33], s[3 * 33]); o.z = pk2(s[4 * 33], s[5 * 33]); o.w = pk2(s[6 * 33], s[7 * 33]);
        *(GAS v4u*)(WT + (size_t)(n0 + n) * K + k0 + 8 * c) = o; }
    LDS_WAIT(); asm volatile("" ::: "memory");
}
__device__ __forceinline__ void win_tr_load(const float* W, int n0, int k0, float (&v)[32], int lane) {
    const int sc = win_src_col(n0 + (lane & 31)); const float* p = W + (size_t)(k0 + (lane >> 5)) * NIN + (sc >= 0 ? sc : 0);
#pragma unroll
    for (int i = 0; i < 32; ++i) v[i] = __builtin_nontemporal_load(p + (size_t)(2 * i) * NIN);
}
__device__ __forceinline__ void win_tr_store(const float (&v)[32], bf16* WT, int n0, int k0, LAS float* scr, int lane) {
    const int nl = lane & 31; const bool ok = win_src_col(n0 + nl) >= 0;
#pragma unroll
    for (int i = 0; i < 32; ++i) scr[(2 * i + (lane >> 5)) * 33 + nl] = ok ? v[i] : 0.f;
    LDS_WAIT(); asm volatile("" ::: "memory");
    const int c = lane & 7;
#pragma unroll
    for (int j = 0; j < 4; ++j) { const int n = (lane >> 3) + 8 * j; const LAS float* s = scr + (8 * c) * 33 + n;
        v4u o; o.x = pk2(s[0 * 33], s[1 * 33]); o.y = pk2(s[2 * 33], s[3 * 33]); o.z = pk2(s[4 * 33], s[5 * 33]); o.w = pk2(s[6 * 33], s[7 * 33]);
        *(GAS v4u*)(WT + (size_t)(n0 + n) * D + k0 + 8 * c) = o; }
    LDS_WAIT(); asm volatile("" ::: "memory");
}
__device__ __forceinline__ void mod_item(const Args& a, float* mod, int item, LAS float* scr, int lane) {
    const int kc = item / 96, cg = item % 96, col = cg * 64 + lane;
    float acc[36];
#pragma unroll
    for (int r = 0; r < 36; ++r) acc[r] = 0.f;
    {
        const int kb = kc * 64;
#pragma unroll 4
        for (int r = 0; r < 36; ++r) { const float cv = (r < 4) ? a.c_p[r * D + kb + lane] : a.c_s[(r - 4) * D + kb + lane]; scr[r * 64 + lane] = cv * __builtin_amdgcn_rcpf(1.0f + __expf(-cv)); }
        LDS_WAIT(); asm volatile("" ::: "memory");
        for (int k4 = 0; k4 < 16; ++k4) {
            const float* wp = a.w_ada + (size_t)(kb + 4 * k4) * 6144 + col;
            const float w0 = wp[0], w1 = wp[6144], w2 = wp[2 * 6144], w3 = wp[3 * 6144];
#pragma unroll
            for (int r = 0; r < 36; ++r) { const f32x4 s = *(const LAS f32x4*)(scr + r * 64 + 4 * k4); acc[r] += s[0] * w0 + s[1] * w1 + s[2] * w2 + s[3] * w3; }
        }
        LDS_WAIT(); asm volatile("" ::: "memory");
    }
#pragma unroll
    for (int r = 0; r < 36; ++r) unsafeAtomicAdd(mod + r * 6144 + col, acc[r]);
}

__device__ __forceinline__ unsigned off_b(unsigned row, unsigned ch) { return 256u * row + 16u * (ch ^ (((row & 3) << 2) | ((row >> 2) & 3))); }
__device__ __forceinline__ unsigned tr_read_addr_16(unsigned lane, unsigned c, unsigned t) { const unsigned g = lane >> 4, q = (lane & 15) >> 2, p = lane & 3; return off_b(8 * g + 4 * t + q, 2 * c + (p >> 1)) + 8 * (p & 1); }
__device__ __forceinline__ s16x4 vtr(const LAS unsigned char* p) { return __builtin_bit_cast(s16x4, __builtin_amdgcn_ds_read_tr16_b64_v4i16((LAS s16x4*)p)); }
constexpr int NITEM_P = BP * HV * 32, NITEM_S = BS * HV, NITEM = NITEM_P + NITEM_S;
constexpr int GA_T1 = 0, GA_T2 = 8704, GA_GV = 17408, GA_BV = GA_GV + 256, GA_RK = GA_BV + 256, GA_RQ = GA_RK + 256, GA_WAVE_BYTES = GA_RQ + 256;
constexpr int SC_KI = 0, SC_QF = 16, SC_MF = 32, SC_GF = 40, SC_GF2 = 41, SC_TF = 42, SC_NROW = 50, SC_BUF_BYTES = SC_NROW * 1024, SC_SSQ = 2 * SC_BUF_BYTES, SC_GBASE = 32, SC_GROWS = 18;
__host__ __device__ __forceinline__ int sigma_dk(int t, int r) { return 32 * (t >> 1) + 8 * (r >> 2) + 4 * (t & 1) + (r & 3); }
struct GItem { const bf16 *KN, *QN, *KT, *VT; int Lt, grow, nvalid, id; };
__device__ __forceinline__ GItem gitem_of(const Args& a, int item) {
    GItem I;
    if (item < NITEM_P) { const int c = item & 31, hv = (item >> 5) & 31, b = item >> 10, hq = hv >> 1;
        I.KN = (const bf16*)(a.ws + WS_KNP) + ((size_t)(b * HQK + hq) * LP + 64 * c) * 128; I.QN = (const bf16*)(a.ws + WS_QNP) + ((size_t)(b * HQK + hq) * LP + 64 * c) * 128;
        I.KT = (const bf16*)(a.ws + WS_KTP) + (size_t)(b * HQK + hq) * 128 * LP + 64 * c; I.VT = (const bf16*)(a.ws + WS_VTP) + (size_t)(b * HV + hv) * 128 * LP + 64 * c;
        I.Lt = LP; I.grow = b * LP + 64 * c; I.nvalid = 64; I.id = item; }
    else { const int r = item - NITEM_P, hv = r & 31, b = r >> 5, hq = hv >> 1;
        I.KN = (const bf16*)(a.ws + WS_KNS) + (size_t)(b * HQK + hq) * 64 * 128; I.QN = (const bf16*)(a.ws + WS_QNS) + (size_t)(b * HQK + hq) * 64 * 128;
        I.KT = (const bf16*)(a.ws + WS_KTS) + (size_t)(b * HQK + hq) * 128 * 64; I.VT = (const bf16*)(a.ws + WS_VTS) + (size_t)(b * HV + hv) * 128 * 64;
        I.Lt = 64; I.grow = MP + b * LS; I.nvalid = LS; I.id = item; }
    return I;
}
__device__ __forceinline__ void prep_item(const Args& a, int item, int lane) {
    asm volatile("" : "+v"(lane));
    const bf16* QKV = (const bf16*)(a.ws + WS_QKV);
    const bool sample = item >= BP * 32 * 64;
    int slot, tc, b;
    if (!sample) { slot = item & 63; tc = (item >> 6) & 31; b = item >> 11; } else { const int r = item - BP * 32 * 64; slot = r & 63; tc = 0; b = r >> 6; }
    const int mode = slot < 16 ? 0 : (slot < 32 ? 1 : 2), hd = mode == 0 ? slot : (mode == 1 ? slot - 16 : slot - 32);
    const int ch = (mode == 0 ? 0 : (mode == 1 ? 2048 : 4096)) + hd * 128 + 2 * lane, t0 = tc * 64;
    const int Lt = sample ? 64 : LP, nreal = sample ? LS : 64;
    const size_t rowbase = sample ? (size_t)MP + b * LS : (size_t)b * LP + t0;
    bf16* drow = nullptr; bf16* dtr = nullptr;
    if (mode == 0) drow = (bf16*)(a.ws + (sample ? WS_QNS : WS_QNP)) + ((size_t)(b * HQK + hd) * Lt + t0) * 128;
    else if (mode == 1) drow = (bf16*)(a.ws + (sample ? WS_KNS : WS_KNP)) + ((size_t)(b * HQK + hd) * Lt + t0) * 128;
    else dtr = (bf16*)(a.ws + (sample ? WS_VTS : WS_VTP)) + ((size_t)(b * HV + hd) * 128 + 2 * lane) * Lt + t0;
    const int rpos = 2 * lane;
    float w0[4], w1[4];
#pragma unroll
    for (int i = 0; i < 4; ++i) { w0[i] = a.conv_w[i * CONVCH + ch]; w1[i] = a.conv_w[i * CONVCH + ch + 1]; }
    float xa[3][2];
#pragma unroll
    for (int i = 0; i < 3; ++i) {
        if (sample) { xa[i][0] = a.state_conv[((size_t)b * 3 + i) * CONVCH + ch]; xa[i][1] = a.state_conv[((size_t)b * 3 + i) * CONVCH + ch + 1]; }
        else { const int t = t0 - 3 + i; unsigned u = *(const unsigned*)(QKV + ((size_t)b * LP + (t >= 0 ? t : 0)) * CONVCH + ch); if (t < 0) u = 0u; xa[i][0] = pg8::bf_lo(u); xa[i][1] = pg8::bf_hi(u); }
    }
    unsigned uall[64];
#pragma unroll
    for (int e = 0; e < 64; ++e) { const unsigned ul = *(const unsigned*)(QKV + (rowbase + (e < nreal ? e : nreal - 1)) * CONVCH + ch); uall[e] = e < nreal ? ul : 0u; }
#pragma unroll
    for (int t8 = 0; t8 < 8; ++t8) {
        float y0[8], y1[8];
        if (8 * t8 < nreal) {
#pragma unroll
            for (int e = 0; e < 8; ++e) {
                const float x0 = pg8::bf_lo(uall[8 * t8 + e]), x1 = pg8::bf_hi(uall[8 * t8 + e]);
                float v0 = w0[0] * xa[0][0] + w0[1] * xa[1][0] + w0[2] * xa[2][0] + w0[3] * x0;
                float v1 = w1[0] * xa[0][1] + w1[1] * xa[1][1] + w1[2] * xa[2][1] + w1[3] * x1;
                xa[0][0] = xa[1][0]; xa[0][1] = xa[1][1]; xa[1][0] = xa[2][0]; xa[1][1] = xa[2][1]; xa[2][0] = x0; xa[2][1] = x1;
                v0 = v0 * __builtin_amdgcn_rcpf(1.0f + __expf(-v0)); v1 = v1 * __builtin_amdgcn_rcpf(1.0f + __expf(-v1));
                y0[e] = v0; y1[e] = v1;
            }
        } else {
#pragma unroll
            for (int e = 0; e < 8; ++e) { y0[e] = 0.f; y1[e] = 0.f; }
        }
        if (drow) {
#pragma unroll
            for (int e = 0; e < 8; ++e) *(unsigned*)(drow + (size_t)(8 * t8 + e) * 128 + rpos) = pk2(y0[e], y1[e]);
        }
        if (dtr) {
            v4u p0, p1; p0.x = pk2(y0[0], y0[1]); p0.y = pk2(y0[2], y0[3]); p0.z = pk2(y0[4], y0[5]); p0.w = pk2(y0[6], y0[7]);
            p1.x = pk2(y1[0], y1[1]); p1.y = pk2(y1[2], y1[3]); p1.z = pk2(y1[4], y1[5]); p1.w = pk2(y1[6], y1[7]);
            *(v4u*)(dtr + 8 * t8) = p0; *(v4u*)(dtr + Lt + 8 * t8) = p1;
        }
    }
}
template <int I> __device__ __forceinline__ void subst_row(float (&t)[64], const LAS float* Am, int lane) {
    if constexpr (I < 64) {
        float acc[4] = {(lane == I) ? 1.f : 0.f, 0.f, 0.f, 0.f};
#pragma unroll
        for (int j4 = 0; j4 < (I + 3) / 4; ++j4) { const f32x4 a4 = *(const LAS f32x4*)(Am + I * 68 + 4 * j4);
#pragma unroll
            for (int e = 0; e < 4; ++e) if (4 * j4 + e < I) acc[e] -= a4[e] * t[4 * j4 + e]; }
        t[I] = (acc[0] + acc[1]) + (acc[2] + acc[3]);
        if constexpr ((I & 7) == 7) __builtin_amdgcn_sched_barrier(0);
        subst_row<I + 1>(t, Am, lane);
    }
}
__device__ __forceinline__ bf16x8 ld_2x8(const bf16* p0, const bf16* p1) { const v2u a = *(const v2u*)p0, b = *(const v2u*)p1; const v4u w = {a.x, a.y, b.x, b.y}; return __builtin_bit_cast(bf16x8, w); }
__device__ __forceinline__ bf16x8 lds_2x8(const LAS bf16* p0, const LAS bf16* p1) { const v2u a = *(const LAS v2u*)p0, b = *(const LAS v2u*)p1; const v4u w = {a.x, a.y, b.x, b.y}; return __builtin_bit_cast(bf16x8, w); }
__device__ __forceinline__ void gdnA_item(const Args& a, LAS unsigned char* wl, int item, int lane) {
    asm volatile("" : "+v"(lane));
    const GItem I = gitem_of(a, item);
    const int m = lane & 15, g = lane >> 4;
    LAS float* Am = (LAS float*)(wl + GA_T1); LAS bf16* T1 = (LAS bf16*)(wl + GA_T1); LAS bf16* T2 = (LAS bf16*)(wl + GA_T2);
    LAS float* GV = (LAS float*)(wl + GA_GV); LAS float* BV = (LAS float*)(wl + GA_BV); LAS float* RK = (LAS float*)(wl + GA_RK); LAS float* RQ = (LAS float*)(wl + GA_RQ);
    float bl = 0.f, G = 0.f;
    {
        const int hvx = (item < NITEM_P) ? ((item >> 5) & 31) : ((item - NITEM_P) & 31), lr = lane < I.nvalid ? lane : I.nvalid - 1;
        const float blv = ((const float*)(a.ws + WS_BETA))[(size_t)(I.grow + lr) * 32 + hvx], gv = ((const float*)(a.ws + WS_GG))[(size_t)(I.grow + lr) * 32 + hvx];
        if (lane < I.nvalid) { bl = blv; G = gv; }
    }
#pragma unroll
    for (int o = 1; o < 64; o <<= 1) { const float t = __shfl_up(G, o); if (lane >= o) G += t; }
    const float Glast = __shfl(G, 63);
    GV[lane] = G; BV[lane] = bl;
    v4u* FR = (v4u*)(a.ws + WS_FR) + (size_t)I.id * SC_GROWS * 64;
    bf16x8 kf[4][4], qf[4][4];
#pragma unroll
    for (int t = 0; t < 4; ++t)
#pragma unroll
        for (int s = 0; s < 4; ++s) kf[t][s] = *(const bf16x8*)(I.KN + (size_t)(16 * t + m) * 128 + 32 * s + 8 * g);
#pragma unroll
    for (int t = 0; t < 4; ++t)
#pragma unroll
        for (int s = 0; s < 4; ++s) qf[t][s] = *(const bf16x8*)(I.QN + (size_t)(16 * t + m) * 128 + 32 * s + 8 * g);
    f32x4 kd[4];
#pragma unroll
    for (int it = 0; it < 4; ++it) {
        f32x4 aq = {0.f, 0.f, 0.f, 0.f}; kd[it] = (f32x4){0.f, 0.f, 0.f, 0.f};
#pragma unroll
        for (int s = 0; s < 4; ++s) { kd[it] = __builtin_amdgcn_mfma_f32_16x16x32_bf16(kf[it][s], kf[it][s], kd[it], 0, 0, 0); aq = __builtin_amdgcn_mfma_f32_16x16x32_bf16(qf[it][s], qf[it][s], aq, 0, 0, 0); }
        if (g == (m >> 2)) { const int e = m & 3; const float dk2 = e == 0 ? kd[it][0] : (e == 1 ? kd[it][1] : (e == 2 ? kd[it][2] : kd[it][3])), dq2 = e == 0 ? aq[0] : (e == 1 ? aq[1] : (e == 2 ? aq[2] : aq[3]));
            RK[16 * it + m] = rsqrtf(dk2 + L2_EPS); RQ[16 * it + m] = rsqrtf(dq2 + L2_EPS) * 0.08838834764831845f; }
    }
    const float rkl = RK[lane], rql = RQ[lane];
    { float* GF = (float*)(FR + (SC_GF - SC_GBASE) * 64); GF[lane] = __expf(G) * rql; if (lane < 32) GF[64 + lane] = __expf(Glast); GF[128 + lane] = __expf(Glast - G) * rkl;
      GF[256 + lane] = bl; GF[256 + 64 + lane] = __expf(G) * rkl; }
#pragma unroll
    for (int it = 0; it < 4; ++it) {
        const f32x4 gi = *(const LAS f32x4*)(GV + 16 * it + 4 * g), bi = *(const LAS f32x4*)(BV + 16 * it + 4 * g) * *(const LAS f32x4*)(RK + 16 * it + 4 * g);
#pragma unroll
        for (int jt = 0; jt <= it; ++jt) {
            f32x4 acc = kd[it];
            if (jt < it) { acc = (f32x4){0.f, 0.f, 0.f, 0.f};
#pragma unroll
                for (int s = 0; s < 4; ++s) acc = __builtin_amdgcn_mfma_f32_16x16x32_bf16(kf[it][s], kf[jt][s], acc, 0, 0, 0); }
            const float gj = GV[16 * jt + m], rj = RK[16 * jt + m];
#pragma unroll
            for (int e = 0; e < 4; ++e) { const int i = 16 * it + 4 * g + e, j = 16 * jt + m; Am[i * 68 + j] = (i > j) ? bi[e] * rj * acc[e] * __expf(gi[e] - gj) : 0.f; }
        }
    }
    {
        v4u* MF = FR + (SC_MF - SC_GBASE) * 64;
#pragma unroll
        for (int it = 0; it < 4; ++it) {
            const float gi = GV[16 * it + m], rqi = RQ[16 * it + m];
            f32x4 mt[4];
#pragma unroll
            for (int jt = 0; jt < 4; ++jt) {
                mt[jt] = (f32x4){0.f, 0.f, 0.f, 0.f};
                if (jt <= it) {
                    f32x4 acc = {0.f, 0.f, 0.f, 0.f};
#pragma unroll
                    for (int s = 0; s < 4; ++s) acc = __builtin_amdgcn_mfma_f32_16x16x32_bf16(kf[jt][s], qf[it][s], acc, 0, 0, 0);
                    const f32x4 gj = *(const LAS f32x4*)(GV + 16 * jt + 4 * g), rj = *(const LAS f32x4*)(RK + 16 * jt + 4 * g);
#pragma unroll
                    for (int e = 0; e < 4; ++e) { const int i = 16 * it + m, j = 16 * jt + 4 * g + e; mt[jt][e] = (i >= j) ? acc[e] * rqi * rj[e] * __expf(gi - gj[e]) : 0.f; }
                }
            }
#pragma unroll
            for (int s = 0; s < 2; ++s) { v4u w; w.x = pk2(mt[2 * s][0], mt[2 * s][1]); w.y = pk2(mt[2 * s][2], mt[2 * s][3]); w.z = pk2(mt[2 * s + 1][0], mt[2 * s + 1][1]); w.w = pk2(mt[2 * s + 1][2], mt[2 * s + 1][3]);
                MF[(it * 2 + s) * 64 + lane] = w; }
        }
    }
    asm volatile("" ::: "memory");
    float t[64];
    subst_row<0>(t, Am, lane);
#pragma unroll
    for (int i = 0; i < 64; ++i) T1[i * 68 + lane] = f2bf(t[i]);
    asm volatile("" ::: "memory");
#pragma unroll
    for (int it = 0; it < 4; ++it)
#pragma unroll
        for (int s2 = 0; s2 < 2; ++s2)
            FR[(SC_TF - SC_GBASE + it * 2 + s2) * 64 + lane] = __builtin_bit_cast(v4u, lds_2x8(T1 + (16 * it + m) * 68 + 32 * s2 + 4 * g, T1 + (16 * it + m) * 68 + 32 * s2 + 16 + 4 * g));
}
__device__ __forceinline__ void scan_stage_dma(const Args& a, int id, const bf16* qrows, const bf16* krows, LAS unsigned char* buf, int wave, int lane) {
    const v4u* src = (const v4u*)(a.ws + WS_FR) + (size_t)id * SC_GROWS * 64 + lane;
    const bf16* qsrc = qrows + (size_t)(lane & 15) * 128 + 8 * (lane >> 4);
#pragma unroll
    for (int k = 0; k < 8; ++k) { const int r = wave + 8 * k;
        if (r < SC_QF) { const int j = 4 * r + (lane >> 4), slot = lane & 15, ch = slot ^ (((j & 3) << 2) | ((j >> 2) & 3));
            __builtin_amdgcn_global_load_lds((const unsigned*)(krows + (size_t)j * 128 + 8 * ch), (LAS unsigned*)(buf + r * 1024), 16, 0, 0); }
        else if (r < SC_MF) { const int fq = r - SC_QF; __builtin_amdgcn_global_load_lds((const unsigned*)(qsrc + (size_t)(16 * (fq >> 2)) * 128 + 32 * (fq & 3)), (LAS unsigned*)(buf + r * 1024), 16, 0, 0); }
        else if (r < SC_NROW) __builtin_amdgcn_global_load_lds((const unsigned*)(src + (r - SC_GBASE) * 64), (LAS unsigned*)(buf + r * 1024), 16, 0, 2); }
}
__device__ __forceinline__ void scan_chunk(const LAS unsigned char* buf, f32x4 (&S)[8], const v4u (&vb)[2], f32x4 (&O)[4], int lane) {
    const LAS v4u* F = (const LAS v4u*)buf + lane; const LAS float* GFl = (const LAS float*)(buf + SC_GF * 1024);
    const int m = lane & 15, g = lane >> 4, g4 = 4 * g;
    bf16x8 Sb[4];
#pragma unroll
    for (int sp = 0; sp < 4; ++sp) { v4u w; w.x = pk2(S[2 * sp][0], S[2 * sp][1]); w.y = pk2(S[2 * sp][2], S[2 * sp][3]); w.z = pk2(S[2 * sp + 1][0], S[2 * sp + 1][1]); w.w = pk2(S[2 * sp + 1][2], S[2 * sp + 1][3]); Sb[sp] = __builtin_bit_cast(bf16x8, w); }
    f32x4 KS[4];
#pragma unroll
    for (int jt = 0; jt < 4; ++jt) {
        f32x4 ks = {0.f, 0.f, 0.f, 0.f}, qs = {0.f, 0.f, 0.f, 0.f};
#pragma unroll
        for (int sp = 0; sp < 4; ++sp) {
            ks = __builtin_amdgcn_mfma_f32_16x16x32_bf16(*(const LAS bf16x8*)(buf + off_b(16 * jt + m, 4 * sp + g)), Sb[sp], ks, 0, 0, 0);
            qs = __builtin_amdgcn_mfma_f32_16x16x32_bf16(__builtin_bit_cast(bf16x8, F[(SC_QF + jt * 4 + sp) * 64]), Sb[sp], qs, 0, 0, 0);
        }
        KS[jt] = ks; O[jt] = qs * *(const LAS f32x4*)(GFl + 16 * jt + g4);
        __builtin_amdgcn_sched_barrier(0);
    }
    const LAS float* GF2 = (const LAS float*)(buf + SC_GF2 * 1024);
    bf16x8 Rb[2];
#pragma unroll
    for (int s = 0; s < 2; ++s) {
        const f32x4 b0 = *(const LAS f32x4*)(GF2 + 32 * s + g4), b1 = *(const LAS f32x4*)(GF2 + 32 * s + 16 + g4), a0 = *(const LAS f32x4*)(GF2 + 64 + 32 * s + g4), a1 = *(const LAS f32x4*)(GF2 + 64 + 32 * s + 16 + g4);
        const f32x4 v0 = {pg8::bf_lo(vb[s].x), pg8::bf_hi(vb[s].x), pg8::bf_lo(vb[s].y), pg8::bf_hi(vb[s].y)}, v1 = {pg8::bf_lo(vb[s].z), pg8::bf_hi(vb[s].z), pg8::bf_lo(vb[s].w), pg8::bf_hi(vb[s].w)};
        const f32x4 r0 = b0 * (v0 - a0 * KS[2 * s]), r1 = b1 * (v1 - a1 * KS[2 * s + 1]);
        v4u w; w.x = pk2(r0[0], r0[1]); w.y = pk2(r0[2], r0[3]); w.z = pk2(r1[0], r1[1]); w.w = pk2(r1[2], r1[3]); Rb[s] = __builtin_bit_cast(bf16x8, w);
    }
    f32x4 U[4];
#pragma unroll
    for (int it = 0; it < 4; ++it) {
        f32x4 u = {0.f, 0.f, 0.f, 0.f};
#pragma unroll
        for (int s2 = 0; s2 < 2; ++s2) u = __builtin_amdgcn_mfma_f32_16x16x32_bf16(__builtin_bit_cast(bf16x8, F[(SC_TF + it * 2 + s2) * 64]), Rb[s2], u, 0, 0, 0);
        U[it] = u;
    }
    bf16x8 Ub[2], Uc[2];
#pragma unroll
    for (int s = 0; s < 2; ++s) {
        v4u w; w.x = pk2(U[2 * s][0], U[2 * s][1]); w.y = pk2(U[2 * s][2], U[2 * s][3]); w.z = pk2(U[2 * s + 1][0], U[2 * s + 1][1]); w.w = pk2(U[2 * s + 1][2], U[2 * s + 1][3]); Ub[s] = __builtin_bit_cast(bf16x8, w);
        const f32x4 c0 = *(const LAS f32x4*)(GFl + 128 + 32 * s + g4), c1 = *(const LAS f32x4*)(GFl + 128 + 32 * s + 16 + g4), a0 = U[2 * s] * c0, a1 = U[2 * s + 1] * c1;
        v4u x; x.x = pk2(a0[0], a0[1]); x.y = pk2(a0[2], a0[3]); x.z = pk2(a1[0], a1[1]); x.w = pk2(a1[2], a1[3]); Uc[s] = __builtin_bit_cast(bf16x8, x);
    }
#pragma unroll
    for (int it = 0; it < 4; ++it)
#pragma unroll
        for (int s = 0; s < 2; ++s) O[it] = __builtin_amdgcn_mfma_f32_16x16x32_bf16(__builtin_bit_cast(bf16x8, F[(SC_MF + it * 2 + s) * 64]), Ub[s], O[it], 0, 0, 0);
    const float gam = GFl[64];
    const int q4 = (lane & 15) >> 2, p4 = lane & 3;
#pragma unroll
    for (int t = 0; t < 8; ++t) {
        S[t] = S[t] * gam;
#pragma unroll
        for (int s = 0; s < 2; ++s) {
            const s16x4 v0 = vtr(buf + off_b(32 * s + 4 * g + q4, 4 * (t >> 1) + p4) + 8 * (t & 1)), v1 = vtr(buf + off_b(32 * s + 16 + 4 * g + q4, 4 * (t >> 1) + p4) + 8 * (t & 1));
            const bf16x8 kt = (bf16x8){v0[0], v0[1], v0[2], v0[3], v1[0], v1[1], v1[2], v1[3]};
            S[t] = __builtin_amdgcn_mfma_f32_16x16x32_bf16(kt, Uc[s], S[t], 0, 0, 0);
        }
    }
}
__device__ __forceinline__ void scan_norm_partial(LAS float* ssq, const f32x4 (&O)[4], int wave, int lane) {
    const int m = lane & 15, g = lane >> 4;
#pragma unroll
    for (int it = 0; it < 4; ++it) {
        f32x4 q = O[it] * O[it];
        q[0] = row16_sum(q[0]); q[1] = row16_sum(q[1]); q[2] = row16_sum(q[2]); q[3] = row16_sum(q[3]);
        if (m == 0) *(LAS f32x4*)(ssq + wave * 64 + 16 * it + 4 * g) = q;
    }
}
__device__ __forceinline__ void scan_norm_finish(const Args& a, const LAS float* ssq, const f32x4 (&O)[4], const unsigned (&zq)[8], int hv, size_t yrow0, int nrows, int wave, int lane) {
    const int m = lane & 15, g = lane >> 4, odd = lane & 1;
    bf16* YA = (bf16*)(a.ws + WS_YA);
    const float gn = a.gdn_g[16 * wave + m];
#pragma unroll
    for (int it = 0; it < 4; ++it) {
        f32x4 tot = {0.f, 0.f, 0.f, 0.f};
#pragma unroll
        for (int w = 0; w < NWAVES; ++w) tot += *(const LAS f32x4*)(ssq + w * 64 + 16 * it + 4 * g);
#pragma unroll
        for (int pp = 0; pp < 2; ++pp) {
            const unsigned own = zq[it * 2 + pp], nbr = dpp_swap1(own);
            const float z0 = odd ? pg8::bf_hi(nbr) : pg8::bf_lo(own), z1 = odd ? pg8::bf_hi(own) : pg8::bf_lo(nbr);
            const float y0 = O[it][2 * pp] * rsqrtf(tot[2 * pp] * (1.0f / 128.0f) + NORM_EPS) * gn * z0, y1 = O[it][2 * pp + 1] * rsqrtf(tot[2 * pp + 1] * (1.0f / 128.0f) + NORM_EPS) * gn * z1;
            const float r = __builtin_bit_cast(float, dpp_swap1(__builtin_bit_cast(unsigned, odd ? y0 : y1)));
            const unsigned word = odd ? pk2(r, y1) : pk2(y0, r);
            const int row = 16 * it + 4 * g + 2 * pp + odd;
            if (row < nrows) *(unsigned*)(YA + (size_t)(hv >> 4) * MROWS * 2048 + (yrow0 + row) * 2048 + (hv & 15) * 128 + 16 * wave + m - odd) = word;
        }
    }
}
#define SCAN_BAR() do { asm volatile("s_waitcnt vmcnt(0) lgkmcnt(0)" ::: "memory"); __builtin_amdgcn_s_barrier(); asm volatile("" ::: "memory"); } while (0)
__device__ __forceinline__ void scan_prompt_unit(const Args& a, LAS unsigned char* lds, int unit) {
    const int tid = threadIdx.x; int lane = tid & 63; asm volatile("" : "+v"(lane)); const int wave = __builtin_amdgcn_readfirstlane(tid >> 6), m = lane & 15, g = lane >> 4;
    const int hv = unit & 31, b = unit >> 5;
    const bf16* Z = (const bf16*)(a.ws + WS_Z);
    LAS float* ssq = (LAS float*)(lds + SC_SSQ);
    f32x4 S[8];
#pragma unroll
    for (int d = 0; d < 8; ++d) S[d] = (f32x4){0.f, 0.f, 0.f, 0.f};
    const bf16* QN = (const bf16*)(a.ws + WS_QNP) + (size_t)(b * HQK + (hv >> 1)) * LP * 128; const bf16* KN = (const bf16*)(a.ws + WS_KNP) + (size_t)(b * HQK + (hv >> 1)) * LP * 128;
    scan_stage_dma(a, unit * 32, QN, KN, lds, wave, lane);
    scan_stage_dma(a, unit * 32 + 1, QN + (size_t)64 * 128, KN + (size_t)64 * 128, lds + SC_BUF_BYTES, wave, lane);
    const bf16* VTw = (const bf16*)(a.ws + WS_VTP) + ((size_t)unit * 128 + 16 * wave + m) * LP + 4 * g;
    v4u vbn[2];
#pragma unroll
    for (int s2 = 0; s2 < 2; ++s2) { const v2u p0 = *(const v2u*)(VTw + 32 * s2), p1 = *(const v2u*)(VTw + 32 * s2 + 16); vbn[s2] = (v4u){p0.x, p0.y, p1.x, p1.y}; }
    SCAN_BAR();
#pragma unroll 1
    for (int c = 0; c < 32; ++c) {
        const int id = unit * 32 + c;
        unsigned zq[8];
        const size_t yrow0 = (size_t)b * LP + 64 * c;
#pragma unroll
        for (int it = 0; it < 4; ++it)
#pragma unroll
            for (int e2 = 0; e2 < 2; ++e2) zq[it * 2 + e2] = *(const unsigned*)(Z + (yrow0 + 16 * it + 4 * g + 2 * e2 + (lane & 1)) * 4096 + hv * 128 + 16 * wave + m - (lane & 1));
        f32x4 O[4];
        scan_chunk(lds + (c & 1) * SC_BUF_BYTES, S, vbn, O, lane);
        if (c + 1 < 32) {
#pragma unroll
            for (int s2 = 0; s2 < 2; ++s2) { const v2u p0 = __builtin_nontemporal_load((const v2u*)(VTw + 64 * (c + 1) + 32 * s2)), p1 = __builtin_nontemporal_load((const v2u*)(VTw + 64 * (c + 1) + 32 * s2 + 16)); vbn[s2] = (v4u){p0.x, p0.y, p1.x, p1.y}; }
        }
        scan_norm_partial(ssq + (c & 1) * 512, O, wave, lane);
        SCAN_BAR();
        scan_norm_finish(a, ssq + (c & 1) * 512, O, zq, hv, yrow0, 64, wave, lane);
        if (c + 2 < 32) { int l2 = lane; asm volatile("" : "+v"(l2)); scan_stage_dma(a, id + 2, QN + (size_t)(64 * (c + 2)) * 128, KN + (size_t)(64 * (c + 2)) * 128, lds + (c & 1) * SC_BUF_BYTES, wave, l2); }
    }
    float* so = a.out + O_GP + (size_t)unit * DK * DV + 16 * wave + m;
#pragma unroll
    for (int d = 0; d < 8; ++d)
#pragma unroll
        for (int e = 0; e < 4; ++e) so[(size_t)sigma_dk(d, 4 * g + e) * DV] = S[d][e];
    SCAN_BAR();
}
__device__ __forceinline__ void scan_sample_unit(const Args& a, LAS unsigned char* lds, int unit) {
    const int tid = threadIdx.x; int lane = tid & 63; asm volatile("" : "+v"(lane)); const int wave = __builtin_amdgcn_readfirstlane(tid >> 6), m = lane & 15, g = lane >> 4;
    const int hv = unit & 31, b = unit >> 5, id = NITEM_P + unit;
    const bf16* Z = (const bf16*)(a.ws + WS_Z);
    LAS float* ssq = (LAS float*)(lds + SC_SSQ);
    scan_stage_dma(a, id, (const bf16*)(a.ws + WS_QNS) + (size_t)(b * HQK + (hv >> 1)) * 64 * 128, (const bf16*)(a.ws + WS_KNS) + (size_t)(b * HQK + (hv >> 1)) * 64 * 128, lds, wave, lane);
    f32x4 S[8];
    const float* s0 = a.state_gdn + (size_t)unit * DK * DV + 16 * wave + m;
#pragma unroll
    for (int d = 0; d < 8; ++d)
#pragma unroll
        for (int e = 0; e < 4; ++e) S[d][e] = s0[(size_t)sigma_dk(d, 4 * g + e) * DV];
    v4u vb[2];
    { const bf16* VTw = (const bf16*)(a.ws + WS_VTS) + ((size_t)unit * 128 + 16 * wave + m) * 64 + 4 * g;
#pragma unroll
      for (int s2 = 0; s2 < 2; ++s2) { const v2u p0 = *(const v2u*)(VTw + 32 * s2), p1 = *(const v2u*)(VTw + 32 * s2 + 16); vb[s2] = (v4u){p0.x, p0.y, p1.x, p1.y}; } }
    unsigned zq[8];
    const size_t yrow0 = (size_t)MP + b * LS;
#pragma unroll
    for (int e = 0; e < 8; ++e) zq[e] = 0u;
    if (g < 2) {
#pragma unroll
        for (int e2 = 0; e2 < 2; ++e2) zq[e2] = *(const unsigned*)(Z + (yrow0 + 4 * g + 2 * e2 + (lane & 1)) * 4096 + hv * 128 + 16 * wave + m - (lane & 1));
    }
    SCAN_BAR();
    f32x4 O[4];
    scan_chunk(lds, S, vb, O, lane);
    scan_norm_partial(ssq, O, wave, lane);
    SCAN_BAR();
    scan_norm_finish(a, ssq, O, zq, hv, yrow0, LS, wave, lane);
    float* so = a.out + O_GS + (size_t)unit * DK * DV + 16 * wave + m;
#pragma unroll
    for (int d = 0; d < 8; ++d)
#pragma unroll
        for (int e = 0; e < 4; ++e) so[(size_t)sigma_dk(d, 4 * g + e) * DV] = S[d][e];
    __syncthreads();
}

constexpr float IDX_SCALE = 0.08838834764831845f * 0.25f;
__device__ __forceinline__ void idx_reduce4(const f32x4 (&acc)[4], const f32x4 (&wv)[4], float (&v)[4]) {
#pragma unroll
    for (int qq = 0; qq < 4; ++qq) v[qq] = fmaxf(acc[qq][0], 0.f) * wv[qq][0] + fmaxf(acc[qq][1], 0.f) * wv[qq][1] + fmaxf(acc[qq][2], 0.f) * wv[qq][2] + fmaxf(acc[qq][3], 0.f) * wv[qq][3];
    float t[4];
#pragma unroll
    for (int qq = 0; qq < 4; ++qq) t[qq] = __shfl_xor(v[qq], 16);
#pragma unroll
    for (int qq = 0; qq < 4; ++qq) v[qq] += t[qq];
#pragma unroll
    for (int qq = 0; qq < 4; ++qq) t[qq] = __shfl_xor(v[qq], 32);
#pragma unroll
    for (int qq = 0; qq < 4; ++qq) v[qq] = (v[qq] + t[qq]) * IDX_SCALE;
}
__device__ __forceinline__ void idx_prompt_item(const Args& a, LAS unsigned char* wl, int b, int j, int hf, int lane) {
    const bf16* IQ = (const bf16*)(a.ws + WS_IQ); const bf16* IK = (const bf16*)(a.ws + WS_IK); const float* IW = (const float*)(a.ws + WS_IW); _Float16* SC = (_Float16*)(a.ws + WS_SC);
    const int m = lane & 15, g = lane >> 4, rq = b * LP + 4 * j;
    bf16x8 afr[4][4]; f32x4 wv[4];
#pragma unroll
    for (int qq = 0; qq < 4; ++qq) {
#pragma unroll
        for (int s = 0; s < 4; ++s) afr[qq][s] = *(const bf16x8*)(IQ + (size_t)(rq + qq) * 2048 + m * 128 + 32 * s + 8 * g);
        wv[qq] = *(const f32x4*)(IW + (size_t)(rq + qq) * 16 + 4 * g);
    }
    const int nkt = (4 * j + 3) / 16 + 1, k0 = hf ? nkt / 2 : 0, k1 = hf ? nkt : nkt / 2;
    if (k0 >= k1) return;
    const bf16* kb = IK + (size_t)(b * LP + g) * 128 + 8 * m;
    const int g0 = k0 >> 2, g1 = (k1 - 1) >> 2;
    v4u stg[16];
#pragma unroll
    for (int i = 0; i < 16; ++i) stg[i] = *(const v4u*)(kb + (size_t)(64 * g0 + 4 * i) * 128);
#pragma unroll 1
    for (int gi = g0; gi <= g1; ++gi) {
#pragma unroll
        for (int i = 0; i < 16; ++i) *(LAS v4u*)(wl + off_b(4 * i + g, m)) = stg[i];
        const int gn = gi < g1 ? gi + 1 : gi;
#pragma unroll
        for (int i = 0; i < 16; ++i) stg[i] = *(const v4u*)(kb + (size_t)(64 * gn + 4 * i) * 128);
#pragma unroll
        for (int u = 0; u < 4; ++u) {
            const int kt = 4 * gi + u;
            if (kt >= k0 && kt < k1) {
                f32x4 acc[4]; float v[4];
                bf16x8 bf[4];
#pragma unroll
                for (int s = 0; s < 4; ++s) bf[s] = *(const LAS bf16x8*)(wl + off_b(16 * u + m, 4 * s + g));
#pragma unroll
                for (int qq = 0; qq < 4; ++qq) { acc[qq] = (f32x4){0.f, 0.f, 0.f, 0.f};
#pragma unroll
                    for (int s = 0; s < 4; ++s) acc[qq] = __builtin_amdgcn_mfma_f32_16x16x32_bf16(afr[qq][s], bf[s], acc[qq], 0, 0, 0); }
                idx_reduce4(acc, wv, v);
                const int key = 16 * kt + m;
#pragma unroll
                for (int qq = 0; qq < 4; ++qq) { if (key > 4 * j + qq) v[qq] = -__builtin_inff(); if (g == 0) SC[(size_t)(rq + qq) * 2048 + key] = (_Float16)v[qq]; }
            }
        }
    }
}
__device__ __forceinline__ void idx_sample_item(const Args& a, int b, int p, int lane) {
    const bf16* IQ = (const bf16*)(a.ws + WS_IQ); const bf16* IK = (const bf16*)(a.ws + WS_IK); const float* IW = (const float*)(a.ws + WS_IW); float* SCS = (float*)(a.ws + WS_SCS);
    const int m = lane & 15, g = lane >> 4;
    if (p < NPAGES) {
        const float* kr = a.cache_kidx + (size_t)a.page_table[b * NPAGES + p] * PAGE * 128 + (size_t)m * 128 + 8 * g;
#pragma unroll 1
        for (int qh = 0; qh < 2; ++qh) {
            const int rq = MP + b * LS + qh * 4;
            bf16x8 afr[4][4]; f32x4 wv[4];
#pragma unroll
            for (int qq = 0; qq < 4; ++qq) {
#pragma unroll
                for (int s = 0; s < 4; ++s) afr[qq][s] = *(const bf16x8*)(IQ + (size_t)(rq + qq) * 2048 + m * 128 + 32 * s + 8 * g);
                wv[qq] = *(const f32x4*)(IW + (size_t)(rq + qq) * 16 + 4 * g);
            }
            f32x4 fc[8], fn[8];
#pragma unroll
            for (int s = 0; s < 4; ++s) { fc[2 * s] = *(const f32x4*)(kr + 32 * s); fc[2 * s + 1] = *(const f32x4*)(kr + 32 * s + 4); }
#pragma unroll 1
            for (int kt = 0; kt < 8; ++kt) {
                const int ktn = kt + 1 < 8 ? kt + 1 : kt;
#pragma unroll
                for (int s = 0; s < 4; ++s) { fn[2 * s] = *(const f32x4*)(kr + (size_t)(16 * ktn) * 128 + 32 * s); fn[2 * s + 1] = *(const f32x4*)(kr + (size_t)(16 * ktn) * 128 + 32 * s + 4); }
                bf16x8 bfr[4];
#pragma unroll
                for (int s = 0; s < 4; ++s) { v4u w; w.x = pk2(fc[2 * s][0], fc[2 * s][1]); w.y = pk2(fc[2 * s][2], fc[2 * s][3]); w.z = pk2(fc[2 * s + 1][0], fc[2 * s + 1][1]); w.w = pk2(fc[2 * s + 1][2], fc[2 * s + 1][3]); bfr[s] = __builtin_bit_cast(bf16x8, w); }
                f32x4 acc[4]; float v[4];
#pragma unroll
                for (int qq = 0; qq < 4; ++qq) { acc[qq] = (f32x4){0.f, 0.f, 0.f, 0.f};
#pragma unroll
                    for (int s = 0; s < 4; ++s) acc[qq] = __builtin_amdgcn_mfma_f32_16x16x32_bf16(afr[qq][s], bfr[s], acc[qq], 0, 0, 0); }
                idx_reduce4(acc, wv, v);
#pragma unroll
                for (int qq = 0; qq < 4; ++qq) if (g == 0) SCS[(size_t)(b * LS + qh * 4 + qq) * SCS_LD + p * PAGE + 16 * kt + m] = v[qq];
#pragma unroll
                for (int s = 0; s < 8; ++s) fc[s] = fn[s];
            }
        }
    } else {
        const int jr = m < LS ? m : LS - 1;
        bf16x8 bfr[4];
#pragma unroll
        for (int s = 0; s < 4; ++s) bfr[s] = *(const bf16x8*)(IK + (size_t)(MP + b * LS + jr) * 128 + 32 * s + 8 * g);
#pragma unroll 1
        for (int qh = 0; qh < 2; ++qh) {
            const int rq = MP + b * LS + qh * 4;
            f32x4 acc[4], wv[4]; float v[4];
#pragma unroll
            for (int qq = 0; qq < 4; ++qq) { acc[qq] = (f32x4){0.f, 0.f, 0.f, 0.f}; wv[qq] = *(const f32x4*)(IW + (size_t)(rq + qq) * 16 + 4 * g);
#pragma unroll
                for (int s = 0; s < 4; ++s) acc[qq] = __builtin_amdgcn_mfma_f32_16x16x32_bf16(*(const bf16x8*)(IQ + (size_t)(rq + qq) * 2048 + m * 128 + 32 * s + 8 * g), bfr[s], acc[qq], 0, 0, 0); }
            idx_reduce4(acc, wv, v);
#pragma unroll
            for (int qq = 0; qq < 4; ++qq) { if (m > qh * 4 + qq) v[qq] = -__builtin_inff(); if (g == 0 && m < LS) SCS[(size_t)(b * LS + qh * 4 + qq) * SCS_LD + PAST + m] = v[qq]; }
        }
    }
}

template <int NPL> __device__ __forceinline__ void topk_query(const float* sc, int n, int* sel, int* cnt, int lane) {
    if (n <= NTOPK) {
#pragma unroll
        for (int j = 0; j < NTOPK / 64; ++j) { const int i = j * 64 + lane; sel[i] = i < n ? i : 0; }
        if (lane == 0) *cnt = n;
        return;
    }
    unsigned key[NPL];
#pragma unroll
    for (int i = 0; i < NPL; ++i) { const int idx = i * 64 + lane; unsigned k = 0u;
        { const unsigned uu = __float_as_uint(sc[idx < n ? idx : n - 1]); if (idx < n) k = (uu & 0x80000000u) ? ~uu : (uu | 0x80000000u); }
        key[i] = k; }
    unsigned tau = 0u;
    for (int bit = 31; bit >= 0; --bit) {
        const unsigned tr = tau | (1u << bit); int c = 0;
#pragma unroll
        for (int i = 0; i < NPL; ++i) c += __popcll(__ballot(key[i] >= tr));
        if (c >= NTOPK) tau = tr;
        if (c == NTOPK) break;
    }
    int base = 0;
#pragma unroll
    for (int i = 0; i < NPL; ++i) {
        const bool f = key[i] >= tau;
        const unsigned long long bal = __ballot(f);
        const int pos = base + __popcll(bal & ((1ull << lane) - 1ull));
        if (f && pos < NTOPK) sel[pos] = i * 64 + lane;
        base += __popcll(bal);
    }
    if (lane == 0) *cnt = base < NTOPK ? base : NTOPK;
}

__device__ __forceinline__ void topk_query16(const _Float16* sc, int n, int* sel, int* cnt, int lane) {
    if (n <= NTOPK) {
#pragma unroll
        for (int j = 0; j < NTOPK / 64; ++j) { const int i = j * 64 + lane; sel[i] = i < n ? i : 0; }
        if (lane == 0) *cnt = n;
        return;
    }
    unsigned key[32];
#pragma unroll
    for (int i = 0; i < 4; ++i) {
        const int base = (i * 64 + lane) * 8;
        const v4u w = *(const v4u*)(sc + base);
        const unsigned ww[4] = {w.x, w.y, w.z, w.w};
#pragma unroll
        for (int e = 0; e < 8; ++e) { const unsigned uu = (e & 1) ? (ww[e >> 1] >> 16) : (ww[e >> 1] & 0xffffu); const unsigned k = (uu & 0x8000u) ? (~uu & 0xffffu) : (uu | 0x8000u); key[i * 8 + e] = (base + e < n) ? k : 0u; }
    }
    unsigned tau = 0u;
    for (int bit = 15; bit >= 0; --bit) {
        const unsigned tr = tau | (1u << bit); int c = 0;
#pragma unroll
        for (int i = 0; i < 32; ++i) c += __popcll(__ballot(key[i] >= tr));
        if (c >= NTOPK) tau = tr;
        if (c == NTOPK) break;
    }
    int base = 0;
#pragma unroll
    for (int i = 0; i < 32; ++i) {
        const bool f = key[i] >= tau;
        const unsigned long long bal = __ballot(f);
        const int pos = base + __popcll(bal & ((1ull << lane) - 1ull));
        if (f && pos < NTOPK) sel[pos] = ((i >> 3) * 64 + lane) * 8 + (i & 7);
        base += __popcll(bal);
    }
    if (lane == 0) *cnt = base < NTOPK ? base : NTOPK;
}
__device__ __forceinline__ void topk_block(const float* sc, int n, int* sel, int* cnt, LAS int* sl) {
    constexpr int NPT = 17;
    const int tid = threadIdx.x, lane = tid & 63, wave = tid >> 6;
    unsigned key[NPT];
#pragma unroll
    for (int i = 0; i < NPT; ++i) { const int idx = i * NTHREADS + tid; unsigned k = 0u;
        { const unsigned uu = __float_as_uint(sc[idx < n ? idx : n - 1]); if (idx < n) k = (uu & 0x80000000u) ? ~uu : (uu | 0x80000000u); }
        key[i] = k; }
    unsigned tau = 0u;
    for (int bit = 31; bit >= 0; --bit) {
        const unsigned tr = tau | (1u << bit); int c = 0;
#pragma unroll
        for (int i = 0; i < NPT; ++i) c += __popcll(__ballot(key[i] >= tr));
        LAS int* pb = sl + (bit & 1) * 8;
        if (lane == 0) pb[wave] = c;
        __syncthreads();
        int tot = 0;
#pragma unroll
        for (int w = 0; w < NWAVES; ++w) tot += pb[w];
        if (tot >= NTOPK) tau = tr;
        if (tot == NTOPK) break;
    }
    LAS int* wc = sl + 16;
    unsigned long long bal[NPT];
#pragma unroll
    for (int i = 0; i < NPT; ++i) { bal[i] = __ballot(key[i] >= tau); if (lane == 0) wc[i * 8 + wave] = __popcll(bal[i]); }
    __syncthreads();
    int base = 0;
#pragma unroll
    for (int i = 0; i < NPT; ++i) {
        int mybase = base;
#pragma unroll
        for (int w = 0; w < NWAVES; ++w) { const int v = wc[i * 8 + w]; if (w < wave) mybase += v; base += v; }
        const int pos = mybase + __popcll(bal[i] & ((1ull << lane) - 1ull));
        if ((key[i] >= tau) && pos < NTOPK) sel[pos] = i * NTHREADS + tid;
    }
    if (tid == 0) *cnt = base < NTOPK ? base : NTOPK;
    __syncthreads();
}

__device__ __forceinline__ const float* kv_row(const Args& a, bool isv, bool sample, int b, int key, int kvh) {
    if (!sample) return a.out + (isv ? O_VP : O_KP) + ((size_t)(b * LP + key) * 2 + kvh) * 128;
    if (key < PAST) { const int phys = a.page_table[b * NPAGES + (key >> 7)]; return (isv ? a.cache_v : a.cache_k) + (((size_t)phys * PAGE + (key & 127)) * 2 + kvh) * 128; }
    return a.out + (isv ? O_VS : O_KS) + ((size_t)(b * LS + (key - PAST)) * 2 + kvh) * 128;
}
constexpr int ATT_WAVE_BYTES = 17408;
template <bool SAMPLE> __device__ __forceinline__ void attn_query(const Args& a, LAS unsigned char* wl, int row, int lane) {
    const bf16* BQ = (const bf16*)(a.ws + WS_BQ); const bf16* BZ = (const bf16*)(a.ws + WS_BZ); bf16* YB = (bf16*)(a.ws + WS_YB);
    const int* sel = (const int*)(a.ws + WS_SEL) + (size_t)row * NTOPK; const int cnt = ((const int*)(a.ws + WS_CNT))[row];
    const int b = SAMPLE ? (row - MP) >> 3 : row >> 11;
    const int m = lane & 15, g = lane >> 4;
    LAS unsigned char* Kb = wl; LAS unsigned char* Vb = wl + 8192; LAS int* SL = (LAS int*)(wl + 16384);
    { v4u sv = *(const v4u*)(sel + 4 * lane); if constexpr (!SAMPLE) { sv.x <<= 10; sv.y <<= 10; sv.z <<= 10; sv.w <<= 10; } *(LAS v4u*)(SL + 4 * lane) = sv; }
    const int ntile = (cnt + 31) >> 5;
#pragma unroll 1
    for (int kvh = 0; kvh < 2; ++kvh) {
        bf16x8 qf[4];
#pragma unroll
        for (int s = 0; s < 4; ++s) { const bf16x8 ql = *(const bf16x8*)(BQ + (size_t)row * 2048 + (kvh * 8 + (m & 7)) * 128 + 32 * s + 8 * g); qf[s] = m < 8 ? ql : (bf16x8){0, 0, 0, 0, 0, 0, 0, 0}; }
        f32x4 o[8];
#pragma unroll
        for (int cc = 0; cc < 8; ++cc) o[cc] = (f32x4){0.f, 0.f, 0.f, 0.f};
        float mrun = -__builtin_inff(), lrun = 0.f;
        v4u pw_[8], px_[8];
        const unsigned char* kvbase = a.ws + WS_BKV + (size_t)b * LP * 1024 + kvh * 256 + 16 * m;
        if constexpr (!SAMPLE) {
#pragma unroll
            for (int i = 0; i < 8; ++i) { int slot = 4 * i + g; slot = slot < cnt ? slot : cnt - 1;
                const unsigned char* src = kvbase + (unsigned)SL[slot];
                pw_[i] = *(const v4u*)src; px_[i] = *(const v4u*)(src + 512); }
        }
#pragma unroll 1
        for (int T = 0; T < ntile; ++T) {
            if constexpr (!SAMPLE) {
#pragma unroll
                for (int i = 0; i < 8; ++i) { const int kap = 4 * i + g, nu = 8 * ((kap >> 2) & 3) + 4 * (kap >> 4) + (kap & 3);
                    *(LAS v4u*)(Kb + off_b(kap, m)) = pw_[i]; *(LAS v4u*)(Vb + off_b(nu, m)) = px_[i]; }
                if (T + 1 < ntile) {
#pragma unroll
                    for (int i = 0; i < 8; ++i) { int slot = 32 * (T + 1) + 4 * i + g; slot = slot < cnt ? slot : cnt - 1;
                        const unsigned char* src = kvbase + (unsigned)SL[slot];
                        pw_[i] = *(const v4u*)src; px_[i] = *(const v4u*)(src + 512); }
                }
            } else {
#pragma unroll
                for (int hb = 0; hb < 2; ++hb) {
                    int key[4], phys[4];
#pragma unroll
                    for (int i = 0; i < 4; ++i) { int slot = 32 * T + 4 * (4 * hb + i) + g; slot = slot < cnt ? slot : cnt - 1; key[i] = SL[slot]; }
#pragma unroll
                    for (int i = 0; i < 4; ++i) { const int pg = key[i] >> 7; phys[i] = a.page_table[b * NPAGES + (pg < NPAGES ? pg : NPAGES - 1)]; }
                    f32x4 f[4][4];
#pragma unroll
                    for (int i = 0; i < 4; ++i) {
                        const bool past = key[i] < PAST; const int jn = past ? 0 : key[i] - PAST;
                        const size_t oc = (((size_t)phys[i] * PAGE + (key[i] & 127)) * 2 + kvh) * 128 + 8 * m, on = ((size_t)(b * LS + jn) * 2 + kvh) * 128 + 8 * m;
                        const float* ks = past ? a.cache_k + oc : a.out + O_KS + on; const float* vs = past ? a.cache_v + oc : a.out + O_VS + on;
                        f[i][0] = __builtin_nontemporal_load((const f32x4*)ks); f[i][1] = __builtin_nontemporal_load((const f32x4*)(ks + 4)); f[i][2] = __builtin_nontemporal_load((const f32x4*)vs); f[i][3] = __builtin_nontemporal_load((const f32x4*)(vs + 4));
                    }
#pragma unroll
                    for (int i = 0; i < 4; ++i) { const int kap = 4 * (4 * hb + i) + g, nu = 8 * ((kap >> 2) & 3) + 4 * (kap >> 4) + (kap & 3);
                        v4u w, x; w.x = pk2(f[i][0][0], f[i][0][1]); w.y = pk2(f[i][0][2], f[i][0][3]); w.z = pk2(f[i][1][0], f[i][1][1]); w.w = pk2(f[i][1][2], f[i][1][3]);
                        x.x = pk2(f[i][2][0], f[i][2][1]); x.y = pk2(f[i][2][2], f[i][2][3]); x.z = pk2(f[i][3][0], f[i][3][1]); x.w = pk2(f[i][3][2], f[i][3][3]);
                        *(LAS v4u*)(Kb + off_b(kap, m)) = w; *(LAS v4u*)(Vb + off_b(nu, m)) = x; }
                }
            }
            f32x4 c[2];
#pragma unroll
            for (int rb = 0; rb < 2; ++rb) {
                f32x4 acc = {0.f, 0.f, 0.f, 0.f};
#pragma unroll
                for (int s = 0; s < 4; ++s) { const bf16x8 kf = *(const LAS bf16x8*)(Kb + off_b(m + 16 * rb, 4 * s + g)); acc = __builtin_amdgcn_mfma_f32_16x16x32_bf16(kf, qf[s], acc, 0, 0, 0); }
                c[rb] = acc;
            }
#pragma unroll
            for (int rb = 0; rb < 2; ++rb)
#pragma unroll
                for (int i = 0; i < 4; ++i) { const int slot = 32 * T + 16 * rb + 4 * g + i; if (slot >= cnt) c[rb][i] = -__builtin_inff(); }
            if (T == 0) {
                float tm = fmaxf(fmaxf(fmaxf(c[0][0], c[0][1]), fmaxf(c[0][2], c[0][3])), fmaxf(fmaxf(c[1][0], c[1][1]), fmaxf(c[1][2], c[1][3])));
                tm = fmaxf(tm, __shfl_xor(tm, 16)); tm = fmaxf(tm, __shfl_xor(tm, 32));
                mrun = tm;
            }
            float ps = 0.f;
#pragma unroll
            for (int rb = 0; rb < 2; ++rb)
#pragma unroll
                for (int i = 0; i < 4; ++i) { const float pe = __expf(fminf(c[rb][i] - mrun, 80.0f)); c[rb][i] = pe; ps += pe; }
            lrun += ps;
            v4u pw; pw.x = pk2(c[0][0], c[0][1]); pw.y = pk2(c[0][2], c[0][3]); pw.z = pk2(c[1][0], c[1][1]); pw.w = pk2(c[1][2], c[1][3]);
            const bf16x8 pa = __builtin_bit_cast(bf16x8, pw);
#pragma unroll
            for (int cc = 0; cc < 8; ++cc) {
                const s16x4 v0 = vtr(Vb + tr_read_addr_16(lane, cc, 0)), v1 = vtr(Vb + tr_read_addr_16(lane, cc, 1));
                const bf16x8 vf = (bf16x8){v0[0], v0[1], v0[2], v0[3], v1[0], v1[1], v1[2], v1[3]};
                o[cc] = __builtin_amdgcn_mfma_f32_16x16x32_bf16(pa, vf, o[cc], 0, 0, 0);
            }
        }
        float l = lrun; l += __shfl_xor(l, 16); l += __shfl_xor(l, 32);
        float linv[4];
#pragma unroll
        for (int i = 0; i < 4; ++i) linv[i] = 1.0f / __shfl(l, (4 * g + i) & 15);
        {
            const int gg = g & 1;
            bf16 zz[4][8];
#pragma unroll
            for (int i = 0; i < 4; ++i)
#pragma unroll
                for (int cc = 0; cc < 8; ++cc) zz[i][cc] = BZ[(size_t)row * 2048 + (kvh * 8 + 4 * gg + i) * 128 + m + 16 * cc];
            if (g < 2) {
#pragma unroll
                for (int i = 0; i < 4; ++i) { const size_t ro = (size_t)row * 2048 + (kvh * 8 + 4 * g + i) * 128 + m;
#pragma unroll
                    for (int cc = 0; cc < 8; ++cc) YB[ro + 16 * cc] = f2bf(o[cc][i] * linv[i] * bf2f(zz[i][cc])); }
            }
        }
    }
}

template <int KSTEPS> __device__ __forceinline__ void sgemm_32x64(const bf16* A, const bf16* Bt, int K, int k0, int lane, f32x4 (&acc)[2][4]) {
    const bf16* ap = A + (size_t)(lane & 15) * K + k0 + 8 * (lane >> 4); const bf16* bp = Bt + (size_t)(lane & 15) * K + k0 + 8 * (lane >> 4);
#pragma unroll 1
    for (int kk = 0; kk < KSTEPS; kk += 4) {
        bf16x8 af[4][2], bfv[4][4];
#pragma unroll
        for (int s2 = 0; s2 < 4; ++s2) {
#pragma unroll
            for (int ri = 0; ri < 2; ++ri) af[s2][ri] = *(const bf16x8*)(ap + (size_t)(16 * ri) * K + 32 * (kk + s2));
#pragma unroll
            for (int ci = 0; ci < 4; ++ci) bfv[s2][ci] = *(const bf16x8*)(bp + (size_t)(16 * ci) * K + 32 * (kk + s2));
        }
#pragma unroll
        for (int s2 = 0; s2 < 4; ++s2)
#pragma unroll
            for (int ri = 0; ri < 2; ++ri)
#pragma unroll
                for (int ci = 0; ci < 4; ++ci) acc[ri][ci] = __builtin_amdgcn_mfma_f32_16x16x32_bf16(af[s2][ri], bfv[s2][ci], acc[ri][ci], 0, 0, 0);
    }
}
__device__ __forceinline__ void sample_merge_block(const Args& a, LAS unsigned char* lds, int bt) {
    const int tid = threadIdx.x, lane = tid & 63, wave = tid >> 6, m = lane & 15, g = lane >> 4;
    const int rt = bt >> 5, ct = bt & 31, r0 = MP + 32 * rt, c0 = 64 * ct;
    f32x4 a1[2][4], a2[2][4];
#pragma unroll
    for (int ri = 0; ri < 2; ++ri)
#pragma unroll
        for (int ci = 0; ci < 4; ++ci) { a1[ri][ci] = (f32x4){0.f, 0.f, 0.f, 0.f}; a2[ri][ci] = (f32x4){0.f, 0.f, 0.f, 0.f}; }
    sgemm_32x64<8>((const bf16*)(a.ws + WS_YA) + (size_t)r0 * D, (const bf16*)(a.ws + WS_WPA) + (size_t)c0 * D, D, 256 * wave, lane, a1);
    sgemm_32x64<8>((const bf16*)(a.ws + WS_YA) + (size_t)MROWS * D + (size_t)r0 * D, (const bf16*)(a.ws + WS_WPA) + (size_t)D * D + (size_t)c0 * D, D, 256 * wave, lane, a1);
    sgemm_32x64<8>((const bf16*)(a.ws + WS_YB) + (size_t)r0 * D, (const bf16*)(a.ws + WS_WPB) + (size_t)c0 * D, D, 256 * wave, lane, a2);
    LAS f32x4* P = (LAS f32x4*)lds;
#pragma unroll
    for (int ri = 0; ri < 2; ++ri)
#pragma unroll
        for (int ci = 0; ci < 4; ++ci) { P[(wave * 16 + ri * 4 + ci) * 64 + lane] = a1[ri][ci]; P[(wave * 16 + 8 + ri * 4 + ci) * 64 + lane] = a2[ri][ci]; }
    __syncthreads();
    f32x4 s1 = {0.f, 0.f, 0.f, 0.f}, s2 = {0.f, 0.f, 0.f, 0.f};
#pragma unroll
    for (int w = 0; w < NWAVES; ++w) { s1 += P[(w * 16 + wave) * 64 + lane]; s2 += P[(w * 16 + 8 + wave) * 64 + lane]; }
    const int ri = wave >> 2, ci = wave & 3;
    const bf16* GA = (const bf16*)(a.ws + WS_GA); const bf16* GB = (const bf16*)(a.ws + WS_GB); bf16* MG = (bf16*)(a.ws + WS_MG);
#pragma unroll
    for (int e = 0; e < 4; ++e) { const size_t o = (size_t)(r0 + 16 * ri + 4 * g + e) * D + c0 + 16 * ci + m; MG[o] = f2bf(bf2f(GA[o]) * s1[e] + bf2f(GB[o]) * s2[e]); }
    __syncthreads();
}
__device__ __forceinline__ void sample_out_block(const Args& a, LAS unsigned char* lds, int bt) {
    const int tid = threadIdx.x, lane = tid & 63, wave = tid >> 6, m = lane & 15, g = lane >> 4;
    const int rt = bt >> 5, ct = bt & 31, r0 = MP + 32 * rt, c0 = 64 * ct;
    f32x4 acc[2][4];
#pragma unroll
    for (int ri = 0; ri < 2; ++ri)
#pragma unroll
        for (int ci = 0; ci < 4; ++ci) acc[ri][ci] = (f32x4){0.f, 0.f, 0.f, 0.f};
    sgemm_32x64<8>((const bf16*)(a.ws + WS_MG) + (size_t)r0 * D, (const bf16*)(a.ws + WS_WOUT) + (size_t)c0 * D, D, 256 * wave, lane, acc);
    LAS f32x4* P = (LAS f32x4*)lds;
#pragma unroll
    for (int ri = 0; ri < 2; ++ri)
#pragma unroll
        for (int ci = 0; ci < 4; ++ci) P[(wave * 8 + ri * 4 + ci) * 64 + lane] = acc[ri][ci];
    __syncthreads();
    f32x4 s1 = {0.f, 0.f, 0.f, 0.f};
#pragma unroll
    for (int w = 0; w < NWAVES; ++w) s1 += P[(w * 8 + wave) * 64 + lane];
    const int ri = wave >> 2, ci = wave & 3;
    bf16* OUTF = (bf16*)(a.ws + WS_OUTF);
#pragma unroll
    for (int e = 0; e < 4; ++e) OUTF[(size_t)(r0 + 16 * ri + 4 * g + e) * D + c0 + 16 * ci + m] = f2bf(s1[e]);
    __syncthreads();
}

__global__ void __launch_bounds__(NTHREADS, 2) fwd(Args a0) {
    extern __shared__ __attribute__((aligned(16))) unsigned char lds_raw[];
    LAS unsigned char* lds = (LAS unsigned char*)lds_raw;
    const int tid = threadIdx.x, lane0 = tid & 63, wave = __builtin_amdgcn_readfirstlane(tid >> 6);
    const int G = gridDim.x, bid = blockIdx.x;
    const int gw = bid * NWAVES + wave, NGW = G * NWAVES;
    unsigned char* ws = a0.ws;
    gu32* ctl = (gu32*)(ws + WS_CTL);
    for (int u = tid; u < (LDS_BYTES - LDSCTL_OFF) / 4; u += NTHREADS) ((LAS unsigned*)(lds + LDSCTL_OFF))[u] = 0u;
    __syncthreads();
    volatile LAS unsigned* MISC = (volatile LAS unsigned*)(lds + MISC_OFF);
#if MK_ONE_LAUNCH
    XcdBarrier bar = xcd_barrier_post((unsigned*)ctl + CW_BAR, MISC + 8);
#define GRID_BAR() xcd_barrier(bar)
#else
    (void)MISC; (void)ctl;
#define GRID_BAR() do {} while (0)
#endif
    const int lo = a0.ph_lo, hi = a0.ph_hi;
#ifndef PH_MASK
#define PH_MASK 0x1ff
#endif
#define IN(k) (((PH_MASK >> (k)) & 1) && lo <= (k) && (k) < hi)
#define BOTH(k) (IN(k) && IN((k) + 1))
#ifndef REP_MASK
#define REP_MASK 0
#endif
#define NREP(k) (1 + ((REP_MASK >> (k)) & 1))
    float* MOD = (float*)(ws + WS_MOD);
    bf16* WIN = (bf16*)(ws + WS_WIN); bf16* WPA = (bf16*)(ws + WS_WPA); bf16* WPB = (bf16*)(ws + WS_WPB); bf16* WOUT = (bf16*)(ws + WS_WOUT);
    bf16* H = (bf16*)(ws + WS_H);

    if (IN(0)) {
        int ln = lane0; asm volatile("" : "+v"(ln)); const Args a = load_args(lo, hi);
        LAS float* scr = (LAS float*)(lds + wave * 16384);
        constexpr int I_IN = (D / 64) * (NPAD / 32), I_MOD = 32 * 96;
        {
            constexpr int nblk = NPAD / 32;
            LAS unsigned* lctr = (LAS unsigned*)(lds + 8 * 16384);
            if (threadIdx.x == 0) *lctr = 0u;
            __syncthreads();
            for (int r = bid + G * wave; r < I_MOD; r += G * NWAVES) mod_item(a, MOD, r, scr, ln);
            constexpr int NPAIR = I_IN / 2;
            float v0[32], v1[32];
            unsigned q = 0; if (ln == 0) q = __hip_atomic_fetch_add(lctr, 1u, __ATOMIC_RELAXED, __HIP_MEMORY_SCOPE_WORKGROUP);
            int pa = (int)__builtin_amdgcn_readfirstlane(q) * G + bid;
            { const int t = 2 * (pa < NPAIR ? pa : NPAIR - 1); win_tr_load(a.w_in, 32 * (t % nblk), 64 * (t / nblk), v0, ln); win_tr_load(a.w_in, 32 * ((t + 1) % nblk), 64 * ((t + 1) / nblk), v1, ln); }
            while (pa < NPAIR) {
                const int ia = 2 * pa;
                win_tr_store(v0, WIN, 32 * (ia % nblk), 64 * (ia / nblk), scr, ln);
                q = 0; if (ln == 0) q = __hip_atomic_fetch_add(lctr, 1u, __ATOMIC_RELAXED, __HIP_MEMORY_SCOPE_WORKGROUP);
                const int pn = (int)__builtin_amdgcn_readfirstlane(q) * G + bid;
                const int tn = 2 * (pn < NPAIR ? pn : NPAIR - 1);
                win_tr_load(a.w_in, 32 * (tn % nblk), 64 * (tn / nblk), v0, ln);
                win_tr_store(v1, WIN, 32 * ((ia + 1) % nblk), 64 * ((ia + 1) / nblk), scr, ln);
                win_tr_load(a.w_in, 32 * ((tn + 1) % nblk), 64 * ((tn + 1) / nblk), v1, ln);
                pa = pn;
            }
        }
        if (BOTH(0)) GRID_BAR();
    }
    if (IN(1)) for (int rep = 0; rep < NREP(1); ++rep) {
        int ln = lane0; asm volatile("" : "+v"(ln)); const Args a = load_args(lo, hi);
        for (int mrow = gw; mrow < MROWS; mrow += NGW) {
            const float* xr = mrow < MP ? a.x_p + (size_t)mrow * D : a.x_s + (size_t)(mrow - MP) * D;
            const int bi = mrow < MP ? (mrow >> 11) : 4 + ((mrow - MP) >> 3);
            const float* md = MOD + bi * 6144;
            f32x4 v[8], ms[8], mb[8]; float s = 0.f;
#pragma unroll
            for (int j = 0; j < 8; ++j) v[j] = __builtin_nontemporal_load((const f32x4*)xr + ln + 64 * j);
#pragma unroll
            for (int j = 0; j < 8; ++j) { const int col = 4 * (ln + 64 * j);
                ms[j] = *(const f32x4*)(a.pre_g + col) * (*(const f32x4*)(md + 2048 + col) + *(const f32x4*)(a.b_ada + 2048 + col) + 1.0f); mb[j] = *(const f32x4*)(md + col) + *(const f32x4*)(a.b_ada + col); }
#pragma unroll
            for (int j = 0; j < 8; ++j) s += (v[j][0] * v[j][0] + v[j][1] * v[j][1]) + (v[j][2] * v[j][2] + v[j][3] * v[j][3]);
            const float rstd = rsqrtf(wave_sum(s) * (1.0f / D) + NORM_EPS);
#pragma unroll
            for (int j = 0; j < 8; ++j) { const int col = 4 * (ln + 64 * j);
                const f32x4 hv = v[j] * rstd * ms[j] + mb[j];
                v2u w; w.x = pk2(hv[0], hv[1]); w.y = pk2(hv[2], hv[3]);
                *(v2u*)(H + (size_t)mrow * D + col) = w; }
        }
        if (BOTH(1)) GRID_BAR();
    }
    if (IN(2)) for (int rep = 0; rep < NREP(2); ++rep) {
        int ln = lane0; asm volatile("" : "+v"(ln)); const Args a = load_args(lo, hi);
        pg8::Gemm g{H, WIN, MROWS, NPAD, D}; pg8::StaticOrder S; S.init(MROWS, NPAD, G, bid);
        pg8::EpiIn E{(bf16*)(ws + WS_QKV), (bf16*)(ws + WS_Z), (bf16*)(ws + WS_BQ), (bf16*)(ws + WS_BZ), (bf16*)(ws + WS_IQ), (bf16*)(ws + WS_GA), (bf16*)(ws + WS_GB), (bf16*)(ws + WS_IK),
                     (float*)(ws + WS_BETA), (float*)(ws + WS_GG), (float*)(ws + WS_IW), a.out, a.a_log, a.dt_bias, (bf16*)(ws + WS_BKV)};
        pg8::gemm_phase<pg8::EpiIn, pg8::StaticOrder, true, true>(lds, g, S, E);
        {
            constexpr int I_PA = (4096 / 64) * (D / 32), I_PB = (D / 64) * (D / 32), I_OUT = I_PB, NUN = (MROWS / 256) * (NPAD / 256);
            const int nshort = (NUN % G) ? G - NUN % G : G, first = G - nshort;
            if (bid >= first) {
                LAS float* scr = (LAS float*)(lds + wave * 16384);
                for (int it = (bid - first) * NWAVES + wave; it < I_PA + I_PB + I_OUT; it += nshort * NWAVES) {
                    int r = it; const int nblk = D / 32;
                    if (r < I_PA) { const int kb = r / nblk, hh = kb >> 5; transpose_item(a.w_pa + (size_t)hh * D * D, D, D, WPA + (size_t)hh * D * D, 32 * (r % nblk), 64 * (kb & 31), false, scr, ln); continue; } r -= I_PA;
                    if (r < I_PB) { transpose_item(a.w_pb, D, D, WPB, 32 * (r % nblk), 64 * (r / nblk), false, scr, ln); continue; } r -= I_PB;
                    transpose_item(a.w_out, D, D, WOUT, 32 * (r % nblk), 64 * (r / nblk), false, scr, ln);
                }
            }
        }
        if (BOTH(2)) GRID_BAR();
    }
    if (IN(3)) for (int rep = 0; rep < NREP(3); ++rep) {
        int ln = lane0; asm volatile("" : "+v"(ln)); const Args a = load_args(lo, hi);
#pragma unroll 1
        for (int pass = 0; pass < 2; ++pass) {
            if ((pass == 0) == (wave < 4)) {
                for (int it = gw; it < BP * 32 * 64 + BS * 64; it += NGW) prep_item(a, it, ln);
            } else {
                constexpr int NPI = BP * (LP / 4) * 2, NSI = BS * (NPAGES + 1);
                for (int it = gw; it < NPI + NSI; it += NGW) {
                    if (it < NPI) { int i2 = it < NPI / 2 ? it : (NPI - 1) - (it - NPI / 2); idx_prompt_item(a, lds + wave * 16384, i2 & 3, (LP / 4 - 1) - (i2 >> 3), (i2 >> 2) & 1, ln); }
                    else { const int r = it - NPI; idx_sample_item(a, r / (NPAGES + 1), r % (NPAGES + 1), ln); }
                }
            }
        }
        if (BOTH(3)) GRID_BAR();
    }
    if (IN(4)) for (int rep = 0; rep < NREP(4); ++rep) {
        int ln = lane0; asm volatile("" : "+v"(ln)); const Args a = load_args(lo, hi);
        const int nfull = (NITEM / NGW) * NGW, nrem = NITEM - nfull, rper = (nrem + G - 1) / G;
        for (int k = 0; k <= NITEM / NGW; ++k) {
            int it;
            if (k < NITEM / NGW) it = k * NGW + gw; else { if (wave >= rper) break; it = nfull + bid * rper + wave; if (it >= NITEM) break; }
            int item;
            if (it < NITEM_P) { const int par = it & 1, c = (it >> 1) & 31, hq = (it >> 6) & 15, b = it >> 10; item = (b * HV + 2 * hq + par) * 32 + c; }
            else { const int r = it - NITEM_P, par = r & 1, hq = (r >> 1) & 15, b = r >> 5; item = NITEM_P + b * HV + 2 * hq + par; }
            gdnA_item(a, lds + wave * GA_WAVE_BYTES, item, ln);
        }
        int* SEL = (int*)(ws + WS_SEL); int* CNT = (int*)(ws + WS_CNT);
        for (int r = gw; r < MP; r += NGW) topk_query16((const _Float16*)(ws + WS_SC) + (size_t)r * 2048, (r & (LP - 1)) + 1, SEL + (size_t)r * NTOPK, CNT + r, ln);
        __syncthreads();
        for (int r = MP + bid; r < MROWS; r += G) topk_block((const float*)(ws + WS_SCS) + (size_t)(r - MP) * SCS_LD, PAST + ((r - MP) & 7) + 1, SEL + (size_t)r * NTOPK, CNT + r, (LAS int*)lds);
        if (BOTH(4)) GRID_BAR();
    }
    if (IN(5)) for (int rep = 0; rep < NREP(5); ++rep) {
        const Args a = load_args(lo, hi);
        if (G >= 2 * BP * HV) {
            if (bid < BP * HV) scan_prompt_unit(a, lds, bid);
            else for (int u = bid - BP * HV; u < BS * HV; u += G - BP * HV) scan_sample_unit(a, lds, u);
        } else {
            for (int u = bid; u < BP * HV + BS * HV; u += G) { if (u < BP * HV) scan_prompt_unit(a, lds, u); else scan_sample_unit(a, lds, u - BP * HV); }
        }
        __syncthreads();
        {
            int ln = lane0; asm volatile("" : "+v"(ln));
            const int x = bid & 7;
            gu32* qctr = ctl + CW_ATTQ + 16 * x;
            for (;;) {
                unsigned q = 0; if (ln == 0) q = __hip_atomic_fetch_add(qctr, 1u, __ATOMIC_RELAXED, __HIP_MEMORY_SCOPE_AGENT);
                q = __builtin_amdgcn_readfirstlane(q);
                if (q >= (unsigned)(MS / 8 + MP / 8)) break;
                if (q < (unsigned)(MS / 8)) attn_query<true>(a, lds + wave * ATT_WAVE_BYTES, MP + (MS / 8) * x + (int)q, ln);
                else { const int i = (int)q - MS / 8; attn_query<false>(a, lds + wave * ATT_WAVE_BYTES, (x >> 1) * LP + 2 * (LP / 2 - 1 - i) + (x & 1), ln); }
            }
        }
        if (BOTH(5)) GRID_BAR();
    }
    if (IN(6)) for (int rep = 0; rep < NREP(6); ++rep) {
        int ln = lane0; asm volatile("" : "+v"(ln)); const Args a = load_args(lo, hi);
        for (int t = bid; t < (MS / 32) * (D / 64); t += G) sample_merge_block(a, lds, t);
        static_assert(WS_YB == WS_YA + 2 * (size_t)MROWS * D * 2 && WS_WPB == WS_WPA + 2 * (size_t)D * D * 2, "the chain's three segments are contiguous: y_a lo | y_a hi | y_b and w_pa lo | w_pa hi | w_pb");
        pg8::GemmChain g{(const bf16*)(ws + WS_YA), WPA, (size_t)MROWS * D, (size_t)D * D, MP, D, D}; pg8::ChainOrder S; S.init(MP, D, G, bid);
        pg8::EpiChain E{(const bf16*)(ws + WS_GA), (const bf16*)(ws + WS_GB), (bf16*)(ws + WS_MG)};
        pg8::gemm_chain<pg8::EpiChain, pg8::ChainOrder, true, true>(lds, g, S, E);
        if (BOTH(6)) GRID_BAR();
    }
    if (IN(7)) for (int rep = 0; rep < NREP(7); ++rep) {
        int ln = lane0; asm volatile("" : "+v"(ln)); const Args a = load_args(lo, hi);
        for (int t = bid; t < (MS / 32) * (D / 64); t += G) sample_out_block(a, lds, t);
        pg8::Gemm g{(const bf16*)(ws + WS_MG), WOUT, MP, D, D}; pg8::StaticOrder S; S.init(MP, D, G, bid);
        pg8::EpiBf16P E{(bf16*)(ws + WS_OUTF), D};
        pg8::gemm_phase<pg8::EpiBf16P, pg8::StaticOrder, true, true>(lds, g, S, E);
        if (BOTH(7)) GRID_BAR();
    }
    if (IN(8)) for (int rep = 0; rep < NREP(8); ++rep) {
        int ln = lane0; asm volatile("" : "+v"(ln)); const Args a = load_args(lo, hi);
        const bf16* OUTF = (const bf16*)(ws + WS_OUTF);
        for (int mrow = gw; mrow < MROWS; mrow += NGW) {
            const float* xr = mrow < MP ? a.x_p + (size_t)mrow * D : a.x_s + (size_t)(mrow - MP) * D;
            float* yr = mrow < MP ? a.out + O_YP + (size_t)mrow * D : a.out + O_YS + (size_t)(mrow - MP) * D;
            const int bi = mrow < MP ? (mrow >> 11) : 4 + ((mrow - MP) >> 3);
            const float* md = MOD + bi * 6144 + 4096;
            const bf16* orow = OUTF + (size_t)mrow * D;
            v4u ow[4]; f32x4 v[8], xv[8], ms[8]; float s = 0.f;
#pragma unroll
            for (int j = 0; j < 4; ++j) { ow[j] = *(const v4u*)(orow + 8 * (ln + 64 * j)); xv[2 * j] = __builtin_nontemporal_load((const f32x4*)(xr + 8 * (ln + 64 * j))); xv[2 * j + 1] = __builtin_nontemporal_load((const f32x4*)(xr + 8 * (ln + 64 * j) + 4)); }
#pragma unroll
            for (int j = 0; j < 8; ++j) { const int col = 8 * (ln + 64 * (j >> 1)) + 4 * (j & 1); ms[j] = *(const f32x4*)(a.post_g + col) * (*(const f32x4*)(md + col) + *(const f32x4*)(a.b_ada + 4096 + col)); }
#pragma unroll
            for (int j = 0; j < 4; ++j) { v[2 * j] = (f32x4){pg8::bf_lo(ow[j].x), pg8::bf_hi(ow[j].x), pg8::bf_lo(ow[j].y), pg8::bf_hi(ow[j].y)}; v[2 * j + 1] = (f32x4){pg8::bf_lo(ow[j].z), pg8::bf_hi(ow[j].z), pg8::bf_lo(ow[j].w), pg8::bf_hi(ow[j].w)}; }
#pragma unroll
            for (int j = 0; j < 8; ++j) s += (v[j][0] * v[j][0] + v[j][1] * v[j][1]) + (v[j][2] * v[j][2] + v[j][3] * v[j][3]);
            const float rstd = rsqrtf(wave_sum(s) * (1.0f / D) + NORM_EPS);
#pragma unroll
            for (int j = 0; j < 8; ++j) *(f32x4*)(yr + 8 * (ln + 64 * (j >> 1)) + 4 * (j & 1)) = xv[j] + ms[j] * (v[j] * rstd);
        }
    }
#undef IN
#undef BOTH
}

extern "C" void kernel_launch(void* const* d_in, const int* in_sizes, int n_in, void* d_out, int out_size, void* d_ws, size_t ws_size, hipStream_t stream) {
    static int grid = 0;
    if (grid == 0) {
        if (n_in != 22 || (size_t)out_size != O_END || ws_size < WS_END) { fprintf(stderr, "kernel_launch: unexpected shapes (n_in %d, out %d, ws %zu); nothing launched\n", n_in, out_size, ws_size); grid = -1; return; }
        int dev = 0, cus = 0;
        if (hipGetDevice(&dev) != hipSuccess || hipDeviceGetAttribute(&cus, hipDeviceAttributeMultiprocessorCount, dev) != hipSuccess) { grid = -1; return; }
        if (hipFuncSetAttribute((const void*)fwd, hipFuncAttributeMaxDynamicSharedMemorySize, LDS_BYTES) != hipSuccess) { fprintf(stderr, "kernel_launch: hipFuncSetAttribute failed\n"); grid = -1; return; }
        int per_cu = 0;
        if (hipOccupancyMaxActiveBlocksPerMultiprocessor(&per_cu, (const void*)fwd, NTHREADS, LDS_BYTES) != hipSuccess || per_cu < 1) fprintf(stderr, "kernel_launch: note: occupancy query reports %d\n", per_cu);
        (void)hipGetLastError();
        grid = cus;
    }
    if (grid < 0) return;
    (void)hipMemsetAsync((char*)d_ws + WS_CTL, 0, CTL_ZERO_BYTES, stream);
    Args a{};
    a.x_p = (const float*)d_in[0]; a.x_s = (const float*)d_in[1]; a.c_p = (const float*)d_in[2]; a.c_s = (const float*)d_in[3];
    a.cache_k = (const float*)d_in[4]; a.cache_v = (const float*)d_in[5]; a.cache_kidx = (const float*)d_in[6]; a.state_gdn = (const float*)d_in[7]; a.state_conv = (const float*)d_in[8];
    a.page_table = (const int*)d_in[9];
    a.w_ada = (const float*)d_in[10]; a.b_ada = (const float*)d_in[11]; a.pre_g = (const float*)d_in[12]; a.w_in = (const float*)d_in[13]; a.conv_w = (const float*)d_in[14];
    a.a_log = (const float*)d_in[15]; a.dt_bias = (const float*)d_in[16]; a.gdn_g = (const float*)d_in[17]; a.w_pa = (const float*)d_in[18]; a.w_pb = (const float*)d_in[19];
    a.w_out = (const float*)d_in[20]; a.post_g = (const float*)d_in[21];
    a.out = (float*)d_out; a.ws = (unsigned char*)d_ws;
#if MK_ONE_LAUNCH
    a.ph_lo = 0; a.ph_hi = N_PHASES;
    hipLaunchKernelGGL(fwd, dim3(grid), dim3(NTHREADS), LDS_BYTES, stream, a);
#else
    for (int ph = 0; ph < N_PHASES; ++ph) { a.ph_lo = ph; a.ph_hi = ph + 1; hipLaunchKernelGGL(fwd, dim3(grid), dim3(NTHREADS), LDS_BYTES, stream, a); }
#endif
}
```

```cpp
#include <hip/hip_runtime.h>
#include <cstdio>
#include <cstdint>
constexpr int D = 2048, BP = 4, LP = 2048, BS = 32, LS = 8, MP = BP * LP, MS = BS * LS, MROWS = MP + MS;
constexpr int NPAGES = 64, PAGE = 128, PAST = NPAGES * PAGE;
constexpr int HV = 32, HQK = 16, DK = 128, DV = 128, CONVCH = 8192;
constexpr int NIN = 23248, NPAD = 23296;
constexpr int NTOPK = 256;
constexpr float NORM_EPS = 1e-6f, L2_EPS = 1e-6f;
constexpr int SCS_LD = 8256;
constexpr size_t O_YP = 0, O_YS = O_YP + (size_t)MP * D, O_KP = O_YS + (size_t)MS * D, O_VP = O_KP + (size_t)MP * 256, O_KIP = O_VP + (size_t)MP * 256,
                 O_GP = O_KIP + (size_t)MP * 128, O_CP = O_GP + (size_t)BP * HV * DK * DV, O_KS = O_CP + (size_t)BP * 3 * CONVCH, O_VS = O_KS + (size_t)MS * 256,
                 O_KIS = O_VS + (size_t)MS * 256, O_GS = O_KIS + (size_t)MS * 128, O_CS = O_GS + (size_t)BS * HV * DK * DV, O_END = O_CS + (size_t)BS * 3 * CONVCH;
static_assert(O_END == 42467328, "output size");
__host__ __device__ __forceinline__ int win_src_col(int n) {
    if (n < 12288) return n;
    if (n < 18944) return n + 64;
    if (n < 23040) return n + 208;
    if (n < 23168) return n - 23040 + 19008;
    if (n < 23200) return n - 23168 + 12288;
    if (n < 23232) return n - 23200 + 12320;
    if (n < 23248) return n - 23232 + 19136;
    return -1;
}
namespace pg8 {
#define PG8_LAS __attribute__((address_space(3)))
typedef unsigned short bf16_t;
typedef short bf16x8 __attribute__((ext_vector_type(8)));
typedef float f32x4 __attribute__((ext_vector_type(4)));
typedef unsigned u32x4 __attribute__((ext_vector_type(4)));
constexpr int BM = 256, BK = 64, HALF = 128, HTB = HALF * BK * 2  , STAGE_BYTES = 8 * HTB, NXCD = 8, WGM = 4;

__host__ __device__ __forceinline__ int lds_byte(int r, int c) { const int st = (r >> 4) * 2 + (c >> 5), rr = r & 15, cc = c & 31, ob = rr * 64 + cc * 2; return st * 1024 + (ob ^ (((ob >> 9) & 1) << 5)); }
__host__ __device__ __forceinline__ void stage_rc(int b, int& R, int& C) { const int st = b / 1024, sb = b % 1024, swz = sb ^ (((sb >> 9) & 1) << 5); R = (st >> 1) * 16 + swz / 64; C = (st & 1) * 32 + (swz % 64) / 2; }
__host__ __device__ __forceinline__ int perm32(int rho) { const int n = rho >> 4, i = rho & 15; return 8 * (i >> 2) + 4 * n + (i & 3); }

struct Unit { int pm, pn, seg; };
struct Gemm { const bf16_t* A; const bf16_t* Bt; int M, N, K; };

struct StaticOrder {
    int nM, nN, nwg, G, c;
    __host__ __device__ void init(int M, int N, int G_, int c_) { nM = M / BM; nN = N / BM; nwg = nM * nN; G = G_; c = c_; }
    __host__ __device__ bool next(int i, Unit& u) const {
        const long L = (long)i * G + c; if (L >= nwg) return false;
        int wgid = (int)L; { const int q = nwg / NXCD, r = nwg % NXCD, xcd = wgid % NXCD, off = wgid / NXCD; wgid = (xcd < r ? xcd * (q + 1) : r * (q + 1) + (xcd - r) * q) + off; }
        const int nig = WGM * nN, gid = wgid / nig, fm = gid * WGM, gsz = (nM - fm) < WGM ? (nM - fm) : WGM;
        u.pm = fm + ((wgid % nig) % gsz); u.pn = (wgid % nig) / gsz; return true;
    }
    __device__ __forceinline__ void a_ready(const Unit&) const {}
    __device__ __forceinline__ void done(const Unit&) const {}
};

typedef __bf16 bf16x2_t __attribute__((ext_vector_type(2)));
typedef float f32x2_t __attribute__((ext_vector_type(2)));
__device__ __forceinline__ unsigned cvt_pk_bf16(float lo, float hi) { const f32x2_t v = {lo, hi}; const bf16x2_t b = __builtin_convertvector(v, bf16x2_t); return __builtin_bit_cast(unsigned, b); }
__device__ __forceinline__ float bf_lo(unsigned w) { return __uint_as_float(w << 16); }
__device__ __forceinline__ float bf_hi(unsigned w) { return __uint_as_float(w & 0xffff0000u); }
__device__ __forceinline__ float fsigmoid(float x) { return __builtin_amdgcn_rcpf(1.0f + __expf(-x)); }
__device__ __forceinline__ float fsilu(float x) { return x * fsigmoid(x); }
__device__ __forceinline__ f32x4 act4(f32x4 v, int act) {
    if (act == 1) { v[0] = fsilu(v[0]); v[1] = fsilu(v[1]); v[2] = fsilu(v[2]); v[3] = fsilu(v[3]); }
    else if (act == 2) { v[0] = fsigmoid(v[0]); v[1] = fsigmoid(v[1]); v[2] = fsigmoid(v[2]); v[3] = fsigmoid(v[3]); }
    else if (act == 3) { v = v * 0.08838834764831845f; }
    return v;
}
struct EpiIn {
    static constexpr bool PERM = true, AFTER_DRAIN = false;
    bf16_t *QKV, *Z, *BQ, *BZ, *IQ, *GA, *GB, *IK; float *BETA, *GG, *IW; float* out; const float* a_log; const float* dt_bias; bf16_t* BKV;
    __device__ __forceinline__ void operator()(const f32x4 (&acc)[2][2][4][2], const Unit& u, int wr, int wc, int fr, int fq) const {
        const int pn = u.pn, row0 = u.pm * BM + wr * 64 + fr, cl = wc * 32 + 8 * fq;
        if (pn < 56 || (pn >= 58 && pn < 90)) {
            bf16_t* dst; int ldc, cbase, act;
            if (pn < 32) { dst = QKV; ldc = 8192; cbase = pn * 256; act = 0; }
            else if (pn < 48) { dst = Z; ldc = 4096; cbase = (pn - 32) * 256; act = 0; }
            else if (pn < 56) { dst = BQ; ldc = 2048; cbase = (pn - 48) * 256; act = 3; }
            else if (pn < 66) { dst = BZ; ldc = 2048; cbase = (pn - 58) * 256; act = 0; }
            else if (pn < 74) { dst = IQ; ldc = 2048; cbase = (pn - 66) * 256; act = 0; }
            else if (pn < 82) { dst = GA; ldc = 2048; cbase = (pn - 74) * 256; act = 2; }
            else { dst = GB; ldc = 2048; cbase = (pn - 82) * 256; act = 2; }
            const float csc = act == 3 ? 0.08838834764831845f : 1.0f;
            const bool use_sig = (act == 1) || (act == 2), keep_x = act != 2;
            bf16_t* base = dst + (size_t)row0 * ldc + cbase + cl;
            if (use_sig) {
#pragma unroll
                for (int ai = 0; ai < 2; ++ai)
#pragma unroll
                    for (int m = 0; m < 4; ++m)
#pragma unroll
                        for (int bj = 0; bj < 2; ++bj) {
                            f32x4 v0 = acc[ai][bj][m][0], v1 = acc[ai][bj][m][1];
#pragma unroll
                            for (int e = 0; e < 4; ++e) { const float s0 = fsigmoid(v0[e]), s1 = fsigmoid(v1[e]); v0[e] = keep_x ? v0[e] * s0 : s0; v1[e] = keep_x ? v1[e] * s1 : s1; }
                            u32x4 w; w.x = cvt_pk_bf16(v0[0], v0[1]); w.y = cvt_pk_bf16(v0[2], v0[3]); w.z = cvt_pk_bf16(v1[0], v1[1]); w.w = cvt_pk_bf16(v1[2], v1[3]);
                            __builtin_nontemporal_store(w, (u32x4*)(base + (size_t)(ai * HALF + m * 16) * ldc + bj * HALF));
                        }
            } else {
#pragma unroll
                for (int ai = 0; ai < 2; ++ai)
#pragma unroll
                    for (int m = 0; m < 4; ++m)
#pragma unroll
                        for (int bj = 0; bj < 2; ++bj) {
                            const f32x4 v0 = acc[ai][bj][m][0] * csc, v1 = acc[ai][bj][m][1] * csc;
                            u32x4 w; w.x = cvt_pk_bf16(v0[0], v0[1]); w.y = cvt_pk_bf16(v0[2], v0[3]); w.z = cvt_pk_bf16(v1[0], v1[1]); w.w = cvt_pk_bf16(v1[2], v1[3]);
                            __builtin_nontemporal_store(w, (u32x4*)(base + (size_t)(ai * HALF + m * 16) * ldc + bj * HALF));
                        }
            }
            if (pn < 32 && ((u.pm & 7) == 7)) {
                int fro = fr; asm volatile("" : "+v"(fro));
                if (wr == 1 && fro >= 13) {
                    float* tail = out + O_CP + ((size_t)(u.pm >> 3) * 3 + (fro - 13)) * CONVCH + cbase + 8 * (fq) + wc * 32;
#pragma unroll
                    for (int bj = 0; bj < 2; ++bj) { *(f32x4*)(tail + bj * HALF) = acc[1][bj][3][0]; *(f32x4*)(tail + bj * HALF + 4) = acc[1][bj][3][1]; }
                }
            }
            if (pn < 32 && u.pm == MP / BM) {
                int fro = fr; asm volatile("" : "+v"(fro));
#pragma unroll
                for (int ai = 0; ai < 2; ++ai)
#pragma unroll
                    for (int m = 0; m < 4; ++m) { const int rr = ai * HALF + wr * 64 + m * 16 + fro, t = rr & 7;
                        if (t >= 5) { float* tail = out + O_CS + ((size_t)(rr >> 3) * 3 + (t - 5)) * CONVCH + cbase + cl;
#pragma unroll
                            for (int bj = 0; bj < 2; ++bj) { *(f32x4*)(tail + bj * HALF) = acc[ai][bj][m][0]; *(f32x4*)(tail + bj * HALF + 4) = acc[ai][bj][m][1]; } } }
            }
        } else if (pn < 58) {
#pragma unroll
            for (int ai = 0; ai < 2; ++ai)
#pragma unroll
                for (int m = 0; m < 4; ++m) {
                    const int row = row0 + ai * HALF + m * 16;
                    float* rowp = out + (row < MP ? (pn == 56 ? O_KP : O_VP) + (size_t)row * 256 : (pn == 56 ? O_KS : O_VS) + (size_t)(row - MP) * 256) + cl;
#pragma unroll
                    for (int bj = 0; bj < 2; ++bj) { const f32x4 v0 = acc[ai][bj][m][0], v1 = acc[ai][bj][m][1]; *(f32x4*)(rowp + bj * HALF) = v0; *(f32x4*)(rowp + bj * HALF + 4) = v1;
                        u32x4 w; w.x = cvt_pk_bf16(v0[0], v0[1]); w.y = cvt_pk_bf16(v0[2], v0[3]); w.z = cvt_pk_bf16(v1[0], v1[1]); w.w = cvt_pk_bf16(v1[2], v1[3]);
                        *(u32x4*)(BKV + (size_t)row * 512 + (pn == 57 ? 256 : 0) + cl + bj * HALF) = w; }
                }
        } else {
#pragma unroll
            for (int ai = 0; ai < 2; ++ai)
#pragma unroll
                for (int m = 0; m < 4; ++m) {
                    const int row = row0 + ai * HALF + m * 16;
                    {
                        const f32x4 v0 = acc[ai][0][m][0], v1 = acc[ai][0][m][1];
                        float* o = out + (row < MP ? O_KIP + (size_t)row * 128 : O_KIS + (size_t)(row - MP) * 128) + cl;
                        *(f32x4*)o = v0; *(f32x4*)(o + 4) = v1;
                        u32x4 w; w.x = cvt_pk_bf16(v0[0], v0[1]); w.y = cvt_pk_bf16(v0[2], v0[3]); w.z = cvt_pk_bf16(v1[0], v1[1]); w.w = cvt_pk_bf16(v1[2], v1[3]);
                        *(u32x4*)(IK + (size_t)row * 128 + cl) = w;
                    }
                    {
                        f32x4 v0 = acc[ai][1][m][0], v1 = acc[ai][1][m][1];
                        if (wc == 0) {
                            float* o = BETA + (size_t)row * 32 + cl;
                            v0 = act4(v0, 2); v1 = act4(v1, 2); *(f32x4*)o = v0; *(f32x4*)(o + 4) = v1;
                        } else if (wc == 1) {
                            const int h0 = cl - 32; float* o = GG + (size_t)row * 32 + h0;
                            float r[8];
#pragma unroll
                            for (int e = 0; e < 8; ++e) { const float x = (e < 4 ? v0[e & 3] : v1[e & 3]) + dt_bias[h0 + e]; const float sp = fmaxf(x, 0.f) + __logf(1.0f + __expf(-fabsf(x))); r[e] = -__expf(a_log[h0 + e]) * sp; }
                            *(f32x4*)o = (f32x4){r[0], r[1], r[2], r[3]}; *(f32x4*)(o + 4) = (f32x4){r[4], r[5], r[6], r[7]};
                        } else if (wc == 2 && fq < 2) {
                            float* o = IW + (size_t)row * 16 + (cl - 64);
                            *(f32x4*)o = v0; *(f32x4*)(o + 4) = v1;
                        }
                    }
                }
        }
    }
};
struct EpiM1 {
    static constexpr bool PERM = true, AFTER_DRAIN = false;
    const bf16_t* GA; bf16_t* TMP;
    __device__ __forceinline__ void operator()(const f32x4 (&acc)[2][2][4][2], const Unit& u, int wr, int wc, int fr, int fq) const {
        const int row0 = u.pm * BM + wr * 64 + fr, col0 = u.pn * BM + wc * 32 + 8 * fq;
        u32x4 gw[2][4][2];
#pragma unroll
        for (int ai = 0; ai < 2; ++ai)
#pragma unroll
            for (int m = 0; m < 4; ++m)
#pragma unroll
                for (int bj = 0; bj < 2; ++bj) gw[ai][m][bj] = *(const u32x4*)(GA + (size_t)(row0 + ai * HALF + m * 16) * D + col0 + bj * HALF);
#pragma unroll
        for (int ai = 0; ai < 2; ++ai)
#pragma unroll
            for (int m = 0; m < 4; ++m) { const size_t off = (size_t)(row0 + ai * HALF + m * 16) * D + col0;
#pragma unroll
                for (int bj = 0; bj < 2; ++bj) { const u32x4 g4 = gw[ai][m][bj]; const f32x4 v0 = acc[ai][bj][m][0], v1 = acc[ai][bj][m][1];
                    u32x4 w; w.x = cvt_pk_bf16(v0[0] * bf_lo(g4.x), v0[1] * bf_hi(g4.x)); w.y = cvt_pk_bf16(v0[2] * bf_lo(g4.y), v0[3] * bf_hi(g4.y));
                    w.z = cvt_pk_bf16(v1[0] * bf_lo(g4.z), v1[1] * bf_hi(g4.z)); w.w = cvt_pk_bf16(v1[2] * bf_lo(g4.w), v1[3] * bf_hi(g4.w));
                    *(u32x4*)(TMP + off + bj * HALF) = w; } }
    }
};
struct EpiM2 {
    static constexpr bool PERM = true, AFTER_DRAIN = false;
    const bf16_t* GB; const bf16_t* TMP; bf16_t* MG;
    __device__ __forceinline__ void operator()(const f32x4 (&acc)[2][2][4][2], const Unit& u, int wr, int wc, int fr, int fq) const {
        const int row0 = u.pm * BM + wr * 64 + fr, col0 = u.pn * BM + wc * 32 + 8 * fq;
#pragma unroll
        for (int ai = 0; ai < 2; ++ai)
#pragma unroll
            for (int mh = 0; mh < 2; ++mh) {
                u32x4 gw[2][2], tw[2][2];
#pragma unroll
                for (int mm = 0; mm < 2; ++mm)
#pragma unroll
                    for (int bj = 0; bj < 2; ++bj) { const size_t off = (size_t)(row0 + ai * HALF + (2 * mh + mm) * 16) * D + col0 + bj * HALF; gw[mm][bj] = *(const u32x4*)(GB + off); tw[mm][bj] = *(const u32x4*)(TMP + off); }
#pragma unroll
                for (int mm = 0; mm < 2; ++mm)
#pragma unroll
                    for (int bj = 0; bj < 2; ++bj) { const int m = 2 * mh + mm; const size_t off = (size_t)(row0 + ai * HALF + m * 16) * D + col0 + bj * HALF; const u32x4 g4 = gw[mm][bj], t4 = tw[mm][bj]; const f32x4 v0 = acc[ai][bj][m][0], v1 = acc[ai][bj][m][1];
                        u32x4 w; w.x = cvt_pk_bf16(bf_lo(t4.x) + v0[0] * bf_lo(g4.x), bf_hi(t4.x) + v0[1] * bf_hi(g4.x)); w.y = cvt_pk_bf16(bf_lo(t4.y) + v0[2] * bf_lo(g4.y), bf_hi(t4.y) + v0[3] * bf_hi(g4.y));
                        w.z = cvt_pk_bf16(bf_lo(t4.z) + v1[0] * bf_lo(g4.z), bf_hi(t4.z) + v1[1] * bf_hi(g4.z)); w.w = cvt_pk_bf16(bf_lo(t4.w) + v1[2] * bf_lo(g4.w), bf_hi(t4.w) + v1[3] * bf_hi(g4.w));
                        *(u32x4*)(MG + off) = w; }
            }
    }
};
struct EpiChain {
    static constexpr bool PERM = true, AFTER_DRAIN = false;
    const bf16_t *GA, *GB; bf16_t* MG;
    __device__ __forceinline__ void operator()(f32x4 (&acc)[2][2][4][2], const Unit& u, int wr, int wc, int fr, int fq) const {
        if (u.seg == 0) return;
        const int row0 = u.pm * BM + wr * 64 + fr, col0 = u.pn * BM + wc * 32 + 8 * fq;
        if (u.seg == 1) {
#pragma unroll
            for (int ai = 0; ai < 2; ++ai) {
                u32x4 ga[4][2], gb[4][2];
#pragma unroll
                for (int m = 0; m < 4; ++m)
#pragma unroll
                    for (int bj = 0; bj < 2; ++bj) { const size_t off = (size_t)(row0 + ai * HALF + m * 16) * D + col0 + bj * HALF; ga[m][bj] = *(const u32x4*)(GA + off); gb[m][bj] = *(const u32x4*)(GB + off); }
#pragma unroll
                for (int m = 0; m < 4; ++m)
#pragma unroll
                    for (int bj = 0; bj < 2; ++bj) { const u32x4 a4 = ga[m][bj], b4 = gb[m][bj];
                        acc[ai][bj][m][0] = acc[ai][bj][m][0] * (f32x4){bf_lo(a4.x) * __builtin_amdgcn_rcpf(fmaxf(bf_lo(b4.x), 1e-30f)), bf_hi(a4.x) * __builtin_amdgcn_rcpf(fmaxf(bf_hi(b4.x), 1e-30f)), bf_lo(a4.y) * __builtin_amdgcn_rcpf(fmaxf(bf_lo(b4.y), 1e-30f)), bf_hi(a4.y) * __builtin_amdgcn_rcpf(fmaxf(bf_hi(b4.y), 1e-30f))};
                        acc[ai][bj][m][1] = acc[ai][bj][m][1] * (f32x4){bf_lo(a4.z) * __builtin_amdgcn_rcpf(fmaxf(bf_lo(b4.z), 1e-30f)), bf_hi(a4.z) * __builtin_amdgcn_rcpf(fmaxf(bf_hi(b4.z), 1e-30f)), bf_lo(a4.w) * __builtin_amdgcn_rcpf(fmaxf(bf_lo(b4.w), 1e-30f)), bf_hi(a4.w) * __builtin_amdgcn_rcpf(fmaxf(bf_hi(b4.w), 1e-30f))}; }
            }
        } else {
            u32x4 gb[2][4][2];
#pragma unroll
            for (int ai = 0; ai < 2; ++ai)
#pragma unroll
                for (int m = 0; m < 4; ++m)
#pragma unroll
                    for (int bj = 0; bj < 2; ++bj) gb[ai][m][bj] = *(const u32x4*)(GB + (size_t)(row0 + ai * HALF + m * 16) * D + col0 + bj * HALF);
#pragma unroll
            for (int ai = 0; ai < 2; ++ai)
#pragma unroll
                for (int m = 0; m < 4; ++m)
#pragma unroll
                    for (int bj = 0; bj < 2; ++bj) { const u32x4 b4 = gb[ai][m][bj]; const f32x4 v0 = acc[ai][bj][m][0], v1 = acc[ai][bj][m][1];
                        u32x4 w; w.x = cvt_pk_bf16(v0[0] * bf_lo(b4.x), v0[1] * bf_hi(b4.x)); w.y = cvt_pk_bf16(v0[2] * bf_lo(b4.y), v0[3] * bf_hi(b4.y));
                        w.z = cvt_pk_bf16(v1[0] * bf_lo(b4.z), v1[1] * bf_hi(b4.z)); w.w = cvt_pk_bf16(v1[2] * bf_lo(b4.w), v1[3] * bf_hi(b4.w));
                        *(u32x4*)(MG + (size_t)(row0 + ai * HALF + m * 16) * D + col0 + bj * HALF) = w; }
        }
    }
};
struct EpiBf16P {
    static constexpr bool PERM = true, AFTER_DRAIN = false;
    bf16_t* C; int ldc;
    __device__ __forceinline__ void operator()(const f32x4 (&acc)[2][2][4][2], const Unit& u, int wr, int wc, int fr, int fq) const {
        const int row0 = u.pm * BM + wr * 64 + fr, col0 = u.pn * BM + wc * 32 + 8 * fq;
#pragma unroll
        for (int ai = 0; ai < 2; ++ai)
#pragma unroll
            for (int m = 0; m < 4; ++m) { bf16_t* rowp = C + (size_t)(row0 + ai * HALF + m * 16) * ldc + col0;
#pragma unroll
                for (int bj = 0; bj < 2; ++bj) { const f32x4 v0 = acc[ai][bj][m][0], v1 = acc[ai][bj][m][1];
                    u32x4 w; w.x = cvt_pk_bf16(v0[0], v0[1]); w.y = cvt_pk_bf16(v0[2], v0[3]); w.z = cvt_pk_bf16(v1[0], v1[1]); w.w = cvt_pk_bf16(v1[2], v1[3]);
                    *(u32x4*)(rowp + bj * HALF) = w; } }
    }
};
#ifndef PG8_B_AUX
#define PG8_B_AUX 0
#endif
template <class Epi, class Sched, bool ALIGN_EPI = false, bool SP2 = false>
__device__ __forceinline__ void gemm_phase(PG8_LAS unsigned char* lds, const Gemm g, const Sched& S, const Epi& E) {
    const int tid = threadIdx.x, wid = __builtin_amdgcn_readfirstlane(tid >> 6), lane = tid & 63, wr = wid >> 2, wc = wid & 3, fr = lane & 15, fq = lane >> 4;
    const int K = g.K, nt = K / BK;
    unsigned voffA[2], voffB[2];
#pragma unroll
    for (int i = 0; i < 2; ++i) { int R, C; stage_rc(tid * 16 + i * 8192, R, C); const int Rb = Epi::PERM ? ((R & ~31) + perm32(R & 31)) : R;
        voffA[i] = (unsigned)(R * K + C) * 2u; voffB[i] = (unsigned)(Rb * K + C) * 2u; }
    const size_t kstep = (size_t)(BK * 2);
    const size_t hstep = (size_t)HALF * K * 2;
    const size_t tstep = 2 * hstep;
    const unsigned ldsw = (unsigned)wid * 1024u;
    const int aoff = lds_byte(wr * 64 + fr, fq * 8), boff = lds_byte(wc * 32 + fr, fq * 8);
#define PG8_SA(b, h) (((b) * 2 + (h)) * HTB)
#define PG8_SB(b, h) ((4 + (b) * 2 + (h)) * HTB)
#define PG8_STAGE(bufoff, gbase, voff) do { _Pragma("unroll") for (int _i = 0; _i < 2; ++_i) \
        __builtin_amdgcn_global_load_lds((const unsigned*)((const char*)(gbase) + (voff)[_i]), (PG8_LAS unsigned*)(lds + (bufoff) + ldsw + _i * 8192), 16, 0, ((bufoff) >= 4 * HTB) ? PG8_B_AUX : 0); } while (0)
#define PG8_LDA(dst, b, h) do { _Pragma("unroll") for (int m = 0; m < 4; ++m) _Pragma("unroll") for (int k = 0; k < 2; ++k) dst[m][k] = *(const PG8_LAS bf16x8*)(lds + PG8_SA(b, h) + aoff + m * 2048 + k * 1024); } while (0)
#define PG8_LDB(dst, b, h) do { _Pragma("unroll") for (int n = 0; n < 2; ++n) _Pragma("unroll") for (int k = 0; k < 2; ++k) dst[n][k] = *(const PG8_LAS bf16x8*)(lds + PG8_SB(b, h) + boff + n * 2048 + k * 1024); } while (0)
#define PG8_MMA(ai, bj, At, Bt) do { __builtin_amdgcn_s_setprio(1); _Pragma("unroll") for (int m = 0; m < 4; ++m) _Pragma("unroll") for (int n = 0; n < 2; ++n) _Pragma("unroll") for (int k = 0; k < 2; ++k) \
        acc[ai][bj][m][n] = __builtin_amdgcn_mfma_f32_16x16x32_bf16(Bt[n][k], At[m][k], acc[ai][bj][m][n], 0, 0, 0); __builtin_amdgcn_s_setprio(0); } while (0)
#define PG8_WAIT_V(n) asm volatile("s_waitcnt vmcnt(" #n ")" ::: "memory")
#define PG8_WAIT_L(n) asm volatile("s_waitcnt lgkmcnt(" #n ")" ::: "memory")
#define PG8_BAR __builtin_amdgcn_s_barrier()
#define PG8_SCHED __builtin_amdgcn_sched_barrier(0)
    Unit cur, nxt; int ui = 0;
    if (!S.next(0, cur)) return;
    f32x4 acc[2][2][4][2];
#pragma unroll
    for (int a = 0; a < 2; ++a)
#pragma unroll
        for (int b = 0; b < 2; ++b)
#pragma unroll
            for (int m = 0; m < 4; ++m)
#pragma unroll
                for (int n = 0; n < 2; ++n) acc[a][b][m][n] = (f32x4){0.f, 0.f, 0.f, 0.f};
    bf16x8 At[4][2], B0[2][2], B1[2][2];
    const char* cA = (const char*)g.A + (size_t)cur.pm * tstep; const char* cB = (const char*)g.Bt + (size_t)cur.pn * tstep;
    S.a_ready(cur);
    if constexpr (SP2) {
        PG8_STAGE(PG8_SB(0, 0), cB, voffB); PG8_STAGE(PG8_SB(0, 1), cB + hstep, voffB); PG8_STAGE(PG8_SA(0, 0), cA, voffA); PG8_STAGE(PG8_SA(0, 1), cA + hstep, voffA);
        if (wr == 1) PG8_BAR;
        PG8_WAIT_V(2); PG8_BAR;
        PG8_STAGE(PG8_SB(1, 0), cB + kstep, voffB); PG8_STAGE(PG8_SA(1, 0), cA + kstep, voffA); PG8_STAGE(PG8_SB(1, 1), cB + hstep + kstep, voffB);
        PG8_WAIT_V(6); PG8_BAR;
    } else {
        PG8_STAGE(PG8_SB(0, 0), cB, voffB); PG8_STAGE(PG8_SA(0, 0), cA, voffA); PG8_STAGE(PG8_SB(0, 1), cB + hstep, voffB); PG8_STAGE(PG8_SA(0, 1), cA + hstep, voffA);
        if (wr == 1) PG8_BAR;
        PG8_WAIT_V(4); PG8_BAR;
        PG8_STAGE(PG8_SB(1, 0), cB + kstep, voffB); PG8_STAGE(PG8_SA(1, 0), cA + kstep, voffA); PG8_STAGE(PG8_SB(1, 1), cB + hstep + kstep, voffB);
        PG8_WAIT_V(6); PG8_BAR;
    }
    for (;;) {
        const bool has_next = S.next(ui + 1, nxt);
        const char* nA = has_next ? (const char*)g.A + (size_t)nxt.pm * tstep : cA; const char* nB = has_next ? (const char*)g.Bt + (size_t)nxt.pn * tstep : cB;
        for (int t = 0; t < nt; t += 2) {
            const bool last = (t == nt - 2);
            const char* a1 = cA + (size_t)(t + 1) * kstep;
            const char* a2 = last ? nA : cA + (size_t)(t + 2) * kstep; const char* b2 = last ? nB : cB + (size_t)(t + 2) * kstep;
            const char* a3 = a2 + kstep; const char* b3 = b2 + kstep;
            if (last && has_next) S.a_ready(nxt);
            if constexpr (SP2) {
            PG8_LDB(B0, 0, 0); PG8_LDB(B1, 0, 1); PG8_SCHED; PG8_LDA(At, 0, 0); PG8_STAGE(PG8_SA(1, 1), a1 + hstep, voffA);
            PG8_WAIT_V(8); PG8_WAIT_L(0); PG8_BAR; PG8_MMA(0, 0, At, B0); PG8_MMA(0, 1, At, B1); PG8_BAR; PG8_SCHED;
            PG8_LDA(At, 0, 1); PG8_STAGE(PG8_SB(0, 0), b2, voffB); PG8_STAGE(PG8_SB(0, 1), b2 + hstep, voffB); PG8_STAGE(PG8_SA(0, 0), a2, voffA);
            PG8_WAIT_V(8); PG8_WAIT_L(0); PG8_BAR; PG8_MMA(1, 0, At, B0); PG8_MMA(1, 1, At, B1); PG8_BAR; PG8_SCHED;
            PG8_LDB(B0, 1, 0); PG8_LDB(B1, 1, 1); PG8_SCHED; PG8_LDA(At, 1, 0); PG8_STAGE(PG8_SA(0, 1), a2 + hstep, voffA);
            PG8_WAIT_V(8); PG8_WAIT_L(0); PG8_BAR; PG8_MMA(0, 0, At, B0); PG8_MMA(0, 1, At, B1); PG8_BAR; PG8_SCHED;
            PG8_LDA(At, 1, 1); PG8_STAGE(PG8_SB(1, 0), b3, voffB); PG8_STAGE(PG8_SB(1, 1), b3 + hstep, voffB); PG8_STAGE(PG8_SA(1, 0), a3, voffA);
            PG8_WAIT_V(8); PG8_WAIT_L(0); PG8_BAR; PG8_MMA(1, 0, At, B0); PG8_MMA(1, 1, At, B1); PG8_BAR; PG8_SCHED;
            } else {
            PG8_LDB(B0, 0, 0); PG8_SCHED; PG8_LDA(At, 0, 0); PG8_STAGE(PG8_SA(1, 1), a1 + hstep, voffA);
            PG8_WAIT_L(8); PG8_BAR; PG8_WAIT_L(0); PG8_MMA(0, 0, At, B0); PG8_BAR; PG8_SCHED;
            PG8_LDB(B1, 0, 1); PG8_STAGE(PG8_SB(0, 0), b2, voffB);
            PG8_BAR; PG8_WAIT_L(0); PG8_MMA(0, 1, At, B1); PG8_BAR;
            PG8_LDA(At, 0, 1); PG8_STAGE(PG8_SA(0, 0), a2, voffA);
            PG8_BAR; PG8_WAIT_L(0); PG8_MMA(1, 0, At, B0); PG8_BAR; PG8_SCHED;
            PG8_STAGE(PG8_SB(0, 1), b2 + hstep, voffB);
            PG8_WAIT_V(6); PG8_BAR; PG8_MMA(1, 1, At, B1); PG8_BAR;
            PG8_LDB(B0, 1, 0); PG8_SCHED; PG8_LDA(At, 1, 0); PG8_STAGE(PG8_SA(0, 1), a2 + hstep, voffA);
            PG8_WAIT_L(8); PG8_BAR; PG8_WAIT_L(0); PG8_MMA(0, 0, At, B0); PG8_BAR; PG8_SCHED;
            PG8_LDB(B1, 1, 1); PG8_STAGE(PG8_SB(1, 0), b3, voffB);
            PG8_BAR; PG8_WAIT_L(0); PG8_MMA(0, 1, At, B1); PG8_BAR;
            PG8_LDA(At, 1, 1); PG8_STAGE(PG8_SA(1, 0), a3, voffA);
            PG8_BAR; PG8_WAIT_L(0); PG8_MMA(1, 0, At, B0); PG8_BAR; PG8_SCHED;
            PG8_STAGE(PG8_SB(1, 1), b3 + hstep, voffB);
            PG8_WAIT_V(6); PG8_BAR; PG8_MMA(1, 1, At, B1); PG8_BAR;
            }
        }
        if constexpr (ALIGN_EPI) { if (wr == 0) PG8_BAR; }
        if constexpr (!Epi::AFTER_DRAIN) { E(acc, cur, wr, wc, fr, fq); S.done(cur); }
        if (!has_next) break;
#pragma unroll
        for (int a = 0; a < 2; ++a)
#pragma unroll
            for (int b = 0; b < 2; ++b)
#pragma unroll
                for (int m = 0; m < 4; ++m)
#pragma unroll
                    for (int n = 0; n < 2; ++n) acc[a][b][m][n] = (f32x4){0.f, 0.f, 0.f, 0.f};
        cur = nxt; cA = nA; cB = nB; ++ui;
        if constexpr (ALIGN_EPI) { if (wr == 1) PG8_BAR; }
    }
    PG8_WAIT_V(0);
    if constexpr (!ALIGN_EPI) { if (wr == 0) PG8_BAR; }
    PG8_BAR;
    if constexpr (Epi::AFTER_DRAIN) { E.fused(acc, cur, wr, wc, fr, fq, lds, wid, lane); S.done(cur); }
#undef PG8_SA
#undef PG8_SB
#undef PG8_STAGE
#undef PG8_LDA
#undef PG8_LDB
#undef PG8_MMA
#undef PG8_WAIT_V
#undef PG8_WAIT_L
#undef PG8_BAR
#undef PG8_SCHED
}
struct GemmChain { const bf16_t* A; const bf16_t* Bt; size_t segA, segB; int M, N, K; };
struct ChainOrder : StaticOrder {
    __host__ __device__ bool next(int i, Unit& u) const { const int ti = i / 3; if (!StaticOrder::next(ti, u)) return false; u.seg = i - 3 * ti; return true; }
};
template <class Epi, class Sched, bool ALIGN_EPI = false, bool SP2 = false>
__device__ __forceinline__ void gemm_chain(PG8_LAS unsigned char* lds, const GemmChain g, const Sched& S, const Epi& E) {
    const int tid = threadIdx.x, wid = __builtin_amdgcn_readfirstlane(tid >> 6), lane = tid & 63, wr = wid >> 2, wc = wid & 3, fr = lane & 15, fq = lane >> 4;
    const int K = g.K, nt = K / BK;
    unsigned voffA[2], voffB[2];
#pragma unroll
    for (int i = 0; i < 2; ++i) { int R, C; stage_rc(tid * 16 + i * 8192, R, C); const int Rb = Epi::PERM ? ((R & ~31) + perm32(R & 31)) : R;
        voffA[i] = (unsigned)(R * K + C) * 2u; voffB[i] = (unsigned)(Rb * K + C) * 2u; }
    const size_t kstep = (size_t)(BK * 2);
    const size_t hstep = (size_t)HALF * K * 2;
    const size_t tstep = 2 * hstep;
    const unsigned ldsw = (unsigned)wid * 1024u;
    const int aoff = lds_byte(wr * 64 + fr, fq * 8), boff = lds_byte(wc * 32 + fr, fq * 8);
#define PG8_SA(b, h) (((b) * 2 + (h)) * HTB)
#define PG8_SB(b, h) ((4 + (b) * 2 + (h)) * HTB)
#define PG8_STAGE(bufoff, gbase, voff) do { _Pragma("unroll") for (int _i = 0; _i < 2; ++_i) \
        __builtin_amdgcn_global_load_lds((const unsigned*)((const char*)(gbase) + (voff)[_i]), (PG8_LAS unsigned*)(lds + (bufoff) + ldsw + _i * 8192), 16, 0, 0); } while (0)
#define PG8_LDA(dst, b, h) do { _Pragma("unroll") for (int m = 0; m < 4; ++m) _Pragma("unroll") for (int k = 0; k < 2; ++k) dst[m][k] = *(const PG8_LAS bf16x8*)(lds + PG8_SA(b, h) + aoff + m * 2048 + k * 1024); } while (0)
#define PG8_LDB(dst, b, h) do { _Pragma("unroll") for (int n = 0; n < 2; ++n) _Pragma("unroll") for (int k = 0; k < 2; ++k) dst[n][k] = *(const PG8_LAS bf16x8*)(lds + PG8_SB(b, h) + boff + n * 2048 + k * 1024); } while (0)
#define PG8_MMA(ai, bj, At, Bt) do { __builtin_amdgcn_s_setprio(1); _Pragma("unroll") for (int m = 0; m < 4; ++m) _Pragma("unroll") for (int n = 0; n < 2; ++n) _Pragma("unroll") for (int k = 0; k < 2; ++k) \
        acc[ai][bj][m][n] = __builtin_amdgcn_mfma_f32_16x16x32_bf16(Bt[n][k], At[m][k], acc[ai][bj][m][n], 0, 0, 0); __builtin_amdgcn_s_setprio(0); } while (0)
#define PG8_WAIT_V(n) asm volatile("s_waitcnt vmcnt(" #n ")" ::: "memory")
#define PG8_WAIT_L(n) asm volatile("s_waitcnt lgkmcnt(" #n ")" ::: "memory")
#define PG8_BAR __builtin_amdgcn_s_barrier()
#define PG8_SCHED __builtin_amdgcn_sched_barrier(0)
    Unit cur, nxt; int ui = 0;
    if (!S.next(0, cur)) return;
    f32x4 acc[2][2][4][2];
#pragma unroll
    for (int a = 0; a < 2; ++a)
#pragma unroll
        for (int b = 0; b < 2; ++b)
#pragma unroll
            for (int m = 0; m < 4; ++m)
#pragma unroll
                for (int n = 0; n < 2; ++n) acc[a][b][m][n] = (f32x4){0.f, 0.f, 0.f, 0.f};
    bf16x8 At[4][2], B0[2][2], B1[2][2];
    const char* cA = (const char*)(g.A + (size_t)cur.seg * g.segA) + (size_t)cur.pm * tstep; const char* cB = (const char*)(g.Bt + (size_t)cur.seg * g.segB) + (size_t)cur.pn * tstep;
    S.a_ready(cur);
    if constexpr (SP2) {
        PG8_STAGE(PG8_SB(0, 0), cB, voffB); PG8_STAGE(PG8_SB(0, 1), cB + hstep, voffB); PG8_STAGE(PG8_SA(0, 0), cA, voffA); PG8_STAGE(PG8_SA(0, 1), cA + hstep, voffA);
        if (wr == 1) PG8_BAR;
        PG8_WAIT_V(2); PG8_BAR;
        PG8_STAGE(PG8_SB(1, 0), cB + kstep, voffB); PG8_STAGE(PG8_SA(1, 0), cA + kstep, voffA); PG8_STAGE(PG8_SB(1, 1), cB + hstep + kstep, voffB);
        PG8_WAIT_V(6); PG8_BAR;
    } else {
        PG8_STAGE(PG8_SB(0, 0), cB, voffB); PG8_STAGE(PG8_SA(0, 0), cA, voffA); PG8_STAGE(PG8_SB(0, 1), cB + hstep, voffB); PG8_STAGE(PG8_SA(0, 1), cA + hstep, voffA);
        if (wr == 1) PG8_BAR;
        PG8_WAIT_V(4); PG8_BAR;
        PG8_STAGE(PG8_SB(1, 0), cB + kstep, voffB); PG8_STAGE(PG8_SA(1, 0), cA + kstep, voffA); PG8_STAGE(PG8_SB(1, 1), cB + hstep + kstep, voffB);
        PG8_WAIT_V(6); PG8_BAR;
    }
    for (;;) {
        const bool has_next = S.next(ui + 1, nxt);
        const char* nA = has_next ? (const char*)(g.A + (size_t)nxt.seg * g.segA) + (size_t)nxt.pm * tstep : cA; const char* nB = has_next ? (const char*)(g.Bt + (size_t)nxt.seg * g.segB) + (size_t)nxt.pn * tstep : cB;
        for (int t = 0; t < nt; t += 2) {
            const bool last = (t == nt - 2);
            const char* a1 = cA + (size_t)(t + 1) * kstep;
            const char* a2 = last ? nA : cA + (size_t)(t + 2) * kstep; const char* b2 = last ? nB : cB + (size_t)(t + 2) * kstep;
            const char* a3 = a2 + kstep; const char* b3 = b2 + kstep;
            if (last && has_next) S.a_ready(nxt);
            if constexpr (SP2) {
            PG8_LDB(B0, 0, 0); PG8_LDB(B1, 0, 1); PG8_SCHED; PG8_LDA(At, 0, 0); PG8_STAGE(PG8_SA(1, 1), a1 + hstep, voffA);
            PG8_WAIT_V(8); PG8_WAIT_L(0); PG8_BAR; PG8_MMA(0, 0, At, B0); PG8_MMA(0, 1, At, B1); PG8_BAR; PG8_SCHED;
            PG8_LDA(At, 0, 1); PG8_STAGE(PG8_SB(0, 0), b2, voffB); PG8_STAGE(PG8_SB(0, 1), b2 + hstep, voffB); PG8_STAGE(PG8_SA(0, 0), a2, voffA);
            PG8_WAIT_V(8); PG8_WAIT_L(0); PG8_BAR; PG8_MMA(1, 0, At, B0); PG8_MMA(1, 1, At, B1); PG8_BAR; PG8_SCHED;
            PG8_LDB(B0, 1, 0); PG8_LDB(B1, 1, 1); PG8_SCHED; PG8_LDA(At, 1, 0); PG8_STAGE(PG8_SA(0, 1), a2 + hstep, voffA);
            PG8_WAIT_V(8); PG8_WAIT_L(0); PG8_BAR; PG8_MMA(0, 0, At, B0); PG8_MMA(0, 1, At, B1); PG8_BAR; PG8_SCHED;
            PG8_LDA(At, 1, 1); PG8_STAGE(PG8_SB(1, 0), b3, voffB); PG8_STAGE(PG8_SB(1, 1), b3 + hstep, voffB); PG8_STAGE(PG8_SA(1, 0), a3, voffA);
            PG8_WAIT_V(8); PG8_WAIT_L(0); PG8_BAR; PG8_MMA(1, 0, At, B0); PG8_MMA(1, 1, At, B1); PG8_BAR; PG8_SCHED;
            } else {
            PG8_LDB(B0, 0, 0); PG8_SCHED; PG8_LDA(At, 0, 0); PG8_STAGE(PG8_SA(1, 1), a1 + hstep, voffA);
            PG8_WAIT_L(8); PG8_BAR; PG8_WAIT_L(0); PG8_MMA(0, 0, At, B0); PG8_BAR; PG8_SCHED;
            PG8_LDB(B1, 0, 1); PG8_STAGE(PG8_SB(0, 0), b2, voffB);
            PG8_BAR; PG8_WAIT_L(0); PG8_MMA(0, 1, At, B1); PG8_BAR;
            PG8_LDA(At, 0, 1); PG8_STAGE(PG8_SA(0, 0), a2, voffA);
            PG8_BAR; PG8_WAIT_L(0); PG8_MMA(1, 0, At, B0); PG8_BAR; PG8_SCHED;
            PG8_STAGE(PG8_SB(0, 1), b2 + hstep, voffB);
            PG8_WAIT_V(6); PG8_BAR; PG8_MMA(1, 1, At, B1); PG8_BAR;
            PG8_LDB(B0, 1, 0); PG8_SCHED; PG8_LDA(At, 1, 0); PG8_STAGE(PG8_SA(0, 1), a2 + hstep, voffA);
            PG8_WAIT_L(8); PG8_BAR; PG8_WAIT_L(0); PG8_MMA(0, 0, At, B0); PG8_BAR; PG8_SCHED;
            PG8_LDB(B1, 1, 1); PG8_STAGE(PG8_SB(1, 0), b3, voffB);
            PG8_BAR; PG8_WAIT_L(0); PG8_MMA(0, 1, At, B1); PG8_BAR;
            PG8_LDA(At, 1, 1); PG8_STAGE(PG8_SA(1, 0), a3, voffA);
            PG8_BAR; PG8_WAIT_L(0); PG8_MMA(1, 0, At, B0); PG8_BAR; PG8_SCHED;
            PG8_STAGE(PG8_SB(1, 1), b3 + hstep, voffB);
            PG8_WAIT_V(6); PG8_BAR; PG8_MMA(1, 1, At, B1); PG8_BAR;
            }
        }
        if constexpr (ALIGN_EPI) { if (wr == 0) PG8_BAR; }
        if constexpr (!Epi::AFTER_DRAIN) { E(acc, cur, wr, wc, fr, fq); S.done(cur); }
        if (!has_next) break;
        if (nxt.seg == 0)
#pragma unroll
        for (int a = 0; a < 2; ++a)
#pragma unroll
            for (int b = 0; b < 2; ++b)
#pragma unroll
                for (int m = 0; m < 4; ++m)
#pragma unroll
                    for (int n = 0; n < 2; ++n) acc[a][b][m][n] = (f32x4){0.f, 0.f, 0.f, 0.f};
        cur = nxt; cA = nA; cB = nB; ++ui;
        if constexpr (ALIGN_EPI) { if (wr == 1) PG8_BAR; }
    }
    PG8_WAIT_V(0);
    if constexpr (!ALIGN_EPI) { if (wr == 0) PG8_BAR; }
    PG8_BAR;
    if constexpr (Epi::AFTER_DRAIN) { E.fused(acc, cur, wr, wc, fr, fq, lds, wid, lane); S.done(cur); }
#undef PG8_SA
#undef PG8_SB
#undef PG8_STAGE
#undef PG8_LDA
#undef PG8_LDB
#undef PG8_MMA
#undef PG8_WAIT_V
#undef PG8_WAIT_L
#undef PG8_BAR
#undef PG8_SCHED
}
}
#ifndef MK_ONE_LAUNCH
#define MK_ONE_LAUNCH 1
#endif
constexpr int NWAVES = 8, NTHREADS = NWAVES * 64;
constexpr int N_PHASES = 9;
constexpr size_t MiB = 1u << 20;
constexpr size_t WS_CTL = 0, CTL_ZERO_BYTES = 32 * 1024 + 36 * 6144 * 4;
constexpr size_t WS_MOD = 32 * 1024;
constexpr size_t WS_WIN = 2 * MiB;
constexpr size_t WS_WPA = 94 * MiB;
constexpr size_t WS_WPB = 110 * MiB;
constexpr size_t WS_WOUT = 118 * MiB;
constexpr size_t WS_H = 126 * MiB;
constexpr size_t WS_QKV = 159 * MiB;
constexpr size_t WS_Z = 291 * MiB;
constexpr size_t WS_BQ = 357 * MiB;
constexpr size_t WS_BZ = 390 * MiB;
constexpr size_t WS_IQ = 423 * MiB;
constexpr size_t WS_GA = 456 * MiB, WS_GB = 489 * MiB;
constexpr size_t WS_IK = 522 * MiB;
constexpr size_t WS_BETA = 525 * MiB, WS_GG = 527 * MiB, WS_IW = 529 * MiB;
constexpr size_t WS_YA = 530 * MiB;
constexpr size_t WS_YB = 596 * MiB;
constexpr size_t WS_SC = 629 * MiB;
constexpr size_t WS_SCS = 693 * MiB;
constexpr size_t WS_SEL = 702 * MiB;
constexpr size_t WS_CNT = 711 * MiB;
constexpr size_t WS_TMP = 712 * MiB;
constexpr size_t WS_MG = 778 * MiB;
constexpr size_t WS_OUTF = 811 * MiB;
constexpr size_t WS_QNP = 712 * MiB, WS_KNP = 744 * MiB, WS_KTP = 776 * MiB, WS_VTP = 808 * MiB;
constexpr size_t WS_FR = 877 * MiB;
constexpr size_t WS_QNS = 1171 * MiB, WS_KNS = 1179 * MiB, WS_KTS = 1187 * MiB, WS_VTS = 1195 * MiB;
constexpr size_t WS_END = 1211 * MiB;
constexpr size_t WS_BKV = 1162 * MiB;
static_assert(WS_WIN + (size_t)NPAD * D * 2 <= WS_WPA && WS_H + (size_t)MROWS * D * 2 <= WS_QKV && WS_QKV + (size_t)MROWS * 8192 * 2 <= WS_Z && WS_Z + (size_t)MROWS * 4096 * 2 <= WS_BQ, "ws map");
static_assert(WS_SC + (size_t)MP * 2048 * 4 <= WS_SCS && WS_SCS + (size_t)MS * SCS_LD * 4 <= WS_SEL && WS_SEL + (size_t)MROWS * 256 * 4 <= WS_CNT && WS_TMP + (size_t)MROWS * D * 4 <= WS_MG && WS_OUTF + (size_t)MROWS * D * 4 <= WS_END, "ws map 2");
constexpr int CW_BAR = 4096;
constexpr int CW_Q0 = 32;
constexpr int CW_ATTQ = 64;
constexpr int RING_BYTES = 147456;
constexpr int LDSCTL_OFF = RING_BYTES, MISC_OFF = LDSCTL_OFF + 320;
constexpr int LDS_BYTES = 151552;

#define GAS __attribute__((address_space(1)))
#define LAS __attribute__((address_space(3)))
typedef unsigned short bf16;
typedef unsigned v4u __attribute__((ext_vector_type(4)));
typedef unsigned v2u __attribute__((ext_vector_type(2)));
typedef float f32x4 __attribute__((ext_vector_type(4)));
typedef short bf16x8 __attribute__((ext_vector_type(8)));
typedef short s16x4 __attribute__((ext_vector_type(4)));
typedef GAS unsigned gu32;
#define LDS_WAIT() asm volatile("s_waitcnt lgkmcnt(0)" ::: "memory")
#define VM_WAIT() asm volatile("s_waitcnt vmcnt(0)" ::: "memory")
__device__ __forceinline__ float bf2f(bf16 v) { return __uint_as_float(((unsigned)v) << 16); }
__device__ __forceinline__ unsigned pk2(float lo, float hi) { return pg8::cvt_pk_bf16(lo, hi); }
__device__ __forceinline__ bf16 f2bf(float f) { return (bf16)(pg8::cvt_pk_bf16(f, 0.f) & 0xffffu); }
__device__ __forceinline__ float wave_sum(float v) {
#pragma unroll
    for (int o = 1; o < 64; o <<= 1) v += __shfl_xor(v, o);
    return v;
}
__device__ __forceinline__ float row16_sum(float v) {
    v += __builtin_bit_cast(float, __builtin_amdgcn_mov_dpp(__builtin_bit_cast(int, v), 0xB1, 0xf, 0xf, true));
    v += __builtin_bit_cast(float, __builtin_amdgcn_mov_dpp(__builtin_bit_cast(int, v), 0x4E, 0xf, 0xf, true));
    v += __builtin_bit_cast(float, __builtin_amdgcn_mov_dpp(__builtin_bit_cast(int, v), 0x141, 0xf, 0xf, true));
    v += __builtin_bit_cast(float, __builtin_amdgcn_mov_dpp(__builtin_bit_cast(int, v), 0x140, 0xf, 0xf, true));
    return v;
}
__device__ __forceinline__ unsigned dpp_swap1(unsigned v) { return (unsigned)__builtin_amdgcn_mov_dpp((int)v, 0xB1, 0xf, 0xf, true); }
__device__ __forceinline__ int wave_sum_i(int v) {
#pragma unroll
    for (int o = 1; o < 64; o <<= 1) v += __shfl_xor(v, o);
    return v;
}

#define XB_TMO      128
#define XB_XCNT(j)  (256  + 64 * (j))
#define XB_XSUB(j)  (1280 + 64 * (j))
#define XB_XGEN(j)  (2304 + 64 * (j))
#define XB_TOP      3328
#define XB_TOPGEN   3392
#define XCD_BAR_WORDS 3456
#define XB_SPIN_CAP (1u << 18)
__device__ __forceinline__ unsigned xb_ld(unsigned* p)              { return __hip_atomic_load(p, __ATOMIC_RELAXED, __HIP_MEMORY_SCOPE_AGENT); }
__device__ __forceinline__ unsigned xb_add(unsigned* p, unsigned v) { return __hip_atomic_fetch_add(p, v, __ATOMIC_RELAXED, __HIP_MEMORY_SCOPE_AGENT); }
__device__ __forceinline__ unsigned xb_xcc_id() { return (unsigned)__builtin_amdgcn_s_getreg((3 << 11) | 20) & 0xFu; }
#define XB_SPIN(cond, bar) do { unsigned _sp = 0; while (cond) { __builtin_amdgcn_s_sleep(1); \
    if ((++_sp & 255u) == 0u) { if (xb_ld(&(bar)[XB_TMO])) break; if (_sp > XB_SPIN_CAP) { atomicAdd(&(bar)[XB_TMO], 1u); break; } } } } while (0)
struct XcdBarrier { unsigned* bar; unsigned x; volatile LAS unsigned* st; };
__device__ __forceinline__ XcdBarrier xcd_barrier_post(unsigned* bar, volatile LAS unsigned* st) {
    XcdBarrier b; b.bar = bar; b.x = xb_xcc_id(); b.st = st;
    if (threadIdx.x == 0) (void)xb_add(&bar[XB_XCNT(b.x)], 1u);
    return b;
}
__device__ __forceinline__ void xcd_barrier_complete(unsigned* bar, unsigned x, unsigned& nloc, unsigned& nx) {
    const unsigned G = gridDim.x * gridDim.y * gridDim.z;
    unsigned sum, cnt, mine, sp = 0u;
    for (;;) {
        sum = 0u; cnt = 0u; mine = 0u;
#pragma unroll
        for (unsigned j = 0; j < 16; ++j) { const unsigned c = xb_ld(&bar[XB_XCNT(j)]); sum += c; cnt += (c > 0u) ? 1u : 0u; mine = (j == x) ? c : mine; }
        if (sum == G) break;
        __builtin_amdgcn_s_sleep(1);
        if ((++sp & 255u) == 0u) { if (xb_ld(&bar[XB_TMO])) break; if (sp > XB_SPIN_CAP) { atomicAdd(&bar[XB_TMO], 1u); break; } }
    }
    nloc = mine > 0u ? mine : 1u; nx = cnt > 0u ? cnt : 1u;
}
__device__ __forceinline__ void xcd_barrier(const XcdBarrier& b) {
    asm volatile("s_waitcnt vmcnt(0)" ::: "memory");
    __syncthreads();
    if (threadIdx.x == 0) {
        unsigned* bar = b.bar;
        __builtin_amdgcn_s_waitcnt(0);
        unsigned nloc = b.st[0], nx = b.st[1];
        if (nloc == 0u) { xcd_barrier_complete(bar, b.x, nloc, nx); b.st[0] = nloc; b.st[1] = nx; }
        const unsigned old = xb_add(&bar[XB_XSUB(b.x)], 1u);
        const unsigned gen = old / nloc;
        if (old + 1u == (gen + 1u) * nloc) {
            __builtin_amdgcn_fence(__ATOMIC_RELEASE, "agent");
            asm volatile("s_waitcnt vmcnt(0)" ::: "memory");
            const unsigned og = xb_add(&bar[XB_TOP], 1u);
            const unsigned tg = og / nx;
            if (og + 1u == (tg + 1u) * nx) xb_add(&bar[XB_TOPGEN], 1u);
            else XB_SPIN(xb_ld(&bar[XB_TOPGEN]) == tg, bar);
            __builtin_amdgcn_fence(__ATOMIC_ACQUIRE, "agent");
            xb_add(&bar[XB_XGEN(b.x)], 1u);
            asm volatile("s_waitcnt vmcnt(0)" ::: "memory");
        } else {
            XB_SPIN(xb_ld(&bar[XB_XGEN(b.x)]) == gen, bar);
            __builtin_amdgcn_fence(__ATOMIC_ACQUIRE, "agent");
            asm volatile("s_waitcnt vmcnt(0)" ::: "memory");
        }
    }
    __syncthreads();
}

struct Args {
    const float *x_p, *x_s, *c_p, *c_s, *cache_k, *cache_v, *cache_kidx, *state_gdn, *state_conv; const int* page_table;
    const float *w_ada, *b_ada, *pre_g, *w_in, *conv_w, *a_log, *dt_bias, *gdn_g, *w_pa, *w_pb, *w_out, *post_g;
    float* out; unsigned char* ws; int ph_lo, ph_hi;
};
static_assert(sizeof(Args) == 24 * 8 + 8, "Args has no padding");
template <int OFF> __device__ __forceinline__ const void* karg_ptr() {
    unsigned long long v; const unsigned long long kp = (unsigned long long)__builtin_amdgcn_kernarg_segment_ptr();
    asm volatile("s_load_dwordx2 %0, %1, %2\n\ts_waitcnt lgkmcnt(0)" : "=s"(v) : "s"(kp), "n"(OFF));
    return (const void*)(const __attribute__((address_space(1))) void*)v;
}
#define KARG(A, f) (A).f = (decltype((A).f))karg_ptr<(int)__builtin_offsetof(Args, f)>()
__device__ __forceinline__ Args load_args(int lo, int hi) {
    Args A;
    KARG(A, x_p); KARG(A, x_s); KARG(A, c_p); KARG(A, c_s); KARG(A, cache_k); KARG(A, cache_v); KARG(A, cache_kidx); KARG(A, state_gdn); KARG(A, state_conv); KARG(A, page_table);
    KARG(A, w_ada); KARG(A, b_ada); KARG(A, pre_g); KARG(A, w_in); KARG(A, conv_w); KARG(A, a_log); KARG(A, dt_bias); KARG(A, gdn_g); KARG(A, w_pa); KARG(A, w_pb); KARG(A, w_out); KARG(A, post_g);
    KARG(A, out); KARG(A, ws); A.ph_lo = lo; A.ph_hi = hi;
    return A;
}


__device__ __forceinline__ void transpose_item(const float* W, int Nsrc, int K, bf16* WT, int n0, int k0, bool remap, LAS float* scr, int lane) {
    const int nl = lane & 31, nd = n0 + nl, sc = remap ? win_src_col(nd) : nd;
#pragma unroll 8
    for (int i = 0; i < 32; ++i) { const int kk = 2 * i + (lane >> 5); const float vl = W[(size_t)(k0 + kk) * Nsrc + (sc >= 0 ? sc : 0)]; scr[kk * 33 + nl] = sc >= 0 ? vl : 0.f; }
    LDS_WAIT(); asm volatile("" ::: "memory");
    const int c = lane & 7;
#pragma unroll
    for (int j = 0; j < 4; ++j) { const int n = (lane >> 3) + 8 * j; const LAS float* s = scr + (8 * c) * 33 + n;
        v4u o; o.x = pk2(s[0 * 33], s[1 * 33]); o.y = pk2(s[2 * 33], s[3 * 33]); o.z = pk2(s[4 * 33], s[5 * 33]); o.w = pk2(s[6 * 33], s[7 * 33]);
        *(GAS v4u*)(WT + (size_t)(n0 + n) * K + k0 + 8 * c) = o; }
    LDS_WAIT(); asm volatile("" ::: "memory");
}
__device__ __forceinline__ void win_tr_load(const float* W, int n0, int k0, float (&v)[32], int lane) {
    const int sc = win_src_col(n0 + (lane & 31)); const float* p = W + (size_t)(k0 + (lane >> 5)) * NIN + (sc >= 0 ? sc : 0);
#pragma unroll
    for (int i = 0; i < 32; ++i) v[i] = __builtin_nontemporal_load(p + (size_t)(2 * i) * NIN);
}
__device__ __forceinline__ void win_tr_store(const float (&v)[32], bf16* WT, int n0, int k0, LAS float* scr, int lane) {
    const int nl = lane & 31; const bool ok = win_src_col(n0 + nl) >= 0;
#pragma unroll
    for (int i = 0; i < 32; ++i) scr[(2 * i + (lane >> 5)) * 33 + nl] = ok ? v[i] : 0.f;
    LDS_WAIT(); asm volatile("" ::: "memory");
    const int c = lane & 7;
#pragma unroll
    for (int j = 0; j < 4; ++j) { const int n = (lane >> 3) + 8 * j; const LAS float* s = scr + (8 * c) * 33 + n;
        v4u o; o.x = pk2(s[0 * 33], s[1 * 33]); o.y = pk2(s[2 * 33], s[3 * 33]); o.z = pk2(s[4 * 33], s[5 * 33]); o.w = pk2(s[6 * 33], s[7 * 33]);
        *(GAS v4u*)(WT + (size_t)(n0 + n) * D + k0 + 8 * c) = o; }
    LDS_WAIT(); asm volatile("" ::: "memory");
}
__device__ __forceinline__ void mod_item(const Args& a, float* mod, int item, LAS float* scr, int lane) {
    const int kc = item / 96, cg = item % 96, col = cg * 64 + lane;
    float acc[36];
#pragma unroll
    for (int r = 0; r < 36; ++r) acc[r] = 0.f;
    {
        const int kb = kc * 64;
#pragma unroll 4
        for (int r = 0; r < 36; ++r) { const float cv = (r < 4) ? a.c_p[r * D + kb + lane] : a.c_s[(r - 4) * D + kb + lane]; scr[r * 64 + lane] = cv * __builtin_amdgcn_rcpf(1.0f + __expf(-cv)); }
        LDS_WAIT(); asm volatile("" ::: "memory");
        for (int k4 = 0; k4 < 16; ++k4) {
            const float* wp = a.w_ada + (size_t)(kb + 4 * k4) * 6144 + col;
            const float w0 = wp[0], w1 = wp[6144], w2 = wp[2 * 6144], w3 = wp[3 * 6144];
#pragma unroll
            for (int r = 0; r < 36; ++r) { const f32x4 s = *(const LAS f32x4*)(scr + r * 64 + 4 * k4); acc[r] += s[0] * w0 + s[1] * w1 + s[2] * w2 + s[3] * w3; }
        }
        LDS_WAIT(); asm volatile("" ::: "memory");
    }
#pragma unroll
    for (int r = 0; r < 36; ++r) unsafeAtomicAdd(mod + r * 6144 + col, acc[r]);
}

__device__ __forceinline__ unsigned off_b(unsigned row, unsigned ch) { return 256u * row + 16u * (ch ^ (((row & 3) << 2) | ((row >> 2) & 3))); }
__device__ __forceinline__ unsigned tr_read_addr_16(unsigned lane, unsigned c, unsigned t) { const unsigned g = lane >> 4, q = (lane & 15) >> 2, p = lane & 3; return off_b(8 * g + 4 * t + q, 2 * c + (p >> 1)) + 8 * (p & 1); }
__device__ __forceinline__ s16x4 vtr(const LAS unsigned char* p) { return __builtin_bit_cast(s16x4, __builtin_amdgcn_ds_read_tr16_b64_v4i16((LAS s16x4*)p)); }
constexpr int NITEM_P = BP * HV * 32, NITEM_S = BS * HV, NITEM = NITEM_P + NITEM_S;
constexpr int GA_T1 = 0, GA_T2 = 8704, GA_GV = 17408, GA_BV = GA_GV + 256, GA_RK = GA_BV + 256, GA_RQ = GA_RK + 256, GA_WAVE_BYTES = GA_RQ + 256;
constexpr int SC_KI = 0, SC_QF = 16, SC_MF = 32, SC_GF = 40, SC_GF2 = 41, SC_TF = 42, SC_NROW = 50, SC_BUF_BYTES = SC_NROW * 1024, SC_SSQ = 2 * SC_BUF_BYTES, SC_GBASE = 32, SC_GROWS = 18;
__host__ __device__ __forceinline__ int sigma_dk(int t, int r) { return 32 * (t >> 1) + 8 * (r >> 2) + 4 * (t & 1) + (r & 3); }
struct GItem { const bf16 *KN, *QN, *KT, *VT; int Lt, grow, nvalid, id; };
__device__ __forceinline__ GItem gitem_of(const Args& a, int item) {
    GItem I;
    if (item < NITEM_P) { const int c = item & 31, hv = (item >> 5) & 31, b = item >> 10, hq = hv >> 1;
        I.KN = (const bf16*)(a.ws + WS_KNP) + ((size_t)(b * HQK + hq) * LP + 64 * c) * 128; I.QN = (const bf16*)(a.ws + WS_QNP) + ((size_t)(b * HQK + hq) * LP + 64 * c) * 128;
        I.KT = (const bf16*)(a.ws + WS_KTP) + (size_t)(b * HQK + hq) * 128 * LP + 64 * c; I.VT = (const bf16*)(a.ws + WS_VTP) + (size_t)(b * HV + hv) * 128 * LP + 64 * c;
        I.Lt = LP; I.grow = b * LP + 64 * c; I.nvalid = 64; I.id = item; }
    else { const int r = item - NITEM_P, hv = r & 31, b = r >> 5, hq = hv >> 1;
        I.KN = (const bf16*)(a.ws + WS_KNS) + (size_t)(b * HQK + hq) * 64 * 128; I.QN = (const bf16*)(a.ws + WS_QNS) + (size_t)(b * HQK + hq) * 64 * 128;
        I.KT = (const bf16*)(a.ws + WS_KTS) + (size_t)(b * HQK + hq) * 128 * 64; I.VT = (const bf16*)(a.ws + WS_VTS) + (size_t)(b * HV + hv) * 128 * 64;
        I.Lt = 64; I.grow = MP + b * LS; I.nvalid = LS; I.id = item; }
    return I;
}
__device__ __forceinline__ void prep_item(const Args& a, int item, int lane) {
    asm volatile("" : "+v"(lane));
    const bf16* QKV = (const bf16*)(a.ws + WS_QKV);
    const bool sample = item >= BP * 32 * 64;
    int slot, tc, b;
    if (!sample) { slot = item & 63; tc = (item >> 6) & 31; b = item >> 11; } else { const int r = item - BP * 32 * 64; slot = r & 63; tc = 0; b = r >> 6; }
    const int mode = slot < 16 ? 0 : (slot < 32 ? 1 : 2), hd = mode == 0 ? slot : (mode == 1 ? slot - 16 : slot - 32);
    const int ch = (mode == 0 ? 0 : (mode == 1 ? 2048 : 4096)) + hd * 128 + 2 * lane, t0 = tc * 64;
    const int Lt = sample ? 64 : LP, nreal = sample ? LS : 64;
    const size_t rowbase = sample ? (size_t)MP + b * LS : (size_t)b * LP + t0;
    bf16* drow = nullptr; bf16* dtr = nullptr;
    if (mode == 0) drow = (bf16*)(a.ws + (sample ? WS_QNS : WS_QNP)) + ((size_t)(b * HQK + hd) * Lt + t0) * 128;
    else if (mode == 1) drow = (bf16*)(a.ws + (sample ? WS_KNS : WS_KNP)) + ((size_t)(b * HQK + hd) * Lt + t0) * 128;
    else dtr = (bf16*)(a.ws + (sample ? WS_VTS : WS_VTP)) + ((size_t)(b * HV + hd) * 128 + 2 * lane) * Lt + t0;
    const int rpos = 2 * lane;
    float w0[4], w1[4];
#pragma unroll
    for (int i = 0; i < 4; ++i) { w0[i] = a.conv_w[i * CONVCH + ch]; w1[i] = a.conv_w[i * CONVCH + ch + 1]; }
    float xa[3][2];
#pragma unroll
    for (int i = 0; i < 3; ++i) {
        if (sample) { xa[i][0] = a.state_conv[((size_t)b * 3 + i) * CONVCH + ch]; xa[i][1] = a.state_conv[((size_t)b * 3 + i) * CONVCH + ch + 1]; }
        else { const int t = t0 - 3 + i; unsigned u = *(const unsigned*)(QKV + ((size_t)b * LP + (t >= 0 ? t : 0)) * CONVCH + ch); if (t < 0) u = 0u; xa[i][0] = pg8::bf_lo(u); xa[i][1] = pg8::bf_hi(u); }
    }
    unsigned uall[64];
#pragma unroll
    for (int e = 0; e < 64; ++e) { const unsigned ul = *(const unsigned*)(QKV + (rowbase + (e < nreal ? e : nreal - 1)) * CONVCH + ch); uall[e] = e < nreal ? ul : 0u; }
#pragma unroll
    for (int t8 = 0; t8 < 8; ++t8) {
        float y0[8], y1[8];
        if (8 * t8 < nreal) {
#pragma unroll
            for (int e = 0; e < 8; ++e) {
                const float x0 = pg8::bf_lo(uall[8 * t8 + e]), x1 = pg8::bf_hi(uall[8 * t8 + e]);
                float v0 = w0[0] * xa[0][0] + w0[1] * xa[1][0] + w0[2] * xa[2][0] + w0[3] * x0;
                float v1 = w1[0] * xa[0][1] + w1[1] * xa[1][1] + w1[2] * xa[2][1] + w1[3] * x1;
                xa[0][0] = xa[1][0]; xa[0][1] = xa[1][1]; xa[1][0] = xa[2][0]; xa[1][1] = xa[2][1]; xa[2][0] = x0; xa[2][1] = x1;
                v0 = v0 * __builtin_amdgcn_rcpf(1.0f + __expf(-v0)); v1 = v1 * __builtin_amdgcn_rcpf(1.0f + __expf(-v1));
                y0[e] = v0; y1[e] = v1;
            }
        } else {
#pragma unroll
            for (int e = 0; e < 8; ++e) { y0[e] = 0.f; y1[e] = 0.f; }
        }
        if (drow) {
#pragma unroll
            for (int e = 0; e < 8; ++e) *(unsigned*)(drow + (size_t)(8 * t8 + e) * 128 + rpos) = pk2(y0[e], y1[e]);
        }
        if (dtr) {
            v4u p0, p1; p0.x = pk2(y0[0], y0[1]); p0.y = pk2(y0[2], y0[3]); p0.z = pk2(y0[4], y0[5]); p0.w = pk2(y0[6], y0[7]);
            p1.x = pk2(y1[0], y1[1]); p1.y = pk2(y1[2], y1[3]); p1.z = pk2(y1[4], y1[5]); p1.w = pk2(y1[6], y1[7]);
            *(v4u*)(dtr + 8 * t8) = p0; *(v4u*)(dtr + Lt + 8 * t8) = p1;
        }
    }
}
template <int I> __device__ __forceinline__ void subst_row(float (&t)[64], const LAS float* Am, int lane) {
    if constexpr (I < 64) {
        float acc[4] = {(lane == I) ? 1.f : 0.f, 0.f, 0.f, 0.f};
#pragma unroll
        for (int j4 = 0; j4 < (I + 3) / 4; ++j4) { const f32x4 a4 = *(const LAS f32x4*)(Am + I * 68 + 4 * j4);
#pragma unroll
            for (int e = 0; e < 4; ++e) if (4 * j4 + e < I) acc[e] -= a4[e] * t[4 * j4 + e]; }
        t[I] = (acc[0] + acc[1]) + (acc[2] + acc[3]);
        if constexpr ((I & 7) == 7) __builtin_amdgcn_sched_barrier(0);
        subst_row<I + 1>(t, Am, lane);
    }
}
__device__ __forceinline__ bf16x8 ld_2x8(const bf16* p0, const bf16* p1) { const v2u a = *(const v2u*)p0, b = *(const v2u*)p1; const v4u w = {a.x, a.y, b.x, b.y}; return __builtin_bit_cast(bf16x8, w); }
__device__ __forceinline__ bf16x8 lds_2x8(const LAS bf16* p0, const LAS bf16* p1) { const v2u a = *(const LAS v2u*)p0, b = *(const LAS v2u*)p1; const v4u w = {a.x, a.y, b.x, b.y}; return __builtin_bit_cast(bf16x8, w); }
__device__ __forceinline__ void gdnA_item(const Args& a, LAS unsigned char* wl, int item, int lane) {
    asm volatile("" : "+v"(lane));
    const GItem I = gitem_of(a, item);
    const int m = lane & 15, g = lane >> 4;
    LAS float* Am = (LAS float*)(wl + GA_T1); LAS bf16* T1 = (LAS bf16*)(wl + GA_T1); LAS bf16* T2 = (LAS bf16*)(wl + GA_T2);
    LAS float* GV = (LAS float*)(wl + GA_GV); LAS float* BV = (LAS float*)(wl + GA_BV); LAS float* RK = (LAS float*)(wl + GA_RK); LAS float* RQ = (LAS float*)(wl + GA_RQ);
    float bl = 0.f, G = 0.f;
    {
        const int hvx = (item < NITEM_P) ? ((item >> 5) & 31) : ((item - NITEM_P) & 31), lr = lane < I.nvalid ? lane : I.nvalid - 1;
        const float blv = ((const float*)(a.ws + WS_BETA))[(size_t)(I.grow + lr) * 32 + hvx], gv = ((const float*)(a.ws + WS_GG))[(size_t)(I.grow + lr) * 32 + hvx];
        if (lane < I.nvalid) { bl = blv; G = gv; }
    }
#pragma unroll
    for (int o = 1; o < 64; o <<= 1) { const float t = __shfl_up(G, o); if (lane >= o) G += t; }
    const float Glast = __shfl(G, 63);
    GV[lane] = G; BV[lane] = bl;
    v4u* FR = (v4u*)(a.ws + WS_FR) + (size_t)I.id * SC_GROWS * 64;
    bf16x8 kf[4][4], qf[4][4];
#pragma unroll
    for (int t = 0; t < 4; ++t)
#pragma unroll
        for (int s = 0; s < 4; ++s) kf[t][s] = *(const bf16x8*)(I.KN + (size_t)(16 * t + m) * 128 + 32 * s + 8 * g);
#pragma unroll
    for (int t = 0; t < 4; ++t)
#pragma unroll
        for (int s = 0; s < 4; ++s) qf[t][s] = *(const bf16x8*)(I.QN + (size_t)(16 * t + m) * 128 + 32 * s + 8 * g);
    f32x4 kd[4];
#pragma unroll
    for (int it = 0; it < 4; ++it) {
        f32x4 aq = {0.f, 0.f, 0.f, 0.f}; kd[it] = (f32x4){0.f, 0.f, 0.f, 0.f};
#pragma unroll
        for (int s = 0; s < 4; ++s) { kd[it] = __builtin_amdgcn_mfma_f32_16x16x32_bf16(kf[it][s], kf[it][s], kd[it], 0, 0, 0); aq = __builtin_amdgcn_mfma_f32_16x16x32_bf16(qf[it][s], qf[it][s], aq, 0, 0, 0); }
        if (g == (m >> 2)) { const int e = m & 3; const float dk2 = e == 0 ? kd[it][0] : (e == 1 ? kd[it][1] : (e == 2 ? kd[it][2] : kd[it][3])), dq2 = e == 0 ? aq[0] : (e == 1 ? aq[1] : (e == 2 ? aq[2] : aq[3]));
            RK[16 * it + m] = rsqrtf(dk2 + L2_EPS); RQ[16 * it + m] = rsqrtf(dq2 + L2_EPS) * 0.08838834764831845f; }
    }
    const float rkl = RK[lane], rql = RQ[lane];
    { float* GF = (float*)(FR + (SC_GF - SC_GBASE) * 64); GF[lane] = __expf(G) * rql; if (lane < 32) GF[64 + lane] = __expf(Glast); GF[128 + lane] = __expf(Glast - G) * rkl;
      GF[256 + lane] = bl; GF[256 + 64 + lane] = __expf(G) * rkl; }
#pragma unroll
    for (int it = 0; it < 4; ++it) {
        const f32x4 gi = *(const LAS f32x4*)(GV + 16 * it + 4 * g), bi = *(const LAS f32x4*)(BV + 16 * it + 4 * g) * *(const LAS f32x4*)(RK + 16 * it + 4 * g);
#pragma unroll
        for (int jt = 0; jt <= it; ++jt) {
            f32x4 acc = kd[it];
            if (jt < it) { acc = (f32x4){0.f, 0.f, 0.f, 0.f};
#pragma unroll
                for (int s = 0; s < 4; ++s) acc = __builtin_amdgcn_mfma_f32_16x16x32_bf16(kf[it][s], kf[jt][s], acc, 0, 0, 0); }
            const float gj = GV[16 * jt + m], rj = RK[16 * jt + m];
#pragma unroll
            for (int e = 0; e < 4; ++e) { const int i = 16 * it + 4 * g + e, j = 16 * jt + m; Am[i * 68 + j] = (i > j) ? bi[e] * rj * acc[e] * __expf(gi[e] - gj) : 0.f; }
        }
    }
    {
        v4u* MF = FR + (SC_MF - SC_GBASE) * 64;
#pragma unroll
        for (int it = 0; it < 4; ++it) {
            const float gi = GV[16 * it + m], rqi = RQ[16 * it + m];
            f32x4 mt[4];
#pragma unroll
            for (int jt = 0; jt < 4; ++jt) {
                mt[jt] = (f32x4){0.f, 0.f, 0.f, 0.f};
                if (jt <= it) {
                    f32x4 acc = {0.f, 0.f, 0.f, 0.f};
#pragma unroll
                    for (int s = 0; s < 4; ++s) acc = __builtin_amdgcn_mfma_f32_16x16x32_bf16(kf[jt][s], qf[it][s], acc, 0, 0, 0);
                    const f32x4 gj = *(const LAS f32x4*)(GV + 16 * jt + 4 * g), rj = *(const LAS f32x4*)(RK + 16 * jt + 4 * g);
#pragma unroll
                    for (int e = 0; e < 4; ++e) { const int i = 16 * it + m, j = 16 * jt + 4 * g + e; mt[jt][e] = (i >= j) ? acc[e] * rqi * rj[e] * __expf(gi - gj[e]) : 0.f; }
                }
            }
#pragma unroll
            for (int s = 0; s < 2; ++s) { v4u w; w.x = pk2(mt[2 * s][0], mt[2 * s][1]); w.y = pk2(mt[2 * s][2], mt[2 * s][3]); w.z = pk2(mt[2 * s + 1][0], mt[2 * s + 1][1]); w.w = pk2(mt[2 * s + 1][2], mt[2 * s + 1][3]);
                MF[(it * 2 + s) * 64 + lane] = w; }
        }
    }
    asm volatile("" ::: "memory");
    float t[64];
    subst_row<0>(t, Am, lane);
#pragma unroll
    for (int i = 0; i < 64; ++i) T1[i * 68 + lane] = f2bf(t[i]);
    asm volatile("" ::: "memory");
#pragma unroll
    for (int it = 0; it < 4; ++it)
#pragma unroll
        for (int s2 = 0; s2 < 2; ++s2)
            FR[(SC_TF - SC_GBASE + it * 2 + s2) * 64 + lane] = __builtin_bit_cast(v4u, lds_2x8(T1 + (16 * it + m) * 68 + 32 * s2 + 4 * g, T1 + (16 * it + m) * 68 + 32 * s2 + 16 + 4 * g));
}
__device__ __forceinline__ void scan_stage_dma(const Args& a, int id, const bf16* qrows, const bf16* krows, LAS unsigned char* buf, int wave, int lane) {
    const v4u* src = (const v4u*)(a.ws + WS_FR) + (size_t)id * SC_GROWS * 64 + lane;
    const bf16* qsrc = qrows + (size_t)(lane & 15) * 128 + 8 * (lane >> 4);
#pragma unroll
    for (int k = 0; k < 8; ++k) { const int r = wave + 8 * k;
        if (r < SC_QF) { const int j = 4 * r + (lane >> 4), slot = lane & 15, ch = slot ^ (((j & 3) << 2) | ((j >> 2) & 3));
            __builtin_amdgcn_global_load_lds((const unsigned*)(krows + (size_t)j * 128 + 8 * ch), (LAS unsigned*)(buf + r * 1024), 16, 0, 0); }
        else if (r < SC_MF) { const int fq = r - SC_QF; __builtin_amdgcn_global_load_lds((const unsigned*)(qsrc + (size_t)(16 * (fq >> 2)) * 128 + 32 * (fq & 3)), (LAS unsigned*)(buf + r * 1024), 16, 0, 0); }
        else if (r < SC_NROW) __builtin_amdgcn_global_load_lds((const unsigned*)(src + (r - SC_GBASE) * 64), (LAS unsigned*)(buf + r * 1024), 16, 0, 0); }
}
__device__ __forceinline__ void scan_chunk(const LAS unsigned char* buf, f32x4 (&S)[8], const v4u (&vb)[2], f32x4 (&O)[4], int lane) {
    const LAS v4u* F = (const LAS v4u*)buf + lane; const LAS float* GFl = (const LAS float*)(buf + SC_GF * 1024);
    const int m = lane & 15, g = lane >> 4, g4 = 4 * g;
    bf16x8 Sb[4];
#pragma unroll
    for (int sp = 0; sp < 4; ++sp) { v4u w; w.x = pk2(S[2 * sp][0], S[2 * sp][1]); w.y = pk2(S[2 * sp][2], S[2 * sp][3]); w.z = pk2(S[2 * sp + 1][0], S[2 * sp + 1][1]); w.w = pk2(S[2 * sp + 1][2], S[2 * sp + 1][3]); Sb[sp] = __builtin_bit_cast(bf16x8, w); }
    f32x4 KS[4];
#pragma unroll
    for (int jt = 0; jt < 4; ++jt) {
        f32x4 ks = {0.f, 0.f, 0.f, 0.f}, qs = {0.f, 0.f, 0.f, 0.f};
#pragma unroll
        for (int sp = 0; sp < 4; ++sp) {
            ks = __builtin_amdgcn_mfma_f32_16x16x32_bf16(*(const LAS bf16x8*)(buf + off_b(16 * jt + m, 4 * sp + g)), Sb[sp], ks, 0, 0, 0);
            qs = __builtin_amdgcn_mfma_f32_16x16x32_bf16(__builtin_bit_cast(bf16x8, F[(SC_QF + jt * 4 + sp) * 64]), Sb[sp], qs, 0, 0, 0);
        }
        KS[jt] = ks; O[jt] = qs * *(const LAS f32x4*)(GFl + 16 * jt + g4);
        __builtin_amdgcn_sched_barrier(0);
    }
    const LAS float* GF2 = (const LAS float*)(buf + SC_GF2 * 1024);
    bf16x8 Rb[2];
#pragma unroll
    for (int s = 0; s < 2; ++s) {
        const f32x4 b0 = *(const LAS f32x4*)(GF2 + 32 * s + g4), b1 = *(const LAS f32x4*)(GF2 + 32 * s + 16 + g4), a0 = *(const LAS f32x4*)(GF2 + 64 + 32 * s + g4), a1 = *(const LAS f32x4*)(GF2 + 64 + 32 * s + 16 + g4);
        const f32x4 v0 = {pg8::bf_lo(vb[s].x), pg8::bf_hi(vb[s].x), pg8::bf_lo(vb[s].y), pg8::bf_hi(vb[s].y)}, v1 = {pg8::bf_lo(vb[s].z), pg8::bf_hi(vb[s].z), pg8::bf_lo(vb[s].w), pg8::bf_hi(vb[s].w)};
        const f32x4 r0 = b0 * (v0 - a0 * KS[2 * s]), r1 = b1 * (v1 - a1 * KS[2 * s + 1]);
        v4u w; w.x = pk2(r0[0], r0[1]); w.y = pk2(r0[2], r0[3]); w.z = pk2(r1[0], r1[1]); w.w = pk2(r1[2], r1[3]); Rb[s] = __builtin_bit_cast(bf16x8, w);
    }
    f32x4 U[4];
#pragma unroll
    for (int it = 0; it < 4; ++it) {
        f32x4 u = {0.f, 0.f, 0.f, 0.f};
#pragma unroll
        for (int s2 = 0; s2 < 2; ++s2) u = __builtin_amdgcn_mfma_f32_16x16x32_bf16(__builtin_bit_cast(bf16x8, F[(SC_TF + it * 2 + s2) * 64]), Rb[s2], u, 0, 0, 0);
        U[it] = u;
    }
    bf16x8 Ub[2], Uc[2];
#pragma unroll
    for (int s = 0; s < 2; ++s) {
        v4u w; w.x = pk2(U[2 * s][0], U[2 * s][1]); w.y = pk2(U[2 * s][2], U[2 * s][3]); w.z = pk2(U[2 * s + 1][0], U[2 * s + 1][1]); w.w = pk2(U[2 * s + 1][2], U[2 * s + 1][3]); Ub[s] = __builtin_bit_cast(bf16x8, w);
        const f32x4 c0 = *(const LAS f32x4*)(GFl + 128 + 32 * s + g4), c1 = *(const LAS f32x4*)(GFl + 128 + 32 * s + 16 + g4), a0 = U[2 * s] * c0, a1 = U[2 * s + 1] * c1;
        v4u x; x.x = pk2(a0[0], a0[1]); x.y = pk2(a0[2], a0[3]); x.z = pk2(a1[0], a1[1]); x.w = pk2(a1[2], a1[3]); Uc[s] = __builtin_bit_cast(bf16x8, x);
    }
#pragma unroll
    for (int it = 0; it < 4; ++it)
#pragma unroll
        for (int s = 0; s < 2; ++s) O[it] = __builtin_amdgcn_mfma_f32_16x16x32_bf16(__builtin_bit_cast(bf16x8, F[(SC_MF + it * 2 + s) * 64]), Ub[s], O[it], 0, 0, 0);
    const float gam = GFl[64];
    const int q4 = (lane & 15) >> 2, p4 = lane & 3;
#pragma unroll
    for (int t = 0; t < 8; ++t) {
        S[t] = S[t] * gam;
#pragma unroll
        for (int s = 0; s < 2; ++s) {
            const s16x4 v0 = vtr(buf + off_b(32 * s + 4 * g + q4, 4 * (t >> 1) + p4) + 8 * (t & 1)), v1 = vtr(buf + off_b(32 * s + 16 + 4 * g + q4, 4 * (t >> 1) + p4) + 8 * (t & 1));
            const bf16x8 kt = (bf16x8){v0[0], v0[1], v0[2], v0[3], v1[0], v1[1], v1[2], v1[3]};
            S[t] = __builtin_amdgcn_mfma_f32_16x16x32_bf16(kt, Uc[s], S[t], 0, 0, 0);
        }
    }
}
__device__ __forceinline__ void scan_norm_partial(LAS float* ssq, const f32x4 (&O)[4], int wave, int lane) {
    const int m = lane & 15, g = lane >> 4;
#pragma unroll
    for (int it = 0; it < 4; ++it) {
        f32x4 q = O[it] * O[it];
        q[0] = row16_sum(q[0]); q[1] = row16_sum(q[1]); q[2] = row16_sum(q[2]); q[3] = row16_sum(q[3]);
        if (m == 0) *(LAS f32x4*)(ssq + wave * 64 + 16 * it + 4 * g) = q;
    }
}
__device__ __forceinline__ void scan_norm_finish(const Args& a, const LAS float* ssq, const f32x4 (&O)[4], const unsigned (&zq)[8], int hv, size_t yrow0, int nrows, int wave, int lane) {
    const int m = lane & 15, g = lane >> 4, odd = lane & 1;
    bf16* YA = (bf16*)(a.ws + WS_YA);
    const float gn = a.gdn_g[16 * wave + m];
#pragma unroll
    for (int it = 0; it < 4; ++it) {
        f32x4 tot = {0.f, 0.f, 0.f, 0.f};
#pragma unroll
        for (int w = 0; w < NWAVES; ++w) tot += *(const LAS f32x4*)(ssq + w * 64 + 16 * it + 4 * g);
#pragma unroll
        for (int pp = 0; pp < 2; ++pp) {
            const unsigned own = zq[it * 2 + pp], nbr = dpp_swap1(own);
            const float r0 = odd ? pg8::bf_hi(nbr) : pg8::bf_lo(own), r1 = odd ? pg8::bf_hi(own) : pg8::bf_lo(nbr);
            const float z0 = pg8::fsilu(r0), z1 = pg8::fsilu(r1);
            const float y0 = O[it][2 * pp] * rsqrtf(tot[2 * pp] * (1.0f / 128.0f) + NORM_EPS) * gn * z0, y1 = O[it][2 * pp + 1] * rsqrtf(tot[2 * pp + 1] * (1.0f / 128.0f) + NORM_EPS) * gn * z1;
            const float r = __builtin_bit_cast(float, dpp_swap1(__builtin_bit_cast(unsigned, odd ? y0 : y1)));
            const unsigned word = odd ? pk2(r, y1) : pk2(y0, r);
            const int row = 16 * it + 4 * g + 2 * pp + odd;
            if (row < nrows) *(unsigned*)(YA + (size_t)(hv >> 4) * MROWS * 2048 + (yrow0 + row) * 2048 + (hv & 15) * 128 + 16 * wave + m - odd) = word;
        }
    }
}
#define SCAN_BAR() do { asm volatile("s_waitcnt vmcnt(0) lgkmcnt(0)" ::: "memory"); __builtin_amdgcn_s_barrier(); asm volatile("" ::: "memory"); } while (0)
__device__ __forceinline__ void scan_prompt_unit(const Args& a, LAS unsigned char* lds, int unit) {
    const int tid = threadIdx.x; int lane = tid & 63; asm volatile("" : "+v"(lane)); const int wave = __builtin_amdgcn_readfirstlane(tid >> 6), m = lane & 15, g = lane >> 4;
    const int hv = unit & 31, b = unit >> 5;
    const bf16* Z = (const bf16*)(a.ws + WS_Z);
    LAS float* ssq = (LAS float*)(lds + SC_SSQ);
    f32x4 S[8];
#pragma unroll
    for (int d = 0; d < 8; ++d) S[d] = (f32x4){0.f, 0.f, 0.f, 0.f};
    const bf16* QN = (const bf16*)(a.ws + WS_QNP) + (size_t)(b * HQK + (hv >> 1)) * LP * 128; const bf16* KN = (const bf16*)(a.ws + WS_KNP) + (size_t)(b * HQK + (hv >> 1)) * LP * 128;
    scan_stage_dma(a, unit * 32, QN, KN, lds, wave, lane);
    scan_stage_dma(a, unit * 32 + 1, QN + (size_t)64 * 128, KN + (size_t)64 * 128, lds + SC_BUF_BYTES, wave, lane);
    const bf16* VTw = (const bf16*)(a.ws + WS_VTP) + ((size_t)unit * 128 + 16 * wave + m) * LP + 4 * g;
    v4u vbn[2];
#pragma unroll
    for (int s2 = 0; s2 < 2; ++s2) { const v2u p0 = *(const v2u*)(VTw + 32 * s2), p1 = *(const v2u*)(VTw + 32 * s2 + 16); vbn[s2] = (v4u){p0.x, p0.y, p1.x, p1.y}; }
    SCAN_BAR();
#pragma unroll 1
    for (int c = 0; c < 32; ++c) {
        const int id = unit * 32 + c;
        unsigned zq[8];
        const size_t yrow0 = (size_t)b * LP + 64 * c;
#pragma unroll
        for (int it = 0; it < 4; ++it)
#pragma unroll
            for (int e2 = 0; e2 < 2; ++e2) zq[it * 2 + e2] = *(const unsigned*)(Z + (yrow0 + 16 * it + 4 * g + 2 * e2 + (lane & 1)) * 4096 + hv * 128 + 16 * wave + m - (lane & 1));
        f32x4 O[4];
        scan_chunk(lds + (c & 1) * SC_BUF_BYTES, S, vbn, O, lane);
        if (c + 1 < 32) {
#pragma unroll
            for (int s2 = 0; s2 < 2; ++s2) { const v2u p0 = *(const v2u*)(VTw + 64 * (c + 1) + 32 * s2), p1 = *(const v2u*)(VTw + 64 * (c + 1) + 32 * s2 + 16); vbn[s2] = (v4u){p0.x, p0.y, p1.x, p1.y}; }
        }
        scan_norm_partial(ssq + (c & 1) * 512, O, wave, lane);
        SCAN_BAR();
        scan_norm_finish(a, ssq + (c & 1) * 512, O, zq, hv, yrow0, 64, wave, lane);
        if (c + 2 < 32) { int l2 = lane; asm volatile("" : "+v"(l2)); scan_stage_dma(a, id + 2, QN + (size_t)(64 * (c + 2)) * 128, KN + (size_t)(64 * (c + 2)) * 128, lds + (c & 1) * SC_BUF_BYTES, wave, l2); }
    }
    float* so = a.out + O_GP + (size_t)unit * DK * DV + 16 * wave + m;
#pragma unroll
    for (int d = 0; d < 8; ++d)
#pragma unroll
        for (int e = 0; e < 4; ++e) so[(size_t)sigma_dk(d, 4 * g + e) * DV] = S[d][e];
    SCAN_BAR();
}
__device__ __forceinline__ void scan_sample_unit(const Args& a, LAS unsigned char* lds, int unit) {
    const int tid = threadIdx.x; int lane = tid & 63; asm volatile("" : "+v"(lane)); const int wave = __builtin_amdgcn_readfirstlane(tid >> 6), m = lane & 15, g = lane >> 4;
    const int hv = unit & 31, b = unit >> 5, id = NITEM_P + unit;
    const bf16* Z = (const bf16*)(a.ws + WS_Z);
    LAS float* ssq = (LAS float*)(lds + SC_SSQ);
    scan_stage_dma(a, id, (const bf16*)(a.ws + WS_QNS) + (size_t)(b * HQK + (hv >> 1)) * 64 * 128, (const bf16*)(a.ws + WS_KNS) + (size_t)(b * HQK + (hv >> 1)) * 64 * 128, lds, wave, lane);
    f32x4 S[8];
    const float* s0 = a.state_gdn + (size_t)unit * DK * DV + 16 * wave + m;
#pragma unroll
    for (int d = 0; d < 8; ++d)
#pragma unroll
        for (int e = 0; e < 4; ++e) S[d][e] = s0[(size_t)sigma_dk(d, 4 * g + e) * DV];
    v4u vb[2];
    { const bf16* VTw = (const bf16*)(a.ws + WS_VTS) + ((size_t)unit * 128 + 16 * wave + m) * 64 + 4 * g;
#pragma unroll
      for (int s2 = 0; s2 < 2; ++s2) { const v2u p0 = *(const v2u*)(VTw + 32 * s2), p1 = *(const v2u*)(VTw + 32 * s2 + 16); vb[s2] = (v4u){p0.x, p0.y, p1.x, p1.y}; } }
    unsigned zq[8];
    const size_t yrow0 = (size_t)MP + b * LS;
#pragma unroll
    for (int e = 0; e < 8; ++e) zq[e] = 0u;
    if (g < 2) {
#pragma unroll
        for (int e2 = 0; e2 < 2; ++e2) zq[e2] = *(const unsigned*)(Z + (yrow0 + 4 * g + 2 * e2 + (lane & 1)) * 4096 + hv * 128 + 16 * wave + m - (lane & 1));
    }
    SCAN_BAR();
    f32x4 O[4];
    scan_chunk(lds, S, vb, O, lane);
    scan_norm_partial(ssq, O, wave, lane);
    SCAN_BAR();
    scan_norm_finish(a, ssq, O, zq, hv, yrow0, LS, wave, lane);
    float* so = a.out + O_GS + (size_t)unit * DK * DV + 16 * wave + m;
#pragma unroll
    for (int d = 0; d < 8; ++d)
#pragma unroll
        for (int e = 0; e < 4; ++e) so[(size_t)sigma_dk(d, 4 * g + e) * DV] = S[d][e];
    __syncthreads();
}

constexpr float IDX_SCALE = 0.08838834764831845f * 0.25f;
__device__ __forceinline__ void idx_reduce4(const f32x4 (&acc)[4], const f32x4 (&wv)[4], float (&v)[4]) {
#pragma unroll
    for (int qq = 0; qq < 4; ++qq) v[qq] = fmaxf(acc[qq][0], 0.f) * wv[qq][0] + fmaxf(acc[qq][1], 0.f) * wv[qq][1] + fmaxf(acc[qq][2], 0.f) * wv[qq][2] + fmaxf(acc[qq][3], 0.f) * wv[qq][3];
    float t[4];
#pragma unroll
    for (int qq = 0; qq < 4; ++qq) t[qq] = __shfl_xor(v[qq], 16);
#pragma unroll
    for (int qq = 0; qq < 4; ++qq) v[qq] += t[qq];
#pragma unroll
    for (int qq = 0; qq < 4; ++qq) t[qq] = __shfl_xor(v[qq], 32);
#pragma unroll
    for (int qq = 0; qq < 4; ++qq) v[qq] = (v[qq] + t[qq]) * IDX_SCALE;
}
__device__ __forceinline__ void idx_prompt_item(const Args& a, LAS unsigned char* wl, int b, int j, int hf, int lane) {
    const bf16* IQ = (const bf16*)(a.ws + WS_IQ); const bf16* IK = (const bf16*)(a.ws + WS_IK); const float* IW = (const float*)(a.ws + WS_IW); _Float16* SC = (_Float16*)(a.ws + WS_SC);
    const int m = lane & 15, g = lane >> 4, rq = b * LP + 4 * j;
    bf16x8 afr[4][4]; f32x4 wv[4];
#pragma unroll
    for (int qq = 0; qq < 4; ++qq) {
#pragma unroll
        for (int s = 0; s < 4; ++s) afr[qq][s] = *(const bf16x8*)(IQ + (size_t)(rq + qq) * 2048 + m * 128 + 32 * s + 8 * g);
        wv[qq] = *(const f32x4*)(IW + (size_t)(rq + qq) * 16 + 4 * g);
    }
    const int nkt = (4 * j + 3) / 16 + 1, k0 = hf ? nkt / 2 : 0, k1 = hf ? nkt : nkt / 2;
    if (k0 >= k1) return;
    const bf16* kb = IK + (size_t)(b * LP + g) * 128 + 8 * m;
    const int g0 = k0 >> 2, g1 = (k1 - 1) >> 2;
    v4u stg[16];
#pragma unroll
    for (int i = 0; i < 16; ++i) stg[i] = *(const v4u*)(kb + (size_t)(64 * g0 + 4 * i) * 128);
#pragma unroll 1
    for (int gi = g0; gi <= g1; ++gi) {
#pragma unroll
        for (int i = 0; i < 16; ++i) *(LAS v4u*)(wl + off_b(4 * i + g, m)) = stg[i];
        const int gn = gi < g1 ? gi + 1 : gi;
#pragma unroll
        for (int i = 0; i < 16; ++i) stg[i] = *(const v4u*)(kb + (size_t)(64 * gn + 4 * i) * 128);
#pragma unroll
        for (int u = 0; u < 4; ++u) {
            const int kt = 4 * gi + u;
            if (kt >= k0 && kt < k1) {
                f32x4 acc[4]; float v[4];
                bf16x8 bf[4];
#pragma unroll
                for (int s = 0; s < 4; ++s) bf[s] = *(const LAS bf16x8*)(wl + off_b(16 * u + m, 4 * s + g));
#pragma unroll
                for (int qq = 0; qq < 4; ++qq) { acc[qq] = (f32x4){0.f, 0.f, 0.f, 0.f};
#pragma unroll
                    for (int s = 0; s < 4; ++s) acc[qq] = __builtin_amdgcn_mfma_f32_16x16x32_bf16(afr[qq][s], bf[s], acc[qq], 0, 0, 0); }
                idx_reduce4(acc, wv, v);
                const int key = 16 * kt + m;
#pragma unroll
                for (int qq = 0; qq < 4; ++qq) { if (key > 4 * j + qq) v[qq] = -__builtin_inff(); if (g == 0) SC[(size_t)(rq + qq) * 2048 + key] = (_Float16)v[qq]; }
            }
        }
    }
}
__device__ __forceinline__ void idx_sample_item(const Args& a, int b, int p, int lane) {
    const bf16* IQ = (const bf16*)(a.ws + WS_IQ); const bf16* IK = (const bf16*)(a.ws + WS_IK); const float* IW = (const float*)(a.ws + WS_IW); float* SCS = (float*)(a.ws + WS_SCS);
    const int m = lane & 15, g = lane >> 4;
    if (p < NPAGES) {
        const float* kr = a.cache_kidx + (size_t)a.page_table[b * NPAGES + p] * PAGE * 128 + (size_t)m * 128 + 8 * g;
#pragma unroll 1
        for (int qh = 0; qh < 2; ++qh) {
            const int rq = MP + b * LS + qh * 4;
            bf16x8 afr[4][4]; f32x4 wv[4];
#pragma unroll
            for (int qq = 0; qq < 4; ++qq) {
#pragma unroll
                for (int s = 0; s < 4; ++s) afr[qq][s] = *(const bf16x8*)(IQ + (size_t)(rq + qq) * 2048 + m * 128 + 32 * s + 8 * g);
                wv[qq] = *(const f32x4*)(IW + (size_t)(rq + qq) * 16 + 4 * g);
            }
            f32x4 fc[8], fn[8];
#pragma unroll
            for (int s = 0; s < 4; ++s) { fc[2 * s] = *(const f32x4*)(kr + 32 * s); fc[2 * s + 1] = *(const f32x4*)(kr + 32 * s + 4); }
#pragma unroll 1
            for (int kt = 0; kt < 8; ++kt) {
                const int ktn = kt + 1 < 8 ? kt + 1 : kt;
#pragma unroll
                for (int s = 0; s < 4; ++s) { fn[2 * s] = *(const f32x4*)(kr + (size_t)(16 * ktn) * 128 + 32 * s); fn[2 * s + 1] = *(const f32x4*)(kr + (size_t)(16 * ktn) * 128 + 32 * s + 4); }
                bf16x8 bfr[4];
#pragma unroll
                for (int s = 0; s < 4; ++s) { v4u w; w.x = pk2(fc[2 * s][0], fc[2 * s][1]); w.y = pk2(fc[2 * s][2], fc[2 * s][3]); w.z = pk2(fc[2 * s + 1][0], fc[2 * s + 1][1]); w.w = pk2(fc[2 * s + 1][2], fc[2 * s + 1][3]); bfr[s] = __builtin_bit_cast(bf16x8, w); }
                f32x4 acc[4]; float v[4];
#pragma unroll
                for (int qq = 0; qq < 4; ++qq) { acc[qq] = (f32x4){0.f, 0.f, 0.f, 0.f};
#pragma unroll
                    for (int s = 0; s < 4; ++s) acc[qq] = __builtin_amdgcn_mfma_f32_16x16x32_bf16(afr[qq][s], bfr[s], acc[qq], 0, 0, 0); }
                idx_reduce4(acc, wv, v);
#pragma unroll
                for (int qq = 0; qq < 4; ++qq) if (g == 0) SCS[(size_t)(b * LS + qh * 4 + qq) * SCS_LD + p * PAGE + 16 * kt + m] = v[qq];
#pragma unroll
                for (int s = 0; s < 8; ++s) fc[s] = fn[s];
            }
        }
    } else {
        const int jr = m < LS ? m : LS - 1;
        bf16x8 bfr[4];
#pragma unroll
        for (int s = 0; s < 4; ++s) bfr[s] = *(const bf16x8*)(IK + (size_t)(MP + b * LS + jr) * 128 + 32 * s + 8 * g);
#pragma unroll 1
        for (int qh = 0; qh < 2; ++qh) {
            const int rq = MP + b * LS + qh * 4;
            f32x4 acc[4], wv[4]; float v[4];
#pragma unroll
            for (int qq = 0; qq < 4; ++qq) { acc[qq] = (f32x4){0.f, 0.f, 0.f, 0.f}; wv[qq] = *(const f32x4*)(IW + (size_t)(rq + qq) * 16 + 4 * g);
#pragma unroll
                for (int s = 0; s < 4; ++s) acc[qq] = __builtin_amdgcn_mfma_f32_16x16x32_bf16(*(const bf16x8*)(IQ + (size_t)(rq + qq) * 2048 + m * 128 + 32 * s + 8 * g), bfr[s], acc[qq], 0, 0, 0); }
            idx_reduce4(acc, wv, v);
#pragma unroll
            for (int qq = 0; qq < 4; ++qq) { if (m > qh * 4 + qq) v[qq] = -__builtin_inff(); if (g == 0 && m < LS) SCS[(size_t)(b * LS + qh * 4 + qq) * SCS_LD + PAST + m] = v[qq]; }
        }
    }
}

template <int NPL> __device__ __forceinline__ void topk_query(const float* sc, int n, int* sel, int* cnt, int lane) {
    if (n <= NTOPK) {
#pragma unroll
        for (int j = 0; j < NTOPK / 64; ++j) { const int i = j * 64 + lane; sel[i] = i < n ? i : 0; }
        if (lane == 0) *cnt = n;
        return;
    }
    unsigned key[NPL];
#pragma unroll
    for (int i = 0; i < NPL; ++i) { const int idx = i * 64 + lane; unsigned k = 0u;
        { const unsigned uu = __float_as_uint(sc[idx < n ? idx : n - 1]); if (idx < n) k = (uu & 0x80000000u) ? ~uu : (uu | 0x80000000u); }
        key[i] = k; }
    unsigned tau = 0u;
    for (int bit = 31; bit >= 0; --bit) {
        const unsigned tr = tau | (1u << bit); int c = 0;
#pragma unroll
        for (int i = 0; i < NPL; ++i) c += __popcll(__ballot(key[i] >= tr));
        if (c >= NTOPK) tau = tr;
        if (c == NTOPK) break;
    }
    int base = 0;
#pragma unroll
    for (int i = 0; i < NPL; ++i) {
        const bool f = key[i] >= tau;
        const unsigned long long bal = __ballot(f);
        const int pos = base + __popcll(bal & ((1ull << lane) - 1ull));
        if (f && pos < NTOPK) sel[pos] = i * 64 + lane;
        base += __popcll(bal);
    }
    if (lane == 0) *cnt = base < NTOPK ? base : NTOPK;
}

__device__ __forceinline__ void topk_query16(const _Float16* sc, int n, int* sel, int* cnt, int lane) {
    if (n <= NTOPK) {
#pragma unroll
        for (int j = 0; j < NTOPK / 64; ++j) { const int i = j * 64 + lane; sel[i] = i < n ? i : 0; }
        if (lane == 0) *cnt = n;
        return;
    }
    unsigned key[32];
#pragma unroll
    for (int i = 0; i < 4; ++i) {
        const int base = (i * 64 + lane) * 8;
        const v4u w = *(const v4u*)(sc + base);
        const unsigned ww[4] = {w.x, w.y, w.z, w.w};
#pragma unroll
        for (int e = 0; e < 8; ++e) { const unsigned uu = (e & 1) ? (ww[e >> 1] >> 16) : (ww[e >> 1] & 0xffffu); const unsigned k = (uu & 0x8000u) ? (~uu & 0xffffu) : (uu | 0x8000u); key[i * 8 + e] = (base + e < n) ? k : 0u; }
    }
    unsigned tau = 0u;
    for (int bit = 15; bit >= 0; --bit) {
        const unsigned tr = tau | (1u << bit); int c = 0;
#pragma unroll
        for (int i = 0; i < 32; ++i) c += __popcll(__ballot(key[i] >= tr));
        if (c >= NTOPK) tau = tr;
        if (c == NTOPK) break;
    }
    int base = 0;
#pragma unroll
    for (int i = 0; i < 32; ++i) {
        const bool f = key[i] >= tau;
        const unsigned long long bal = __ballot(f);
        const int pos = base + __popcll(bal & ((1ull << lane) - 1ull));
        if (f && pos < NTOPK) sel[pos] = ((i >> 3) * 64 + lane) * 8 + (i & 7);
        base += __popcll(bal);
    }
    if (lane == 0) *cnt = base < NTOPK ? base : NTOPK;
}
__device__ __forceinline__ void topk_block(const float* sc, int n, int* sel, int* cnt, LAS int* sl) {
    constexpr int NPT = 17;
    const int tid = threadIdx.x, lane = tid & 63, wave = tid >> 6;
    unsigned key[NPT];
#pragma unroll
    for (int i = 0; i < NPT; ++i) { const int idx = i * NTHREADS + tid; unsigned k = 0u;
        { const unsigned uu = __float_as_uint(sc[idx < n ? idx : n - 1]); if (idx < n) k = (uu & 0x80000000u) ? ~uu : (uu | 0x80000000u); }
        key[i] = k; }
    unsigned tau = 0u;
    for (int bit = 31; bit >= 0; --bit) {
        const unsigned tr = tau | (1u << bit); int c = 0;
#pragma unroll
        for (int i = 0; i < NPT; ++i) c += __popcll(__ballot(key[i] >= tr));
        LAS int* pb = sl + (bit & 1) * 8;
        if (lane == 0) pb[wave] = c;
        __syncthreads();
        int tot = 0;
#pragma unroll
        for (int w = 0; w < NWAVES; ++w) tot += pb[w];
        if (tot >= NTOPK) tau = tr;
        if (tot == NTOPK) break;
    }
    LAS int* wc = sl + 16;
    unsigned long long bal[NPT];
#pragma unroll
    for (int i = 0; i < NPT; ++i) { bal[i] = __ballot(key[i] >= tau); if (lane == 0) wc[i * 8 + wave] = __popcll(bal[i]); }
    __syncthreads();
    int base = 0;
#pragma unroll
    for (int i = 0; i < NPT; ++i) {
        int mybase = base;
#pragma unroll
        for (int w = 0; w < NWAVES; ++w) { const int v = wc[i * 8 + w]; if (w < wave) mybase += v; base += v; }
        const int pos = mybase + __popcll(bal[i] & ((1ull << lane) - 1ull));
        if ((key[i] >= tau) && pos < NTOPK) sel[pos] = i * NTHREADS + tid;
    }
    if (tid == 0) *cnt = base < NTOPK ? base : NTOPK;
    __syncthreads();
}

__device__ __forceinline__ const float* kv_row(const Args& a, bool isv, bool sample, int b, int key, int kvh) {
    if (!sample) return a.out + (isv ? O_VP : O_KP) + ((size_t)(b * LP + key) * 2 + kvh) * 128;
    if (key < PAST) { const int phys = a.page_table[b * NPAGES + (key >> 7)]; return (isv ? a.cache_v : a.cache_k) + (((size_t)phys * PAGE + (key & 127)) * 2 + kvh) * 128; }
    return a.out + (isv ? O_VS : O_KS) + ((size_t)(b * LS + (key - PAST)) * 2 + kvh) * 128;
}
constexpr int ATT_WAVE_BYTES = 17408;
template <bool SAMPLE> __device__ __forceinline__ void attn_query(const Args& a, LAS unsigned char* wl, int row, int lane) {
    const bf16* BQ = (const bf16*)(a.ws + WS_BQ); const bf16* BZ = (const bf16*)(a.ws + WS_BZ); bf16* YB = (bf16*)(a.ws + WS_YB);
    const int* sel = (const int*)(a.ws + WS_SEL) + (size_t)row * NTOPK; const int cnt = ((const int*)(a.ws + WS_CNT))[row];
    const int b = SAMPLE ? (row - MP) >> 3 : row >> 11;
    const int m = lane & 15, g = lane >> 4;
    LAS unsigned char* Kb = wl; LAS unsigned char* Vb = wl + 8192; LAS int* SL = (LAS int*)(wl + 16384);
    { v4u sv = *(const v4u*)(sel + 4 * lane); if constexpr (!SAMPLE) { sv.x <<= 10; sv.y <<= 10; sv.z <<= 10; sv.w <<= 10; } *(LAS v4u*)(SL + 4 * lane) = sv; }
    const int ntile = (cnt + 31) >> 5;
#pragma unroll 1
    for (int kvh = 0; kvh < 2; ++kvh) {
        bf16x8 qf[4];
#pragma unroll
        for (int s = 0; s < 4; ++s) { const bf16x8 ql = *(const bf16x8*)(BQ + (size_t)row * 2048 + (kvh * 8 + (m & 7)) * 128 + 32 * s + 8 * g); qf[s] = m < 8 ? ql : (bf16x8){0, 0, 0, 0, 0, 0, 0, 0}; }
        f32x4 o[8];
#pragma unroll
        for (int cc = 0; cc < 8; ++cc) o[cc] = (f32x4){0.f, 0.f, 0.f, 0.f};
        float mrun = -__builtin_inff(), lrun = 0.f;
        v4u pw_[8], px_[8];
        const unsigned char* kvbase = a.ws + WS_BKV + (size_t)b * LP * 1024 + kvh * 256 + 16 * m;
        if constexpr (!SAMPLE) {
#pragma unroll
            for (int i = 0; i < 8; ++i) { int slot = 4 * i + g; slot = slot < cnt ? slot : cnt - 1;
                const unsigned char* src = kvbase + (unsigned)SL[slot];
                pw_[i] = *(const v4u*)src; px_[i] = *(const v4u*)(src + 512); }
        }
#pragma unroll 1
        for (int T = 0; T < ntile; ++T) {
            if constexpr (!SAMPLE) {
#pragma unroll
                for (int i = 0; i < 8; ++i) { const int kap = 4 * i + g, nu = 8 * ((kap >> 2) & 3) + 4 * (kap >> 4) + (kap & 3);
                    *(LAS v4u*)(Kb + off_b(kap, m)) = pw_[i]; *(LAS v4u*)(Vb + off_b(nu, m)) = px_[i]; }
                if (T + 1 < ntile) {
#pragma unroll
                    for (int i = 0; i < 8; ++i) { int slot = 32 * (T + 1) + 4 * i + g; slot = slot < cnt ? slot : cnt - 1;
                        const unsigned char* src = kvbase + (unsigned)SL[slot];
                        pw_[i] = *(const v4u*)src; px_[i] = *(const v4u*)(src + 512); }
                }
            } else {
#pragma unroll
                for (int hb = 0; hb < 2; ++hb) {
                    int key[4], phys[4];
#pragma unroll
                    for (int i = 0; i < 4; ++i) { int slot = 32 * T + 4 * (4 * hb + i) + g; slot = slot < cnt ? slot : cnt - 1; key[i] = SL[slot]; }
#pragma unroll
                    for (int i = 0; i < 4; ++i) { const int pg = key[i] >> 7; phys[i] = a.page_table[b * NPAGES + (pg < NPAGES ? pg : NPAGES - 1)]; }
                    f32x4 f[4][4];
#pragma unroll
                    for (int i = 0; i < 4; ++i) {
                        const bool past = key[i] < PAST; const int jn = past ? 0 : key[i] - PAST;
                        const size_t oc = (((size_t)phys[i] * PAGE + (key[i] & 127)) * 2 + kvh) * 128 + 8 * m, on = ((size_t)(b * LS + jn) * 2 + kvh) * 128 + 8 * m;
                        const float* ks = past ? a.cache_k + oc : a.out + O_KS + on; const float* vs = past ? a.cache_v + oc : a.out + O_VS + on;
                        f[i][0] = *(const f32x4*)ks; f[i][1] = *(const f32x4*)(ks + 4); f[i][2] = *(const f32x4*)vs; f[i][3] = *(const f32x4*)(vs + 4);
                    }
#pragma unroll
                    for (int i = 0; i < 4; ++i) { const int kap = 4 * (4 * hb + i) + g, nu = 8 * ((kap >> 2) & 3) + 4 * (kap >> 4) + (kap & 3);
                        v4u w, x; w.x = pk2(f[i][0][0], f[i][0][1]); w.y = pk2(f[i][0][2], f[i][0][3]); w.z = pk2(f[i][1][0], f[i][1][1]); w.w = pk2(f[i][1][2], f[i][1][3]);
                        x.x = pk2(f[i][2][0], f[i][2][1]); x.y = pk2(f[i][2][2], f[i][2][3]); x.z = pk2(f[i][3][0], f[i][3][1]); x.w = pk2(f[i][3][2], f[i][3][3]);
                        *(LAS v4u*)(Kb + off_b(kap, m)) = w; *(LAS v4u*)(Vb + off_b(nu, m)) = x; }
                }
            }
            f32x4 c[2];
#pragma unroll
            for (int rb = 0; rb < 2; ++rb) {
                f32x4 acc = {0.f, 0.f, 0.f, 0.f};
#pragma unroll
                for (int s = 0; s < 4; ++s) { const bf16x8 kf = *(const LAS bf16x8*)(Kb + off_b(m + 16 * rb, 4 * s + g)); acc = __builtin_amdgcn_mfma_f32_16x16x32_bf16(kf, qf[s], acc, 0, 0, 0); }
                c[rb] = acc;
            }
#pragma unroll
            for (int rb = 0; rb < 2; ++rb)
#pragma unroll
                for (int i = 0; i < 4; ++i) { const int slot = 32 * T + 16 * rb + 4 * g + i; if (slot >= cnt) c[rb][i] = -__builtin_inff(); }
            if (T == 0) {
                float tm = fmaxf(fmaxf(fmaxf(c[0][0], c[0][1]), fmaxf(c[0][2], c[0][3])), fmaxf(fmaxf(c[1][0], c[1][1]), fmaxf(c[1][2], c[1][3])));
                tm = fmaxf(tm, __shfl_xor(tm, 16)); tm = fmaxf(tm, __shfl_xor(tm, 32));
                mrun = tm;
            }
            float ps = 0.f;
#pragma unroll
            for (int rb = 0; rb < 2; ++rb)
#pragma unroll
                for (int i = 0; i < 4; ++i) { const float pe = __expf(fminf(c[rb][i] - mrun, 80.0f)); c[rb][i] = pe; ps += pe; }
            lrun += ps;
            v4u pw; pw.x = pk2(c[0][0], c[0][1]); pw.y = pk2(c[0][2], c[0][3]); pw.z = pk2(c[1][0], c[1][1]); pw.w = pk2(c[1][2], c[1][3]);
            const bf16x8 pa = __builtin_bit_cast(bf16x8, pw);
#pragma unroll
            for (int cc = 0; cc < 8; ++cc) {
                const s16x4 v0 = vtr(Vb + tr_read_addr_16(lane, cc, 0)), v1 = vtr(Vb + tr_read_addr_16(lane, cc, 1));
                const bf16x8 vf = (bf16x8){v0[0], v0[1], v0[2], v0[3], v1[0], v1[1], v1[2], v1[3]};
                o[cc] = __builtin_amdgcn_mfma_f32_16x16x32_bf16(pa, vf, o[cc], 0, 0, 0);
            }
        }
        float l = lrun; l += __shfl_xor(l, 16); l += __shfl_xor(l, 32);
        float linv[4];
#pragma unroll
        for (int i = 0; i < 4; ++i) linv[i] = 1.0f / __shfl(l, (4 * g + i) & 15);
        {
            const int gg = g & 1;
            bf16 zz[4][8];
#pragma unroll
            for (int i = 0; i < 4; ++i)
#pragma unroll
                for (int cc = 0; cc < 8; ++cc) zz[i][cc] = BZ[(size_t)row * 2048 + (kvh * 8 + 4 * gg + i) * 128 + m + 16 * cc];
            if (g < 2) {
#pragma unroll
                for (int i = 0; i < 4; ++i) { const size_t ro = (size_t)row * 2048 + (kvh * 8 + 4 * g + i) * 128 + m;
#pragma unroll
                    for (int cc = 0; cc < 8; ++cc) YB[ro + 16 * cc] = f2bf(o[cc][i] * linv[i] * pg8::fsilu(bf2f(zz[i][cc]))); }
            }
        }
    }
}

template <int KSTEPS> __device__ __forceinline__ void sgemm_32x64(const bf16* A, const bf16* Bt, int K, int k0, int lane, f32x4 (&acc)[2][4]) {
    const bf16* ap = A + (size_t)(lane & 15) * K + k0 + 8 * (lane >> 4); const bf16* bp = Bt + (size_t)(lane & 15) * K + k0 + 8 * (lane >> 4);
#pragma unroll 1
    for (int kk = 0; kk < KSTEPS; kk += 4) {
        bf16x8 af[4][2], bfv[4][4];
#pragma unroll
        for (int s2 = 0; s2 < 4; ++s2) {
#pragma unroll
            for (int ri = 0; ri < 2; ++ri) af[s2][ri] = *(const bf16x8*)(ap + (size_t)(16 * ri) * K + 32 * (kk + s2));
#pragma unroll
            for (int ci = 0; ci < 4; ++ci) bfv[s2][ci] = *(const bf16x8*)(bp + (size_t)(16 * ci) * K + 32 * (kk + s2));
        }
#pragma unroll
        for (int s2 = 0; s2 < 4; ++s2)
#pragma unroll
            for (int ri = 0; ri < 2; ++ri)
#pragma unroll
                for (int ci = 0; ci < 4; ++ci) acc[ri][ci] = __builtin_amdgcn_mfma_f32_16x16x32_bf16(af[s2][ri], bfv[s2][ci], acc[ri][ci], 0, 0, 0);
    }
}
__device__ __forceinline__ void sample_merge_block(const Args& a, LAS unsigned char* lds, int bt) {
    const int tid = threadIdx.x, lane = tid & 63, wave = tid >> 6, m = lane & 15, g = lane >> 4;
    const int rt = bt >> 5, ct = bt & 31, r0 = MP + 32 * rt, c0 = 64 * ct;
    f32x4 a1[2][4], a2[2][4];
#pragma unroll
    for (int ri = 0; ri < 2; ++ri)
#pragma unroll
        for (int ci = 0; ci < 4; ++ci) { a1[ri][ci] = (f32x4){0.f, 0.f, 0.f, 0.f}; a2[ri][ci] = (f32x4){0.f, 0.f, 0.f, 0.f}; }
    sgemm_32x64<8>((const bf16*)(a.ws + WS_YA) + (size_t)r0 * D, (const bf16*)(a.ws + WS_WPA) + (size_t)c0 * D, D, 256 * wave, lane, a1);
    sgemm_32x64<8>((const bf16*)(a.ws + WS_YA) + (size_t)MROWS * D + (size_t)r0 * D, (const bf16*)(a.ws + WS_WPA) + (size_t)D * D + (size_t)c0 * D, D, 256 * wave, lane, a1);
    sgemm_32x64<8>((const bf16*)(a.ws + WS_YB) + (size_t)r0 * D, (const bf16*)(a.ws + WS_WPB) + (size_t)c0 * D, D, 256 * wave, lane, a2);
    LAS f32x4* P = (LAS f32x4*)lds;
#pragma unroll
    for (int ri = 0; ri < 2; ++ri)
#pragma unroll
        for (int ci = 0; ci < 4; ++ci) { P[(wave * 16 + ri * 4 + ci) * 64 + lane] = a1[ri][ci]; P[(wave * 16 + 8 + ri * 4 + ci) * 64 + lane] = a2[ri][ci]; }
    __syncthreads();
    f32x4 s1 = {0.f, 0.f, 0.f, 0.f}, s2 = {0.f, 0.f, 0.f, 0.f};
#pragma unroll
    for (int w = 0; w < NWAVES; ++w) { s1 += P[(w * 16 + wave) * 64 + lane]; s2 += P[(w * 16 + 8 + wave) * 64 + lane]; }
    const int ri = wave >> 2, ci = wave & 3;
    const bf16* GA = (const bf16*)(a.ws + WS_GA); const bf16* GB = (const bf16*)(a.ws + WS_GB); bf16* MG = (bf16*)(a.ws + WS_MG);
#pragma unroll
    for (int e = 0; e < 4; ++e) { const size_t o = (size_t)(r0 + 16 * ri + 4 * g + e) * D + c0 + 16 * ci + m; MG[o] = f2bf(bf2f(GA[o]) * s1[e] + bf2f(GB[o]) * s2[e]); }
    __syncthreads();
}
__device__ __forceinline__ void sample_out_block(const Args& a, LAS unsigned char* lds, int bt) {
    const int tid = threadIdx.x, lane = tid & 63, wave = tid >> 6, m = lane & 15, g = lane >> 4;
    const int rt = bt >> 5, ct = bt & 31, r0 = MP + 32 * rt, c0 = 64 * ct;
    f32x4 acc[2][4];
#pragma unroll
    for (int ri = 0; ri < 2; ++ri)
#pragma unroll
        for (int ci = 0; ci < 4; ++ci) acc[ri][ci] = (f32x4){0.f, 0.f, 0.f, 0.f};
    sgemm_32x64<8>((const bf16*)(a.ws + WS_MG) + (size_t)r0 * D, (const bf16*)(a.ws + WS_WOUT) + (size_t)c0 * D, D, 256 * wave, lane, acc);
    LAS f32x4* P = (LAS f32x4*)lds;
#pragma unroll
    for (int ri = 0; ri < 2; ++ri)
#pragma unroll
        for (int ci = 0; ci < 4; ++ci) P[(wave * 8 + ri * 4 + ci) * 64 + lane] = acc[ri][ci];
    __syncthreads();
    f32x4 s1 = {0.f, 0.f, 0.f, 0.f};
#pragma unroll
    for (int w = 0; w < NWAVES; ++w) s1 += P[(w * 8 + wave) * 64 + lane];
    const int ri = wave >> 2, ci = wave & 3;
    bf16* OUTF = (bf16*)(a.ws + WS_OUTF);
#pragma unroll
    for (int e = 0; e < 4; ++e) OUTF[(size_t)(r0 + 16 * ri + 4 * g + e) * D + c0 + 16 * ci + m] = f2bf(s1[e]);
    __syncthreads();
}

__global__ void __launch_bounds__(NTHREADS, 2) fwd(Args a0) {
    extern __shared__ __attribute__((aligned(16))) unsigned char lds_raw[];
    LAS unsigned char* lds = (LAS unsigned char*)lds_raw;
    const int tid = threadIdx.x, lane0 = tid & 63, wave = __builtin_amdgcn_readfirstlane(tid >> 6);
    const int G = gridDim.x, bid = blockIdx.x;
    const int gw = bid * NWAVES + wave, NGW = G * NWAVES;
    unsigned char* ws = a0.ws;
    gu32* ctl = (gu32*)(ws + WS_CTL);
    for (int u = tid; u < (LDS_BYTES - LDSCTL_OFF) / 4; u += NTHREADS) ((LAS unsigned*)(lds + LDSCTL_OFF))[u] = 0u;
    __syncthreads();
    volatile LAS unsigned* MISC = (volatile LAS unsigned*)(lds + MISC_OFF);
#if MK_ONE_LAUNCH
    XcdBarrier bar = xcd_barrier_post((unsigned*)ctl + CW_BAR, MISC + 8);
#define GRID_BAR() xcd_barrier(bar)
#else
    (void)MISC; (void)ctl;
#define GRID_BAR() do {} while (0)
#endif
    const int lo = a0.ph_lo, hi = a0.ph_hi;
#ifndef PH_MASK
#define PH_MASK 0x1ff
#endif
#define IN(k) (((PH_MASK >> (k)) & 1) && lo <= (k) && (k) < hi)
#define BOTH(k) (IN(k) && IN((k) + 1))
#ifndef REP_MASK
#define REP_MASK 0
#endif
#define NREP(k) (1 + ((REP_MASK >> (k)) & 1))
    float* MOD = (float*)(ws + WS_MOD);
    bf16* WIN = (bf16*)(ws + WS_WIN); bf16* WPA = (bf16*)(ws + WS_WPA); bf16* WPB = (bf16*)(ws + WS_WPB); bf16* WOUT = (bf16*)(ws + WS_WOUT);
    bf16* H = (bf16*)(ws + WS_H);

    if (IN(0)) {
        int ln = lane0; asm volatile("" : "+v"(ln)); const Args a = load_args(lo, hi);
        LAS float* scr = (LAS float*)(lds + wave * 16384);
        constexpr int I_IN = (D / 64) * (NPAD / 32), I_MOD = 32 * 96;
        {
            constexpr int nblk = NPAD / 32;
            LAS unsigned* lctr = (LAS unsigned*)(lds + 8 * 16384);
            if (threadIdx.x == 0) *lctr = 0u;
            __syncthreads();
            for (int r = bid + G * wave; r < I_MOD; r += G * NWAVES) mod_item(a, MOD, r, scr, ln);
            constexpr int NPAIR = I_IN / 2;
            float v0[32], v1[32];
            unsigned q = 0; if (ln == 0) q = __hip_atomic_fetch_add(lctr, 1u, __ATOMIC_RELAXED, __HIP_MEMORY_SCOPE_WORKGROUP);
            int pa = (int)__builtin_amdgcn_readfirstlane(q) * G + bid;
            { const int t = 2 * (pa < NPAIR ? pa : NPAIR - 1); win_tr_load(a.w_in, 32 * (t % nblk), 64 * (t / nblk), v0, ln); win_tr_load(a.w_in, 32 * ((t + 1) % nblk), 64 * ((t + 1) / nblk), v1, ln); }
            while (pa < NPAIR) {
                const int ia = 2 * pa;
                win_tr_store(v0, WIN, 32 * (ia % nblk), 64 * (ia / nblk), scr, ln);
                q = 0; if (ln == 0) q = __hip_atomic_fetch_add(lctr, 1u, __ATOMIC_RELAXED, __HIP_MEMORY_SCOPE_WORKGROUP);
                const int pn = (int)__builtin_amdgcn_readfirstlane(q) * G + bid;
                const int tn = 2 * (pn < NPAIR ? pn : NPAIR - 1);
                win_tr_load(a.w_in, 32 * (tn % nblk), 64 * (tn / nblk), v0, ln);
                win_tr_store(v1, WIN, 32 * ((ia + 1) % nblk), 64 * ((ia + 1) / nblk), scr, ln);
                win_tr_load(a.w_in, 32 * ((tn + 1) % nblk), 64 * ((tn + 1) / nblk), v1, ln);
                pa = pn;
            }
        }
        if (BOTH(0)) GRID_BAR();
    }
    if (IN(1)) for (int rep = 0; rep < NREP(1); ++rep) {
        int ln = lane0; asm volatile("" : "+v"(ln)); const Args a = load_args(lo, hi);
        for (int mrow = gw; mrow < MROWS; mrow += NGW) {
            const float* xr = mrow < MP ? a.x_p + (size_t)mrow * D : a.x_s + (size_t)(mrow - MP) * D;
            const int bi = mrow < MP ? (mrow >> 11) : 4 + ((mrow - MP) >> 3);
            const float* md = MOD + bi * 6144;
            f32x4 v[8], ms[8], mb[8]; float s = 0.f;
#pragma unroll
            for (int j = 0; j < 8; ++j) v[j] = __builtin_nontemporal_load((const f32x4*)xr + ln + 64 * j);
#pragma unroll
            for (int j = 0; j < 8; ++j) { const int col = 4 * (ln + 64 * j);
                ms[j] = *(const f32x4*)(a.pre_g + col) * (*(const f32x4*)(md + 2048 + col) + *(const f32x4*)(a.b_ada + 2048 + col) + 1.0f); mb[j] = *(const f32x4*)(md + col) + *(const f32x4*)(a.b_ada + col); }
#pragma unroll
            for (int j = 0; j < 8; ++j) s += (v[j][0] * v[j][0] + v[j][1] * v[j][1]) + (v[j][2] * v[j][2] + v[j][3] * v[j][3]);
            const float rstd = rsqrtf(wave_sum(s) * (1.0f / D) + NORM_EPS);
#pragma unroll
            for (int j = 0; j < 8; ++j) { const int col = 4 * (ln + 64 * j);
                const f32x4 hv = v[j] * rstd * ms[j] + mb[j];
                v2u w; w.x = pk2(hv[0], hv[1]); w.y = pk2(hv[2], hv[3]);
                *(v2u*)(H + (size_t)mrow * D + col) = w; }
        }
        if (BOTH(1)) GRID_BAR();
    }
    if (IN(2)) for (int rep = 0; rep < NREP(2); ++rep) {
        int ln = lane0; asm volatile("" : "+v"(ln)); const Args a = load_args(lo, hi);
        pg8::Gemm g{H, WIN, MROWS, NPAD, D}; pg8::StaticOrder S; S.init(MROWS, NPAD, G, bid);
        pg8::EpiIn E{(bf16*)(ws + WS_QKV), (bf16*)(ws + WS_Z), (bf16*)(ws + WS_BQ), (bf16*)(ws + WS_BZ), (bf16*)(ws + WS_IQ), (bf16*)(ws + WS_GA), (bf16*)(ws + WS_GB), (bf16*)(ws + WS_IK),
                     (float*)(ws + WS_BETA), (float*)(ws + WS_GG), (float*)(ws + WS_IW), a.out, a.a_log, a.dt_bias, (bf16*)(ws + WS_BKV)};
        pg8::gemm_phase<pg8::EpiIn, pg8::StaticOrder, true, true>(lds, g, S, E);
        {
            constexpr int I_PA = (4096 / 64) * (D / 32), I_PB = (D / 64) * (D / 32), I_OUT = I_PB, NUN = (MROWS / 256) * (NPAD / 256);
            const int nshort = (NUN % G) ? G - NUN % G : G, first = G - nshort;
            if (bid >= first) {
                LAS float* scr = (LAS float*)(lds + wave * 16384);
                for (int it = (bid - first) * NWAVES + wave; it < I_PA + I_PB + I_OUT; it += nshort * NWAVES) {
                    int r = it; const int nblk = D / 32;
                    if (r < I_PA) { const int kb = r / nblk, hh = kb >> 5; transpose_item(a.w_pa + (size_t)hh * D * D, D, D, WPA + (size_t)hh * D * D, 32 * (r % nblk), 64 * (kb & 31), false, scr, ln); continue; } r -= I_PA;
                    if (r < I_PB) { transpose_item(a.w_pb, D, D, WPB, 32 * (r % nblk), 64 * (r / nblk), false, scr, ln); continue; } r -= I_PB;
                    transpose_item(a.w_out, D, D, WOUT, 32 * (r % nblk), 64 * (r / nblk), false, scr, ln);
                }
            }
        }
        if (BOTH(2)) GRID_BAR();
    }
    if (IN(3)) for (int rep = 0; rep < NREP(3); ++rep) {
        int ln = lane0; asm volatile("" : "+v"(ln)); const Args a = load_args(lo, hi);
#pragma unroll 1
        for (int pass = 0; pass < 2; ++pass) {
            if ((pass == 0) == (wave < 4)) {
                for (int it = gw; it < BP * 32 * 64 + BS * 64; it += NGW) prep_item(a, it, ln);
            } else {
                constexpr int NPI = BP * (LP / 4) * 2, NSI = BS * (NPAGES + 1);
                for (int it = gw; it < NPI + NSI; it += NGW) {
                    if (it < NPI) { int i2 = it < NPI / 2 ? it : (NPI - 1) - (it - NPI / 2); idx_prompt_item(a, lds + wave * 16384, i2 & 3, (LP / 4 - 1) - (i2 >> 3), (i2 >> 2) & 1, ln); }
                    else { const int r = it - NPI; idx_sample_item(a, r / (NPAGES + 1), r % (NPAGES + 1), ln); }
                }
            }
        }
        if (BOTH(3)) GRID_BAR();
    }
    if (IN(4)) for (int rep = 0; rep < NREP(4); ++rep) {
        int ln = lane0; asm volatile("" : "+v"(ln)); const Args a = load_args(lo, hi);
        const int nfull = (NITEM / NGW) * NGW, nrem = NITEM - nfull, rper = (nrem + G - 1) / G;
        for (int k = 0; k <= NITEM / NGW; ++k) {
            int it;
            if (k < NITEM / NGW) it = k * NGW + gw; else { if (wave >= rper) break; it = nfull + bid * rper + wave; if (it >= NITEM) break; }
            int item;
            if (it < NITEM_P) { const int par = it & 1, c = (it >> 1) & 31, hq = (it >> 6) & 15, b = it >> 10; item = (b * HV + 2 * hq + par) * 32 + c; }
            else { const int r = it - NITEM_P, par = r & 1, hq = (r >> 1) & 15, b = r >> 5; item = NITEM_P + b * HV + 2 * hq + par; }
            gdnA_item(a, lds + wave * GA_WAVE_BYTES, item, ln);
        }
        int* SEL = (int*)(ws + WS_SEL); int* CNT = (int*)(ws + WS_CNT);
        for (int r = gw; r < MP; r += NGW) topk_query16((const _Float16*)(ws + WS_SC) + (size_t)r * 2048, (r & (LP - 1)) + 1, SEL + (size_t)r * NTOPK, CNT + r, ln);
        __syncthreads();
        for (int r = MP + bid; r < MROWS; r += G) topk_block((const float*)(ws + WS_SCS) + (size_t)(r - MP) * SCS_LD, PAST + ((r - MP) & 7) + 1, SEL + (size_t)r * NTOPK, CNT + r, (LAS int*)lds);
        if (BOTH(4)) GRID_BAR();
    }
    if (IN(5)) for (int rep = 0; rep < NREP(5); ++rep) {
        const Args a = load_args(lo, hi);
        if (G >= 2 * BP * HV) {
            if (bid < BP * HV) scan_prompt_unit(a, lds, bid);
            else for (int u = bid - BP * HV; u < BS * HV; u += G - BP * HV) scan_sample_unit(a, lds, u);
        } else {
            for (int u = bid; u < BP * HV + BS * HV; u += G) { if (u < BP * HV) scan_prompt_unit(a, lds, u); else scan_sample_unit(a, lds, u - BP * HV); }
        }
        __syncthreads();
        {
            int ln = lane0; asm volatile("" : "+v"(ln));
            const int x = bid & 7;
            gu32* qctr = ctl + CW_ATTQ + 16 * x;
            for (;;) {
                unsigned q = 0; if (ln == 0) q = __hip_atomic_fetch_add(qctr, 1u, __ATOMIC_RELAXED, __HIP_MEMORY_SCOPE_AGENT);
                q = __builtin_amdgcn_readfirstlane(q);
                if (q >= (unsigned)(MS / 8 + MP / 8)) break;
                if (q < (unsigned)(MS / 8)) attn_query<true>(a, lds + wave * ATT_WAVE_BYTES, MP + (MS / 8) * x + (int)q, ln);
                else { const int i = (int)q - MS / 8; attn_query<false>(a, lds + wave * ATT_WAVE_BYTES, (x >> 1) * LP + 2 * (LP / 2 - 1 - i) + (x & 1), ln); }
            }
        }
        if (BOTH(5)) GRID_BAR();
    }
    if (IN(6)) for (int rep = 0; rep < NREP(6); ++rep) {
        int ln = lane0; asm volatile("" : "+v"(ln)); const Args a = load_args(lo, hi);
        for (int t = bid; t < (MS / 32) * (D / 64); t += G) sample_merge_block(a, lds, t);
        static_assert(WS_YB == WS_YA + 2 * (size_t)MROWS * D * 2 && WS_WPB == WS_WPA + 2 * (size_t)D * D * 2, "the chain's three segments are contiguous: y_a lo | y_a hi | y_b and w_pa lo | w_pa hi | w_pb");
        pg8::GemmChain g{(const bf16*)(ws + WS_YA), WPA, (size_t)MROWS * D, (size_t)D * D, MP, D, D}; pg8::ChainOrder S; S.init(MP, D, G, bid);
        pg8::EpiChain E{(const bf16*)(ws + WS_GA), (const bf16*)(ws + WS_GB), (bf16*)(ws + WS_MG)};
        pg8::gemm_chain<pg8::EpiChain, pg8::ChainOrder, true, true>(lds, g, S, E);
        if (BOTH(6)) GRID_BAR();
    }
    if (IN(7)) for (int rep = 0; rep < NREP(7); ++rep) {
        int ln = lane0; asm volatile("" : "+v"(ln)); const Args a = load_args(lo, hi);
        for (int t = bid; t < (MS / 32) * (D / 64); t += G) sample_out_block(a, lds, t);
        pg8::Gemm g{(const bf16*)(ws + WS_MG), WOUT, MP, D, D}; pg8::StaticOrder S; S.init(MP, D, G, bid);
        pg8::EpiBf16P E{(bf16*)(ws + WS_OUTF), D};
        pg8::gemm_phase<pg8::EpiBf16P, pg8::StaticOrder, true, true>(lds, g, S, E);
        if (BOTH(7)) GRID_BAR();
    }
    if (IN(8)) for (int rep = 0; rep < NREP(8); ++rep) {
        int ln = lane0; asm volatile("" : "+v"(ln)); const Args a = load_args(lo, hi);
        const bf16* OUTF = (const bf16*)(ws + WS_OUTF);
        for (int mrow = gw; mrow < MROWS; mrow += NGW) {
            const float* xr = mrow < MP ? a.x_p + (size_t)mrow * D : a.x_s + (size_t)(mrow - MP) * D;
            float* yr = mrow < MP ? a.out + O_YP + (size_t)mrow * D : a.out + O_YS + (size_t)(mrow - MP) * D;
            const int bi = mrow < MP ? (mrow >> 11) : 4 + ((mrow - MP) >> 3);
            const float* md = MOD + bi * 6144 + 4096;
            const bf16* orow = OUTF + (size_t)mrow * D;
            v4u ow[4]; f32x4 v[8], xv[8], ms[8]; float s = 0.f;
#pragma unroll
            for (int j = 0; j < 4; ++j) { ow[j] = *(const v4u*)(orow + 8 * (ln + 64 * j)); xv[2 * j] = __builtin_nontemporal_load((const f32x4*)(xr + 8 * (ln + 64 * j))); xv[2 * j + 1] = __builtin_nontemporal_load((const f32x4*)(xr + 8 * (ln + 64 * j) + 4)); }
#pragma unroll
            for (int j = 0; j < 8; ++j) { const int col = 8 * (ln + 64 * (j >> 1)) + 4 * (j & 1); ms[j] = *(const f32x4*)(a.post_g + col) * (*(const f32x4*)(md + col) + *(const f32x4*)(a.b_ada + 4096 + col)); }
#pragma unroll
            for (int j = 0; j < 4; ++j) { v[2 * j] = (f32x4){pg8::bf_lo(ow[j].x), pg8::bf_hi(ow[j].x), pg8::bf_lo(ow[j].y), pg8::bf_hi(ow[j].y)}; v[2 * j + 1] = (f32x4){pg8::bf_lo(ow[j].z), pg8::bf_hi(ow[j].z), pg8::bf_lo(ow[j].w), pg8::bf_hi(ow[j].w)}; }
#pragma unroll
            for (int j = 0; j < 8; ++j) s += (v[j][0] * v[j][0] + v[j][1] * v[j][1]) + (v[j][2] * v[j][2] + v[j][3] * v[j][3]);
            const float rstd = rsqrtf(wave_sum(s) * (1.0f / D) + NORM_EPS);
#pragma unroll
            for (int j = 0; j < 8; ++j) *(f32x4*)(yr + 8 * (ln + 64 * (j >> 1)) + 4 * (j & 1)) = xv[j] + ms[j] * (v[j] * rstd);
        }
    }
#undef IN
#undef BOTH
}

extern "C" void kernel_launch(void* const* d_in, const int* in_sizes, int n_in, void* d_out, int out_size, void* d_ws, size_t ws_size, hipStream_t stream) {
    static int grid = 0;
    if (grid == 0) {
        if (n_in != 22 || (size_t)out_size != O_END || ws_size < WS_END) { fprintf(stderr, "kernel_launch: unexpected shapes (n_in %d, out %d, ws %zu); nothing launched\n", n_in, out_size, ws_size); grid = -1; return; }
        int dev = 0, cus = 0;
        if (hipGetDevice(&dev) != hipSuccess || hipDeviceGetAttribute(&cus, hipDeviceAttributeMultiprocessorCount, dev) != hipSuccess) { grid = -1; return; }
        if (hipFuncSetAttribute((const void*)fwd, hipFuncAttributeMaxDynamicSharedMemorySize, LDS_BYTES) != hipSuccess) { fprintf(stderr, "kernel_launch: hipFuncSetAttribute failed\n"); grid = -1; return; }
        int per_cu = 0;
        if (hipOccupancyMaxActiveBlocksPerMultiprocessor(&per_cu, (const void*)fwd, NTHREADS, LDS_BYTES) != hipSuccess || per_cu < 1) fprintf(stderr, "kernel_launch: note: occupancy query reports %d\n", per_cu);
        (void)hipGetLastError();
        grid = cus;
    }
    if (grid < 0) return;
    (void)hipMemsetAsync((char*)d_ws + WS_CTL, 0, CTL_ZERO_BYTES, stream);
    Args a{};
    a.x_p = (const float*)d_in[0]; a.x_s = (const float*)d_in[1]; a.c_p = (const float*)d_in[2]; a.c_s = (const float*)d_in[3];
    a.cache_k = (const float*)d_in[4]; a.cache_v = (const float*)d_in[5]; a.cache_kidx = (const float*)d_in[6]; a.state_gdn = (const float*)d_in[7]; a.state_conv = (const float*)d_in[8];
    a.page_table = (const int*)d_in[9];
    a.w_ada = (const float*)d_in[10]; a.b_ada = (const float*)d_in[11]; a.pre_g = (const float*)d_in[12]; a.w_in = (const float*)d_in[13]; a.conv_w = (const float*)d_in[14];
    a.a_log = (const float*)d_in[15]; a.dt_bias = (const float*)d_in[16]; a.gdn_g = (const float*)d_in[17]; a.w_pa = (const float*)d_in[18]; a.w_pb = (const float*)d_in[19];
    a.w_out = (const float*)d_in[20]; a.post_g = (const float*)d_in[21];
    a.out = (float*)d_out; a.ws = (unsigned char*)d_ws;
#if MK_ONE_LAUNCH
    a.ph_lo = 0; a.ph_hi = N_PHASES;
    hipLaunchKernelGGL(fwd, dim3(grid), dim3(NTHREADS), LDS_BYTES, stream, a);
#else
    for (int ph = 0; ph < N_PHASES; ++ph) { a.ph_lo = ph; a.ph_hi = ph + 1; hipLaunchKernelGGL(fwd, dim3(grid), dim3(NTHREADS), LDS_BYTES, stream, a); }
#endif
}
```
